# Optimizing an MI355X kernel written in HIP

```python
import math
import jax, jax.numpy as jnp
from jax import lax
import numpy as np

D_MODEL = 1024
BATCH = 4
SEQ = 4096
DEPTH = 4

N_A_LAYERS = DEPTH // 2
N_B_LAYERS = DEPTH - N_A_LAYERS

EXPAND = 2
D_A = EXPAND * D_MODEL
POOL_WINDOWS = (2, 4, 8, 16)
N_POOL_GROUPS = len(POOL_WINDOWS)
POOL_GW = D_A // N_POOL_GROUPS

ATTN_PAIRS = ((128, 1), (512, 4), (2048, 16))
N_GROUPS = len(ATTN_PAIRS)
N_HEADS = 16
HEAD_DIM = D_MODEL // N_HEADS
D_B = N_HEADS * HEAD_DIM
BLK = 128

DN_ALPHA = (2 * DEPTH) ** 0.25
DN_BETA = (8 * DEPTH) ** -0.25
LN_EPS = 1e-5
NEG_INF = -1e30

kernel_name = "yoco_pool_dilated_attn_deepnorm"


def layer_norm(x, g, b):
    xf = x.astype(jnp.float32)
    mu = jnp.mean(xf, axis=-1, keepdims=True)
    var = jnp.mean(jnp.square(xf - mu), axis=-1, keepdims=True)
    y = (xf - mu) * lax.rsqrt(var + LN_EPS) * g.astype(jnp.float32) + b.astype(jnp.float32)
    return y.astype(x.dtype)


def alibi_slopes():
    n = N_GROUPS * N_HEADS
    i = jnp.arange(1, n + 1, dtype=jnp.float32)
    return (2.0 ** (-8.0 * i / n)).reshape(N_GROUPS, N_HEADS)


def pool_mixer(h, w_in, w_grp, scale, w_out):
    B, S, _ = h.shape
    proj = h @ w_in
    u, gate = proj[..., :D_A], proj[..., D_A:]
    uf = u.astype(jnp.float32).reshape(B, S, N_POOL_GROUPS, POOL_GW)
    pos = jnp.arange(S)
    pooled = []
    for g, w in enumerate(POOL_WINDOWS):
        ug = uf[:, :, g]
        cs = jnp.cumsum(ug, axis=1)
        shifted = jnp.pad(cs, ((0, 0), (w, 0), (0, 0)))[:, :S]
        cnt = jnp.minimum(pos + 1, w).astype(jnp.float32)
        pooled.append((cs - shifted) / cnt[None, :, None] - ug)
    pooled = jnp.stack(pooled, axis=2)
    mixed = jnp.einsum('bsgc,gce->bsge', pooled, w_grp.astype(jnp.float32))
    mixed = (mixed.reshape(B, S, D_A) * scale.astype(jnp.float32)).astype(h.dtype)
    return (mixed * jax.nn.silu(gate)) @ w_out


def dilated_window_attention(q, k, v, window, dilation, slopes):
    B, S, H, dh = q.shape
    L = S // dilation
    nblk = -(-L // BLK)
    Lp = nblk * BLK
    win_sub = window // dilation

    def to_sub(t):
        t = t.reshape(B, L, dilation, H, dh)
        t = jnp.pad(t, ((0, 0), (0, Lp - L), (0, 0), (0, 0), (0, 0)))
        return t.reshape(B, nblk, BLK, dilation, H, dh)

    qb, kb, vb = to_sub(q), to_sub(k), to_sub(v)

    def with_prev(t):
        prev = jnp.concatenate([jnp.zeros_like(t[:, :1]), t[:, :-1]], axis=1)
        return jnp.concatenate([prev, t], axis=2)

    kk, vv = with_prev(kb), with_prev(vb)
    scores = jnp.einsum('bnqrhd,bnkrhd->bnrhqk', qb, kk) * (HEAD_DIM ** -0.5)

    a = jnp.arange(BLK)[:, None]
    c = jnp.arange(2 * BLK)[None, :]
    rel = BLK + a - c
    key_pos = (jnp.arange(nblk)[:, None, None] - 1) * BLK + c[None]
    valid = (rel >= 0)[None] & (rel <= win_sub)[None] & (key_pos >= 0)
    bias = -slopes[:, None, None] * (dilation * rel).astype(jnp.float32)[None]
    scores = jnp.where(valid[None, :, None, None], scores + bias[None, None, None], NEG_INF)

    lse = jax.nn.logsumexp(scores, axis=-1)
    p = jnp.exp(scores - lse[..., None])
    out = jnp.einsum('bnrhqk,bnkrhd->bnqrhd', p, vv)
    out = out.reshape(B, Lp, dilation, H, dh)[:, :L].reshape(B, S, H, dh)
    lse = jnp.transpose(lse, (0, 1, 4, 2, 3)).reshape(B, Lp, dilation, H)[:, :L].reshape(B, S, H)
    return out, lse


def dilated_mixer(h, w_in, w_out, k_sh, v_sh, slopes):
    B, S, _ = h.shape
    proj = h @ w_in
    q_all = proj[..., :N_GROUPS * D_B].astype(jnp.float32).reshape(B, S, N_GROUPS, N_HEADS, HEAD_DIM)
    gate = proj[..., N_GROUPS * D_B:]
    kf = k_sh.astype(jnp.float32)
    vf = v_sh.astype(jnp.float32)
    outs, lses = [], []
    for g, (window, dilation) in enumerate(ATTN_PAIRS):
        o, l = dilated_window_attention(q_all[:, :, g], kf[:, :, g], vf[:, :, g], window, dilation, slopes[g])
        outs.append(o)
        lses.append(l)
    wts = jax.nn.softmax(jnp.stack(lses, axis=0), axis=0)
    merged = jnp.sum(wts[..., None] * jnp.stack(outs, axis=0), axis=0)
    merged = merged.reshape(B, S, D_B).astype(h.dtype)
    return (merged * jax.nn.silu(gate)) @ w_out


def setup_inputs(seed: int = 0) -> dict:
    key = jax.random.key(seed)
    ks = jax.random.split(key, 12)
    f32 = jnp.float32
    x = jax.random.normal(ks[0], (BATCH, SEQ, D_MODEL), f32)
    w_in_a = jax.random.normal(ks[1], (N_A_LAYERS, D_MODEL, 2 * D_A), f32) * D_MODEL ** -0.5
    w_grp_a = jax.random.normal(ks[2], (N_A_LAYERS, N_POOL_GROUPS, POOL_GW, POOL_GW), f32) * POOL_GW ** -0.5
    scale_a = 1.0 + 0.1 * jax.random.normal(ks[3], (N_A_LAYERS, D_A), f32)
    w_out_a = jax.random.normal(ks[4], (N_A_LAYERS, D_A, D_MODEL), f32) * (D_A ** -0.5) * DN_BETA
    w_kv = jax.random.normal(ks[5], (D_MODEL, 2 * N_GROUPS * D_B), f32) * D_MODEL ** -0.5
    w_in_b = jax.random.normal(ks[6], (N_B_LAYERS, D_MODEL, (N_GROUPS + 1) * D_B), f32) * D_MODEL ** -0.5
    w_out_b = jax.random.normal(ks[7], (N_B_LAYERS, D_B, D_MODEL), f32) * (D_B ** -0.5) * DN_BETA
    ln_g = 1.0 + 0.02 * jax.random.normal(ks[8], (DEPTH, D_MODEL), f32)
    ln_b = 0.02 * jax.random.normal(ks[9], (DEPTH, D_MODEL), f32)
    return {"x": x, "w_in_a": w_in_a, "w_grp_a": w_grp_a, "scale_a": scale_a, "w_out_a": w_out_a,
            "w_kv": w_kv, "w_in_b": w_in_b, "w_out_b": w_out_b, "ln_g": ln_g, "ln_b": ln_b}


def reference(x, w_in_a, w_grp_a, scale_a, w_out_a, w_kv, w_in_b, w_out_b, ln_g, ln_b):
    B, S, _ = x.shape
    slopes = alibi_slopes()
    h = x
    k_sh = None
    v_sh = None
    for l in range(DEPTH):
        if l < N_A_LAYERS:
            y = pool_mixer(h, w_in_a[l], w_grp_a[l], scale_a[l], w_out_a[l])
        else:
            j = l - N_A_LAYERS
            y = dilated_mixer(h, w_in_b[j], w_out_b[j], k_sh, v_sh, slopes)
        h = layer_norm(DN_ALPHA * h + y, ln_g[l], ln_b[l])
        if l == N_A_LAYERS - 1:
            kv = h @ w_kv
            k_sh = kv[..., :N_GROUPS * D_B].reshape(B, S, N_GROUPS, N_HEADS, HEAD_DIM)
            v_sh = kv[..., N_GROUPS * D_B:].reshape(B, S, N_GROUPS, N_HEADS, HEAD_DIM)
    return h
```

```cpp
#include <hip/hip_runtime.h>
#include <hip/hip_cooperative_groups.h>
#include <cstdio>
namespace cg = cooperative_groups;

#define LAS __attribute__((address_space(3)))
typedef unsigned short bf16_t;
typedef short bf16x8 __attribute__((ext_vector_type(8)));
typedef short bf16x4 __attribute__((ext_vector_type(4)));
typedef float f32x4 __attribute__((ext_vector_type(4)));
typedef float f32x2 __attribute__((ext_vector_type(2)));
typedef unsigned u32x4 __attribute__((ext_vector_type(4)));
typedef unsigned u32x2 __attribute__((ext_vector_type(2)));

constexpr int MT = 16384, DM = 1024, SEQ = 4096;
constexpr int BM = 256, BK = 64, HALF = 128, HTB = HALF * BK * 2, STAGE_BYTES = 8 * HTB, NXCD = 8, WGM = 8;
constexpr int LDS_BYTES = 131072 + 1024;
constexpr float DN_ALPHA = 1.681792830507429f;
constexpr float LN_EPS = 1e-5f;
constexpr float LOG2E = 1.4426950408889634f, LN2 = 0.6931471805599453f;
constexpr size_t MiB = 1024 * 1024;
constexpr size_t OFF_V = 0, OFF_SG = 64 * MiB, OFF_BTA = 128 * MiB, OFF_WOA = 144 * MiB, OFF_WGT = 152 * MiB, OFF_WINU = 156 * MiB;
constexpr size_t OFF_KVT = 192 * MiB, OFF_INB = 204 * MiB, OFF_BAR = 220 * MiB, OFF_HB = 224 * MiB;
constexpr size_t OFF_CNT = OFF_BAR + 16384, OFF_XBUF = OFF_BAR + 32768;
constexpr size_t OFF_OUTB = 193 * MiB;
constexpr size_t OFF_K = 0, OFF_VT = 96 * MiB, OFF_LSE = 192 * MiB;
constexpr size_t WS_NEED = 256 * MiB;

__device__ __forceinline__ unsigned cvt_pk_bf16(float lo, float hi) { unsigned r; asm volatile("v_cvt_pk_bf16_f32 %0, %1, %2" : "=v"(r) : "v"(lo), "v"(hi)); return r; }
__device__ __forceinline__ float bf_lo(unsigned w) { return __uint_as_float(w << 16); }
__device__ __forceinline__ float bf_hi(unsigned w) { return __uint_as_float(w & 0xffff0000u); }
typedef _Float16 half8 __attribute__((ext_vector_type(8)));
__device__ __forceinline__ unsigned cvt_pk_f16(float lo, float hi) { const _Float16 a = (_Float16)lo, b = (_Float16)hi; return (unsigned)__builtin_bit_cast(unsigned short, a) | ((unsigned)__builtin_bit_cast(unsigned short, b) << 16); }
__device__ __forceinline__ float h_lo(unsigned w) { return (float)__builtin_bit_cast(_Float16, (unsigned short)(w & 0xffffu)); }
__device__ __forceinline__ float h_hi(unsigned w) { return (float)__builtin_bit_cast(_Float16, (unsigned short)(w >> 16)); }
template <bool F16> __device__ __forceinline__ unsigned cvt_pk16(float lo, float hi) { if constexpr (F16) return cvt_pk_f16(lo, hi); else return cvt_pk_bf16(lo, hi); }
__device__ __forceinline__ int opaque(int x) { asm volatile("" : "+v"(x)); return x; }
__device__ __forceinline__ float silu_f(float x) { return x * __builtin_amdgcn_rcpf(1.0f + __builtin_amdgcn_exp2f(-x * LOG2E)); }

__host__ __device__ __forceinline__ int lds_byte(int r, int c) { const int st = (r >> 4) * 2 + (c >> 5), rr = r & 15, cc = c & 31, ob = rr * 64 + cc * 2; return st * 1024 + (ob ^ (((ob >> 9) & 1) << 5)); }
__host__ __device__ __forceinline__ void stage_rc(int b, int& R, int& C) { const int st = b / 1024, sb = b % 1024, swz = sb ^ (((sb >> 9) & 1) << 5); R = (st >> 1) * 16 + swz / 64; C = (st & 1) * 32 + (swz % 64) / 2; }
__host__ __device__ __forceinline__ int perm32(int rho) { const int n = rho >> 4, i = rho & 15; return 8 * (i >> 2) + 4 * n + (i & 3); }

struct Unit { int pm, pn; };
struct Gemm { const bf16_t* A; const bf16_t* Bt; int M, N, K; };

struct StaticOrder {
    int nM, nN, nwg, G, c;
    __device__ void init(int M, int N, int G_, int c_) { nM = M / BM; nN = N / BM; nwg = nM * nN; G = G_; c = c_; }
    __device__ bool next(int i, Unit& u) const {
        const long L = (long)i * G + c; if (L >= nwg) return false;
        int wgid = (int)L; { const int q = nwg / NXCD, r = nwg % NXCD, xcd = wgid % NXCD, off = wgid / NXCD; wgid = (xcd < r ? xcd * (q + 1) : r * (q + 1) + (xcd - r) * q) + off; }
        const int nig = WGM * nN, gid = wgid / nig, fm = gid * WGM, gsz = (nM - fm) < WGM ? (nM - fm) : WGM;
        u.pm = fm + ((wgid % nig) % gsz); u.pn = (wgid % nig) / gsz; return true;
    }
};
struct SingleUnit {
    bool has; Unit u0;
    __device__ bool next(int i, Unit& u) const { if (i == 0 && has) { u = u0; return true; } return false; }
};

template <bool F16 = false> struct EpiStore16 {
    static constexpr bool PERM = true, AFTER_DRAIN = false;
    bf16_t* O; int ldc;
    __device__ __forceinline__ void operator()(const f32x4 (&acc)[2][2][4][2], const Unit& u, int wr, int wc, int fr, int fq) const {
        const int row0 = u.pm * BM + wr * 64 + fr, col0 = u.pn * BM + wc * 32 + 8 * fq;
#pragma unroll
        for (int ai = 0; ai < 2; ++ai)
#pragma unroll
            for (int m = 0; m < 4; ++m) { bf16_t* rowp = O + (size_t)(row0 + ai * HALF + m * 16) * ldc + col0;
#pragma unroll
                for (int bj = 0; bj < 2; ++bj) { const f32x4 v0 = acc[ai][bj][m][0], v1 = acc[ai][bj][m][1];
                    u32x4 w; w.x = cvt_pk16<F16>(v0[0], v0[1]); w.y = cvt_pk16<F16>(v0[2], v0[3]); w.z = cvt_pk16<F16>(v1[0], v1[1]); w.w = cvt_pk16<F16>(v1[2], v1[3]);
                    *(u32x4*)(rowp + bj * HALF) = w; } }
    }
};
struct EpiStoreSplit {
    static constexpr bool PERM = true, AFTER_DRAIN = false;
    bf16_t* O0; bf16_t* O1;
    __device__ __forceinline__ void operator()(const f32x4 (&acc)[2][2][4][2], const Unit& u, int wr, int wc, int fr, int fq) const {
        const int row0 = u.pm * BM + wr * 64 + fr, col0 = (u.pn & 3) * BM + wc * 32 + 8 * fq;
        bf16_t* base = u.pn >= 4 ? O1 : O0;
#pragma unroll
        for (int ai = 0; ai < 2; ++ai)
#pragma unroll
            for (int m = 0; m < 4; ++m) { bf16_t* rowp = base + (size_t)(row0 + ai * HALF + m * 16) * 1024 + col0;
#pragma unroll
                for (int bj = 0; bj < 2; ++bj) { const f32x4 v0 = acc[ai][bj][m][0], v1 = acc[ai][bj][m][1];
                    u32x4 w; w.x = cvt_pk_bf16(v0[0], v0[1]); w.y = cvt_pk_bf16(v0[2], v0[3]); w.z = cvt_pk_bf16(v1[0], v1[1]); w.w = cvt_pk_bf16(v1[2], v1[3]);
                    *(u32x4*)(rowp + bj * HALF) = w; } }
    }
};
struct EpiAG1 {
    static constexpr bool PERM = true, AFTER_DRAIN = false;
    bf16_t* V; bf16_t* SG;
    __device__ __forceinline__ void operator()(const f32x4 (&acc)[2][2][4][2], const Unit& u, int wr, int wc, int fr, int fq) const {
        const bool isg = u.pn >= 8;
        const int row0 = u.pm * BM + wr * 64 + fr, col0 = (isg ? u.pn - 8 : u.pn) * BM + wc * 32 + 8 * fq;
        bf16_t* base = isg ? SG : V;
#pragma unroll
        for (int ai = 0; ai < 2; ++ai)
#pragma unroll
            for (int m = 0; m < 4; ++m) { bf16_t* rowp = base + (size_t)(row0 + ai * HALF + m * 16) * 2048 + col0;
#pragma unroll
                for (int bj = 0; bj < 2; ++bj) { f32x4 v0 = acc[ai][bj][m][0], v1 = acc[ai][bj][m][1];
                    if (isg) {
#pragma unroll
                        for (int j = 0; j < 4; ++j) { v0[j] = silu_f(v0[j]); v1[j] = silu_f(v1[j]); } }
                    u32x4 w; w.x = cvt_pk_bf16(v0[0], v0[1]); w.y = cvt_pk_bf16(v0[2], v0[3]); w.z = cvt_pk_bf16(v1[0], v1[1]); w.w = cvt_pk_bf16(v1[2], v1[3]);
                    *(u32x4*)(rowp + bj * HALF) = w; } }
    }
};
struct EpiGateMul {
    static constexpr bool PERM = true, AFTER_DRAIN = false;
    const bf16_t* Zin; bf16_t* Zout;
    __device__ __forceinline__ void operator()(const f32x4 (&acc)[2][2][4][2], const Unit& u, int wr, int wc, int fr, int fq) const {
        const int row0 = u.pm * BM + wr * 64 + fr, col0 = u.pn * BM + wc * 32 + 8 * fq;
#pragma unroll
        for (int ai = 0; ai < 2; ++ai)
#pragma unroll
            for (int m = 0; m < 4; ++m) { const size_t roff = (size_t)(row0 + ai * HALF + m * 16) * DM + col0; const bf16_t* rowp = Zin + roff; bf16_t* rowo = Zout + roff;
#pragma unroll
                for (int bj = 0; bj < 2; ++bj) { const f32x4 v0 = acc[ai][bj][m][0], v1 = acc[ai][bj][m][1];
                    const u32x4 h = *(const u32x4*)(rowp + bj * HALF);
                    u32x4 w;
                    w.x = cvt_pk_bf16(bf_lo(h.x) * silu_f(v0[0]), bf_hi(h.x) * silu_f(v0[1]));
                    w.y = cvt_pk_bf16(bf_lo(h.y) * silu_f(v0[2]), bf_hi(h.y) * silu_f(v0[3]));
                    w.z = cvt_pk_bf16(bf_lo(h.z) * silu_f(v1[0]), bf_hi(h.z) * silu_f(v1[1]));
                    w.w = cvt_pk_bf16(bf_lo(h.w) * silu_f(v1[2]), bf_hi(h.w) * silu_f(v1[3]));
                    *(u32x4*)(rowo + bj * HALF) = w; } }
    }
};
struct EpiKr {
    static constexpr bool PERM = true, AFTER_DRAIN = false;
    bf16_t* Kr;
    __device__ __forceinline__ void operator()(const f32x4 (&acc)[2][2][4][2], const Unit& u, int wr, int wc, int fr, int fq) const {
        const int row0 = u.pm * BM + wr * 64 + fr, col0 = u.pn * BM + wc * 32 + 8 * fq;
        const int g = u.pn >> 2, dsh = 2 * g;
#pragma unroll
        for (int ai = 0; ai < 2; ++ai)
#pragma unroll
            for (int m = 0; m < 4; ++m) { const int t = row0 + ai * HALF + m * 16, b = t >> 12, s = t & 4095, r = s & ((1 << dsh) - 1), i = s >> dsh;
                const int rowidx = r * (SEQ >> dsh) + i;
#pragma unroll
                for (int bj = 0; bj < 2; ++bj) { const f32x4 v0 = acc[ai][bj][m][0], v1 = acc[ai][bj][m][1];
                    const int col = col0 + bj * HALF, hh = (col >> 6) & 15, d0 = col & 63;
                    u32x4 w; w.x = cvt_pk_bf16(v0[0], v0[1]); w.y = cvt_pk_bf16(v0[2], v0[3]); w.z = cvt_pk_bf16(v1[0], v1[1]); w.w = cvt_pk_bf16(v1[2], v1[3]);
                    *(u32x4*)(Kr + ((size_t)(((g * 16 + hh) * 4 + b) * SEQ + rowidx)) * 64 + d0) = w; } }
    }
};
template <int DSH> struct EpiVt {
    static constexpr bool PERM = true, AFTER_DRAIN = false;
    bf16_t* Vt;
    __device__ __forceinline__ void operator()(const f32x4 (&acc)[2][2][4][2], const Unit& u, int wr, int wc, int fr, int fq) const {
        const int row0 = u.pm * BM + wr * 64 + fr;
        const int t_tile = u.pn * BM, b = t_tile >> 12, s_tile = t_tile & 4095;
#pragma unroll
        for (int ai = 0; ai < 2; ++ai)
#pragma unroll
            for (int m = 0; m < 4; ++m) { bf16_t* rowp = Vt + (size_t)(row0 + ai * HALF + m * 16) * MT + b * SEQ + (s_tile >> DSH);
#pragma unroll
                for (int bj = 0; bj < 2; ++bj) { const f32x4 v0 = acc[ai][bj][m][0], v1 = acc[ai][bj][m][1];
                    const int c = bj * HALF + wc * 32 + 8 * fq, r = c >> (8 - DSH), il = c & ((256 >> DSH) - 1);
                    u32x4 w; w.x = cvt_pk_bf16(v0[0], v0[1]); w.y = cvt_pk_bf16(v0[2], v0[3]); w.z = cvt_pk_bf16(v1[0], v1[1]); w.w = cvt_pk_bf16(v1[2], v1[3]);
                    *(u32x4*)(rowp + r * (SEQ >> DSH) + il) = w; } }
    }
};

template <bool RES_F32, bool OUT_F, bool OUT_B, bool F16 = false> struct EpiLnFused {
    static constexpr bool PERM = false, AFTER_DRAIN = true;
    const float* hin_f; const bf16_t* hin_b;
    float* out_f; bf16_t* out_b;
    const float* gam; const float* bet;
    unsigned long long* xbuf; unsigned* cnt; unsigned want;
    __device__ __forceinline__ void fused(f32x4 (&acc)[2][2][4][2], const Unit& u, int wr, int wc, int fr, int fq, LAS unsigned char* lds, int wid, int lane) const {
        LAS f32x2* P = (LAS f32x2*)lds;
        LAS f32x2* S = (LAS f32x2*)(lds + 8192);
        const int col0 = u.pn * BM + wc * 32 + 4 * fq;
#pragma unroll
        for (int ai = 0; ai < 2; ++ai)
#pragma unroll
            for (int mp = 0; mp < 2; ++mp) {
                f32x4 hb_[2][2][2];
#pragma unroll
                for (int mi = 0; mi < 2; ++mi) { const int m = mp * 2 + mi; const unsigned off = (unsigned)(u.pm * BM + ai * HALF + wr * 64 + m * 16 + fr) * DM + col0;
#pragma unroll
                    for (int bj = 0; bj < 2; ++bj)
#pragma unroll
                        for (int n = 0; n < 2; ++n) {
                            if constexpr (RES_F32) hb_[mi][bj][n] = *(const f32x4*)(hin_f + off + bj * HALF + n * 16);
                            else { const u32x2 w = *(const u32x2*)(hin_b + off + bj * HALF + n * 16); hb_[mi][bj][n] = (f32x4){__uint_as_float(w.x), __uint_as_float(w.y), 0.f, 0.f}; } } }
                asm volatile("" : "+v"(hb_[0][0][0]), "+v"(hb_[0][0][1]), "+v"(hb_[0][1][0]), "+v"(hb_[0][1][1]), "+v"(hb_[1][0][0]), "+v"(hb_[1][0][1]), "+v"(hb_[1][1][0]), "+v"(hb_[1][1][1]));
#pragma unroll
                for (int mi = 0; mi < 2; ++mi) { const int m = mp * 2 + mi;
#pragma unroll
                    for (int bj = 0; bj < 2; ++bj)
#pragma unroll
                        for (int n = 0; n < 2; ++n) { f32x4 h = hb_[mi][bj][n];
                            if constexpr (!RES_F32) { const unsigned wx = __float_as_uint(h[0]), wy = __float_as_uint(h[1]); if constexpr (F16) h = (f32x4){h_lo(wx), h_hi(wx), h_lo(wy), h_hi(wy)}; else h = (f32x4){bf_lo(wx), bf_hi(wx), bf_lo(wy), bf_hi(wy)}; }
                            acc[ai][bj][m][n] = h * DN_ALPHA + acc[ai][bj][m][n]; }
                    asm volatile("" : "+v"(acc[ai][0][m][0]), "+v"(acc[ai][0][m][1]), "+v"(acc[ai][1][m][0]), "+v"(acc[ai][1][m][1])); }
                asm volatile("" ::: "memory"); }
#pragma unroll
        for (int ai = 0; ai < 2; ++ai)
#pragma unroll
            for (int m = 0; m < 4; ++m) {
                float s = 0.f;
#pragma unroll
                for (int bj = 0; bj < 2; ++bj)
#pragma unroll
                    for (int n = 0; n < 2; ++n) { const f32x4 x = acc[ai][bj][m][n]; s += (x[0] + x[1]) + (x[2] + x[3]); }
                s += __shfl_xor(s, 16); s += __shfl_xor(s, 32);
                const float mw = s * (1.0f / 64.0f); float qq = 0.f;
#pragma unroll
                for (int bj = 0; bj < 2; ++bj)
#pragma unroll
                    for (int n = 0; n < 2; ++n) { const f32x4 d = acc[ai][bj][m][n] - mw; qq += (d[0] * d[0] + d[1] * d[1]) + (d[2] * d[2] + d[3] * d[3]); }
                qq += __shfl_xor(qq, 16); qq += __shfl_xor(qq, 32);
                if (fq == 0) P[(ai * HALF + wr * 64 + m * 16 + fr) * 4 + wc] = (f32x2){mw, qq};
            }
        asm volatile("s_waitcnt lgkmcnt(0)" ::: "memory"); __builtin_amdgcn_s_barrier(); asm volatile("" ::: "memory");
        const int row = wid * 32 + (lane & 31);
        if (lane < 32) {
            const f32x2 a = P[row * 4 + 0], b = P[row * 4 + 1], c = P[row * 4 + 2], d = P[row * 4 + 3];
            const float mt = (a.x + b.x + c.x + d.x) * 0.25f;
            const float da = a.x - mt, db = b.x - mt, dc = c.x - mt, dd = d.x - mt;
            const float m2 = (a.y + b.y) + (c.y + d.y) + 64.0f * ((da * da + db * db) + (dc * dc + dd * dd));
            unsigned long long* slot = xbuf + ((size_t)(u.pm * BM + row) * 4 + u.pn);
            __hip_atomic_store(slot, ((unsigned long long)__float_as_uint(m2) << 32) | __float_as_uint(mt), __ATOMIC_RELAXED, __HIP_MEMORY_SCOPE_AGENT);
        }
        asm volatile("s_waitcnt vmcnt(0)" ::: "memory");
        if (lane == 0) __hip_atomic_fetch_add(cnt + 64 * u.pm, 1u, __ATOMIC_RELAXED, __HIP_MEMORY_SCOPE_AGENT);
        if (wid == 0) {
            unsigned sp = 0;
            while ((unsigned)__builtin_amdgcn_readfirstlane(__hip_atomic_load(cnt + 64 * u.pm, __ATOMIC_RELAXED, __HIP_MEMORY_SCOPE_AGENT)) < want) { __builtin_amdgcn_s_sleep(2); if (++sp > (1u << 22)) break; }
            __builtin_amdgcn_fence(__ATOMIC_ACQUIRE, "agent");
        }
        asm volatile("s_waitcnt vmcnt(0) lgkmcnt(0)" ::: "memory"); __builtin_amdgcn_s_barrier(); asm volatile("" ::: "memory");
        if (lane < 32) {
            const unsigned long long* slot = xbuf + (size_t)(u.pm * BM + row) * 4; float mt[4], m2[4]; float ms = 0.f;
#pragma unroll
            for (int t = 0; t < 4; ++t) { const unsigned long long w = __hip_atomic_load(slot + t, __ATOMIC_RELAXED, __HIP_MEMORY_SCOPE_AGENT); mt[t] = __uint_as_float((unsigned)w); m2[t] = __uint_as_float((unsigned)(w >> 32)); ms += mt[t]; }
            const float mean = ms * 0.25f; float qq = 0.f;
#pragma unroll
            for (int t = 0; t < 4; ++t) { const float dm = mt[t] - mean; qq += m2[t] + 256.0f * dm * dm; }
            S[row] = (f32x2){mean, 1.0f / sqrtf(qq * (1.0f / 1024.0f) + LN_EPS)};
        }
        asm volatile("s_waitcnt lgkmcnt(0)" ::: "memory"); __builtin_amdgcn_s_barrier(); asm volatile("" ::: "memory");
        f32x2 sr[2][4];
#pragma unroll
        for (int ai = 0; ai < 2; ++ai)
#pragma unroll
            for (int m = 0; m < 4; ++m) sr[ai][m] = S[ai * HALF + wr * 64 + m * 16 + fr];
#pragma unroll
        for (int bj = 0; bj < 2; ++bj)
#pragma unroll
            for (int n = 0; n < 2; ++n) { const f32x4 gv = *(const f32x4*)(gam + col0 + bj * HALF + n * 16), bv = *(const f32x4*)(bet + col0 + bj * HALF + n * 16);
#pragma unroll
                for (int ai = 0; ai < 2; ++ai)
#pragma unroll
                    for (int m = 0; m < 4; ++m) { const int r = ai * HALF + wr * 64 + m * 16 + fr; const unsigned off = (unsigned)(u.pm * BM + r) * DM + col0 + bj * HALF + n * 16;
                        const f32x4 o = (acc[ai][bj][m][n] - sr[ai][m].x) * sr[ai][m].y * gv + bv;
                        if constexpr (OUT_F) *(f32x4*)(out_f + off) = o;
                        if constexpr (OUT_B) { u32x2 w; w.x = cvt_pk16<F16>(o[0], o[1]); w.y = cvt_pk16<F16>(o[2], o[3]); *(u32x2*)(out_b + off) = w; } } }
    }
};

template <class Epi, class Sched, int DSH = 0, bool F16 = false, bool SP2 = true, bool ALIGN_EPI = true>
__device__ __forceinline__ void gemm_phase(LAS unsigned char* lds, const Gemm g, const Sched& S, const Epi& E) {
    const int tid = opaque(threadIdx.x), wid = __builtin_amdgcn_readfirstlane(tid >> 6), lane = tid & 63, wr = wid >> 2, wc = wid & 3, fr = lane & 15, fq = lane >> 4;
    const int K = g.K, nt = K / BK;
    unsigned voffA[2], voffB[2], voffB1[2];
#pragma unroll
    for (int i = 0; i < 2; ++i) { int R, C; stage_rc(tid * 16 + i * 8192, R, C); const int Rb = Epi::PERM ? ((R & ~31) + perm32(R & 31)) : R;
        voffA[i] = (unsigned)(R * K + C) * 2u;
        if constexpr (DSH == 0) { voffB[i] = (unsigned)(Rb * K + C) * 2u; voffB1[i] = (unsigned)((Rb + HALF) * K + C) * 2u; }
        else { const int c0_ = Rb, c1_ = Rb + HALF; const int t0_ = ((c0_ & ((256 >> DSH) - 1)) << DSH) + (c0_ >> (8 - DSH)), t1_ = ((c1_ & ((256 >> DSH) - 1)) << DSH) + (c1_ >> (8 - DSH));
            voffB[i] = (unsigned)(t0_ * K + C) * 2u; voffB1[i] = (unsigned)(t1_ * K + C) * 2u; } }
    const size_t kstep = (size_t)(BK * 2);
    const size_t hstep = (size_t)HALF * K * 2;
    const size_t tstep = 2 * hstep;
    const unsigned ldsw = (unsigned)wid * 1024u;
    const int aoff = lds_byte(wr * 64 + fr, fq * 8), boff = lds_byte(wc * 32 + fr, fq * 8);
#define PG8_SA(b, h) (((b) * 2 + (h)) * HTB)
#define PG8_SB(b, h) ((4 + (b) * 2 + (h)) * HTB)
#define PG8_STAGE(bufoff, gbase, voff) do { _Pragma("unroll") for (int _i = 0; _i < 2; ++_i) \
        __builtin_amdgcn_global_load_lds((const unsigned*)((const char*)(gbase) + (voff)[_i]), (LAS unsigned*)(lds + (bufoff) + ldsw + _i * 8192), 16, 0, 0); } while (0)
#define PG8_LDA(dst, b, h) do { _Pragma("unroll") for (int m = 0; m < 4; ++m) _Pragma("unroll") for (int k = 0; k < 2; ++k) dst[m][k] = *(const LAS bf16x8*)(lds + PG8_SA(b, h) + aoff + m * 2048 + k * 1024); } while (0)
#define PG8_LDB(dst, b, h) do { _Pragma("unroll") for (int n = 0; n < 2; ++n) _Pragma("unroll") for (int k = 0; k < 2; ++k) dst[n][k] = *(const LAS bf16x8*)(lds + PG8_SB(b, h) + boff + n * 2048 + k * 1024); } while (0)
#define PG8_MMA(ai, bj, At, Bt) do { __builtin_amdgcn_s_setprio(1); _Pragma("unroll") for (int m = 0; m < 4; ++m) _Pragma("unroll") for (int n = 0; n < 2; ++n) _Pragma("unroll") for (int k = 0; k < 2; ++k) \
        acc[ai][bj][m][n] = F16 ? __builtin_amdgcn_mfma_f32_16x16x32_f16(__builtin_bit_cast(half8, Bt[n][k]), __builtin_bit_cast(half8, At[m][k]), acc[ai][bj][m][n], 0, 0, 0) : __builtin_amdgcn_mfma_f32_16x16x32_bf16(Bt[n][k], At[m][k], acc[ai][bj][m][n], 0, 0, 0); __builtin_amdgcn_s_setprio(0); } while (0)
#define PG8_WAIT_V(n) asm volatile("s_waitcnt vmcnt(" #n ")" ::: "memory")
#define PG8_WAIT_L(n) asm volatile("s_waitcnt lgkmcnt(" #n ")" ::: "memory")
#define PG8_BAR __builtin_amdgcn_s_barrier()
#define PG8_SCHED __builtin_amdgcn_sched_barrier(0)
    Unit cur, nxt; int ui = 0;
    if (!S.next(0, cur)) return;
    f32x4 acc[2][2][4][2];
#pragma unroll
    for (int a = 0; a < 2; ++a)
#pragma unroll
        for (int b = 0; b < 2; ++b)
#pragma unroll
            for (int m = 0; m < 4; ++m)
#pragma unroll
                for (int n = 0; n < 2; ++n) acc[a][b][m][n] = (f32x4){0.f, 0.f, 0.f, 0.f};
    bf16x8 At[4][2], B0[2][2], B1[2][2];
    const char* cA = (const char*)g.A + (size_t)cur.pm * tstep; const char* cB = (const char*)g.Bt + (size_t)cur.pn * tstep;
    if constexpr (SP2) {
        PG8_STAGE(PG8_SB(0, 0), cB, voffB); PG8_STAGE(PG8_SB(0, 1), cB, voffB1); PG8_STAGE(PG8_SA(0, 0), cA, voffA); PG8_STAGE(PG8_SA(0, 1), cA + hstep, voffA);
        if (wr == 1) PG8_BAR;
        PG8_WAIT_V(2); PG8_BAR;
        PG8_STAGE(PG8_SB(1, 0), cB + kstep, voffB); PG8_STAGE(PG8_SA(1, 0), cA + kstep, voffA); PG8_STAGE(PG8_SB(1, 1), cB + kstep, voffB1);
        PG8_WAIT_V(6); PG8_BAR;
    } else {
    PG8_STAGE(PG8_SB(0, 0), cB, voffB); PG8_STAGE(PG8_SA(0, 0), cA, voffA); PG8_STAGE(PG8_SB(0, 1), cB, voffB1); PG8_STAGE(PG8_SA(0, 1), cA + hstep, voffA);
    if (wr == 1) PG8_BAR;
    PG8_WAIT_V(4); PG8_BAR;
    PG8_STAGE(PG8_SB(1, 0), cB + kstep, voffB); PG8_STAGE(PG8_SA(1, 0), cA + kstep, voffA); PG8_STAGE(PG8_SB(1, 1), cB + kstep, voffB1);
    PG8_WAIT_V(6); PG8_BAR;
    }
    for (;;) {
        const bool has_next = S.next(ui + 1, nxt);
        const char* nA = has_next ? (const char*)g.A + (size_t)nxt.pm * tstep : cA; const char* nB = has_next ? (const char*)g.Bt + (size_t)nxt.pn * tstep : cB;
        for (int t = 0; t < nt; t += 2) {
            const bool last = (t == nt - 2);
            const char* a1 = cA + (size_t)(t + 1) * kstep;
            const char* a2 = last ? nA : cA + (size_t)(t + 2) * kstep; const char* b2 = last ? nB : cB + (size_t)(t + 2) * kstep;
            const char* a3 = a2 + kstep; const char* b3 = b2 + kstep;
            if constexpr (SP2) {
            PG8_LDB(B0, 0, 0); PG8_LDB(B1, 0, 1); PG8_SCHED; PG8_LDA(At, 0, 0); PG8_STAGE(PG8_SA(1, 1), a1 + hstep, voffA);
            PG8_WAIT_V(8); PG8_WAIT_L(0); PG8_BAR; PG8_MMA(0, 0, At, B0); PG8_MMA(0, 1, At, B1); PG8_BAR; PG8_SCHED;
            PG8_LDA(At, 0, 1); PG8_STAGE(PG8_SB(0, 0), b2, voffB); PG8_STAGE(PG8_SB(0, 1), b2, voffB1); PG8_STAGE(PG8_SA(0, 0), a2, voffA);
            PG8_WAIT_V(8); PG8_WAIT_L(0); PG8_BAR; PG8_MMA(1, 0, At, B0); PG8_MMA(1, 1, At, B1); PG8_BAR; PG8_SCHED;
            PG8_LDB(B0, 1, 0); PG8_LDB(B1, 1, 1); PG8_SCHED; PG8_LDA(At, 1, 0); PG8_STAGE(PG8_SA(0, 1), a2 + hstep, voffA);
            PG8_WAIT_V(8); PG8_WAIT_L(0); PG8_BAR; PG8_MMA(0, 0, At, B0); PG8_MMA(0, 1, At, B1); PG8_BAR; PG8_SCHED;
            PG8_LDA(At, 1, 1); PG8_STAGE(PG8_SB(1, 0), b3, voffB); PG8_STAGE(PG8_SB(1, 1), b3, voffB1); PG8_STAGE(PG8_SA(1, 0), a3, voffA);
            PG8_WAIT_V(8); PG8_WAIT_L(0); PG8_BAR; PG8_MMA(1, 0, At, B0); PG8_MMA(1, 1, At, B1); PG8_BAR; PG8_SCHED;
            } else {
            PG8_LDB(B0, 0, 0); PG8_SCHED; PG8_LDA(At, 0, 0); PG8_STAGE(PG8_SA(1, 1), a1 + hstep, voffA);
            PG8_WAIT_L(8); PG8_BAR; PG8_WAIT_L(0); PG8_MMA(0, 0, At, B0); PG8_BAR; PG8_SCHED;
            PG8_LDB(B1, 0, 1); PG8_STAGE(PG8_SB(0, 0), b2, voffB);
            PG8_BAR; PG8_WAIT_L(0); PG8_MMA(0, 1, At, B1); PG8_BAR;
            PG8_LDA(At, 0, 1); PG8_STAGE(PG8_SA(0, 0), a2, voffA);
            PG8_BAR; PG8_WAIT_L(0); PG8_MMA(1, 0, At, B0); PG8_BAR; PG8_SCHED;
            PG8_STAGE(PG8_SB(0, 1), b2, voffB1);
            PG8_WAIT_V(6); PG8_BAR; PG8_MMA(1, 1, At, B1); PG8_BAR;
            PG8_LDB(B0, 1, 0); PG8_SCHED; PG8_LDA(At, 1, 0); PG8_STAGE(PG8_SA(0, 1), a2 + hstep, voffA);
            PG8_WAIT_L(8); PG8_BAR; PG8_WAIT_L(0); PG8_MMA(0, 0, At, B0); PG8_BAR; PG8_SCHED;
            PG8_LDB(B1, 1, 1); PG8_STAGE(PG8_SB(1, 0), b3, voffB);
            PG8_BAR; PG8_WAIT_L(0); PG8_MMA(0, 1, At, B1); PG8_BAR;
            PG8_LDA(At, 1, 1); PG8_STAGE(PG8_SA(1, 0), a3, voffA);
            PG8_BAR; PG8_WAIT_L(0); PG8_MMA(1, 0, At, B0); PG8_BAR; PG8_SCHED;
            PG8_STAGE(PG8_SB(1, 1), b3, voffB1);
            PG8_WAIT_V(6); PG8_BAR; PG8_MMA(1, 1, At, B1); PG8_BAR;
            }
        }
        if constexpr (ALIGN_EPI) { if (wr == 0) PG8_BAR; }
        if constexpr (!Epi::AFTER_DRAIN) E(acc, cur, wr, wc, fr, fq);
        if (!has_next) break;
#pragma unroll
        for (int a = 0; a < 2; ++a)
#pragma unroll
            for (int b = 0; b < 2; ++b)
#pragma unroll
                for (int m = 0; m < 4; ++m)
#pragma unroll
                    for (int n = 0; n < 2; ++n) acc[a][b][m][n] = (f32x4){0.f, 0.f, 0.f, 0.f};
        cur = nxt; cA = nA; cB = nB; ++ui;
        if constexpr (ALIGN_EPI) { if (wr == 1) PG8_BAR; }
    }
    PG8_WAIT_V(0);
    if constexpr (!ALIGN_EPI) { if (wr == 0) PG8_BAR; }
    PG8_BAR;
    if constexpr (Epi::AFTER_DRAIN) E.fused(acc, cur, wr, wc, fr, fq, lds, wid, lane);
#undef PG8_SA
#undef PG8_SB
#undef PG8_STAGE
#undef PG8_LDA
#undef PG8_LDB
#undef PG8_MMA
#undef PG8_WAIT_V
#undef PG8_WAIT_L
#undef PG8_BAR
#undef PG8_SCHED
}


#define XB_TMO      128
#define XB_XCNT(j)  (256  + 64 * (j))
#define XB_XSUB(j)  (1280 + 64 * (j))
#define XB_XGEN(j)  (2304 + 64 * (j))
#define XB_TOP      3328
#define XB_TOPGEN   3392
#define XCD_BAR_WORDS 3456
#define XB_SPIN_CAP (1u << 18)
__device__ __forceinline__ unsigned xb_ld(unsigned* p)              { return __hip_atomic_load(p, __ATOMIC_RELAXED, __HIP_MEMORY_SCOPE_AGENT); }
__device__ __forceinline__ unsigned xb_add(unsigned* p, unsigned v) { return __hip_atomic_fetch_add(p, v, __ATOMIC_RELAXED, __HIP_MEMORY_SCOPE_AGENT); }
__device__ __forceinline__ unsigned xb_xcc_id() { return (unsigned)__builtin_amdgcn_s_getreg((3 << 11) | 20) & 0xFu; }
#define XB_SPIN(cond, bar) do { unsigned _sp = 0; while (cond) { __builtin_amdgcn_s_sleep(1); \
    if ((++_sp & 255u) == 0u) { if (xb_ld(&(bar)[XB_TMO])) break; if (_sp > XB_SPIN_CAP) { atomicAdd(&(bar)[XB_TMO], 1u); break; } } } } while (0)
struct XcdBarrier { unsigned* bar; unsigned x; volatile LAS unsigned* st; };
__device__ __forceinline__ XcdBarrier xcd_barrier_post(unsigned* bar, volatile LAS unsigned* st) {
    XcdBarrier b; b.bar = bar; b.x = xb_xcc_id(); b.st = st;
    if (threadIdx.x == 0) (void)xb_add(&bar[XB_XCNT(b.x)], 1u);
    return b;
}
__device__ __forceinline__ void xcd_barrier_complete(unsigned* bar, unsigned x, unsigned& nloc, unsigned& nx) {
    const unsigned G = gridDim.x * gridDim.y * gridDim.z;
    unsigned sum, cnt, mine, sp = 0u;
    for (;;) {
        sum = 0u; cnt = 0u; mine = 0u;
#pragma unroll
        for (unsigned j = 0; j < 16; ++j) { const unsigned c = xb_ld(&bar[XB_XCNT(j)]); sum += c; cnt += (c > 0u) ? 1u : 0u; mine = (j == x) ? c : mine; }
        if (sum == G) break;
        __builtin_amdgcn_s_sleep(1);
        if ((++sp & 255u) == 0u) { if (xb_ld(&bar[XB_TMO])) break; if (sp > XB_SPIN_CAP) { atomicAdd(&bar[XB_TMO], 1u); break; } }
    }
    nloc = mine > 0u ? mine : 1u; nx = cnt > 0u ? cnt : 1u;
}
__device__ __forceinline__ void xcd_barrier(const XcdBarrier& b) {
    asm volatile("s_waitcnt vmcnt(0)" ::: "memory");
    __syncthreads();
    if (threadIdx.x == 0) {
        unsigned* bar = b.bar;
        const unsigned bx = xb_xcc_id();
        __builtin_amdgcn_s_waitcnt(0);
        unsigned nloc = b.st[0], nx = b.st[1];
        if (nloc == 0u) { xcd_barrier_complete(bar, bx, nloc, nx); b.st[0] = nloc; b.st[1] = nx; }
        const unsigned old = xb_add(&bar[XB_XSUB(bx)], 1u);
        const unsigned gen = old / nloc;
        if (old + 1u == (gen + 1u) * nloc) {
            __builtin_amdgcn_fence(__ATOMIC_RELEASE, "agent");
            asm volatile("s_waitcnt vmcnt(0)" ::: "memory");
            const unsigned og = xb_add(&bar[XB_TOP], 1u);
            const unsigned tg = og / nx;
            if (og + 1u == (tg + 1u) * nx) xb_add(&bar[XB_TOPGEN], 1u);
            else XB_SPIN(xb_ld(&bar[XB_TOPGEN]) == tg, bar);
            __builtin_amdgcn_fence(__ATOMIC_ACQUIRE, "agent");
            xb_add(&bar[XB_XGEN(bx)], 1u);
            asm volatile("s_waitcnt vmcnt(0)" ::: "memory");
        } else {
            XB_SPIN(xb_ld(&bar[XB_XGEN(bx)]) == gen, bar);
            __builtin_amdgcn_fence(__ATOMIC_ACQUIRE, "agent");
            asm volatile("s_waitcnt vmcnt(0)" ::: "memory");
        }
    }
    __syncthreads();
}

template <bool F16 = false>
__device__ __forceinline__ void tp_job(const float* src, size_t smat, int lsrc, int coff, bf16_t* dst, size_t dmat, int ldd, int R, int C, int nmat, LAS float* scr) {
    const int tid = opaque(threadIdx.x);
    const int ntc = C / 64, per = (R / 64) * ntc, total = per * nmat;
    const int G = gridDim.x;
    f32x4 v[2];
    int t = blockIdx.x;
#define TP_LOAD(tt_) do { const int i_ = (tt_) / per, t2_ = (tt_) % per, tr_ = t2_ / ntc, tc_ = t2_ % ntc; const float* s_ = src + (size_t)i_ * smat + coff; \
        _Pragma("unroll") for (int k_ = 0; k_ < 2; ++k_) { const int idx_ = tid + 512 * k_, row_ = idx_ >> 4, c4_ = idx_ & 15; v[k_] = *(const f32x4*)(s_ + (size_t)(tr_ * 64 + row_) * lsrc + tc_ * 64 + c4_ * 4); } } while (0)
    if (t < total) TP_LOAD(t);
#pragma unroll 1
    for (; t < total; t += G) {
#pragma unroll
        for (int k = 0; k < 2; ++k) { const int idx = tid + 512 * k, row = idx >> 4, c4 = idx & 15; LAS float* pp = scr + row * 65 + c4 * 4; pp[0] = v[k][0]; pp[1] = v[k][1]; pp[2] = v[k][2]; pp[3] = v[k][3]; }
        if (t + G < total) TP_LOAD(t + G);
        __syncthreads();
        { const int i = t / per, t2 = t % per, tr = t2 / ntc, tc = t2 % ntc; bf16_t* d = dst + (size_t)i * dmat;
          const int c = tid >> 3, ch = tid & 7; const LAS float* sp = scr + (ch * 8) * 65 + c;
          u32x4 o; o.x = cvt_pk16<F16>(sp[0], sp[65]); o.y = cvt_pk16<F16>(sp[2 * 65], sp[3 * 65]); o.z = cvt_pk16<F16>(sp[4 * 65], sp[5 * 65]); o.w = cvt_pk16<F16>(sp[6 * 65], sp[7 * 65]);
          *(u32x4*)(d + (size_t)(tc * 64 + c) * ldd + tr * 64 + ch * 8) = o; }
        __syncthreads();
    }
#undef TP_LOAD
}

struct Params {
    const float *x, *w_in_a, *w_grp_a, *scale_a, *w_out_a, *w_kv, *w_in_b, *w_out_b, *ln_g, *ln_b;
    float* out; unsigned char* ws;
};

__device__ __forceinline__ void phase_prepA(const Params& p, LAS unsigned char* lds) {
    LAS float* scr = (LAS float*)lds;
    unsigned char* ws = p.ws;
    tp_job<true>(p.w_grp_a, (size_t)512 * 512, 512, 0, (bf16_t*)(ws + OFF_WGT), (size_t)512 * 512, 512, 512, 512, 8, scr);
    { bf16_t* winu = (bf16_t*)(ws + OFF_WINU);
      const int total = 2 * 4 * 1024 * 64;
      const int tid = opaque(threadIdx.x);
#pragma unroll 1
      for (int i0 = blockIdx.x * 512 + tid; i0 < total; i0 += gridDim.x * 512 * 4) {
          f32x4 a[4], b[4];
#pragma unroll
          for (int u = 0; u < 4; ++u) { const int i = i0 + u * gridDim.x * 512; if (i < total) { const int c8 = i & 63, k = (i >> 6) & 1023, lg = i >> 16, l = lg >> 2, g = lg & 3;
              const float* s = p.w_in_a + ((size_t)l * 1024 + k) * 4096 + g * 512 + c8 * 8; a[u] = *(const f32x4*)s; b[u] = *(const f32x4*)(s + 4); } }
#pragma unroll
          for (int u = 0; u < 4; ++u) { const int i = i0 + u * gridDim.x * 512; if (i < total) {
              u32x4 o; o.x = cvt_pk_f16(a[u][0], a[u][1]); o.y = cvt_pk_f16(a[u][2], a[u][3]); o.z = cvt_pk_f16(b[u][0], b[u][1]); o.w = cvt_pk_f16(b[u][2], b[u][3]);
              *(u32x4*)(winu + (size_t)i * 8) = o; } } } }
}
__device__ __forceinline__ void phase_prepB(const Params& p, LAS unsigned char* lds) {
    LAS float* scr = (LAS float*)lds;
    unsigned char* ws = p.ws;
    tp_job<true>(p.w_in_a, (size_t)1024 * 4096, 4096, 2048, (bf16_t*)(ws + OFF_BTA) + (size_t)2048 * 1024, (size_t)4096 * 1024, 1024, 1024, 2048, 2, scr);
    tp_job(p.w_out_a, (size_t)2048 * 1024, 1024, 0, (bf16_t*)(ws + OFF_WOA), (size_t)1024 * 2048, 2048, 2048, 1024, 2, scr);
    tp_job<true>(p.w_kv, 0, 6144, 0, (bf16_t*)(ws + OFF_KVT), 0, 1024, 1024, 6144, 1, scr);
    tp_job<true>(p.w_in_b, (size_t)1024 * 4096, 4096, 0, (bf16_t*)(ws + OFF_INB), (size_t)4096 * 1024, 1024, 1024, 4096, 2, scr);
    { bf16_t* hb = (bf16_t*)(ws + OFF_HB);
      const int total = MT * DM / 8;
      const int tid = opaque(threadIdx.x);
      const int nb_ = (int)gridDim.x - 64;
      if (blockIdx.x >= 64)
#pragma unroll 1
      for (int i0 = ((int)blockIdx.x - 64) * 512 + tid; i0 < total; i0 += nb_ * 512 * 4) {
          f32x4 a[4], b[4];
#pragma unroll
          for (int u = 0; u < 4; ++u) { const int i = i0 + u * nb_ * 512; if (i < total) { const float* s = p.x + (size_t)i * 8; a[u] = *(const f32x4*)s; b[u] = *(const f32x4*)(s + 4); } }
#pragma unroll
          for (int u = 0; u < 4; ++u) { const int i = i0 + u * nb_ * 512; if (i < total) {
              u32x4 o; o.x = cvt_pk_f16(a[u][0], a[u][1]); o.y = cvt_pk_f16(a[u][2], a[u][3]); o.z = cvt_pk_f16(b[u][0], b[u][1]); o.w = cvt_pk_f16(b[u][2], b[u][3]);
              *(u32x4*)(hb + (size_t)i * 8) = o; } } } }
}

__device__ __forceinline__ void unpack8(const u32x4 w, float (&f)[8]) { f[0] = bf_lo(w.x); f[1] = bf_hi(w.x); f[2] = bf_lo(w.y); f[3] = bf_hi(w.y); f[4] = bf_lo(w.z); f[5] = bf_hi(w.z); f[6] = bf_lo(w.w); f[7] = bf_hi(w.w); }
template <int W>
__device__ __forceinline__ void pool_item(const bf16_t* V, bf16_t* SG, const float (&sc)[8], int t0, int c0) {
    const int s0 = t0 & (SEQ - 1);
    u32x4 rows[W + 3], gts[4];
#pragma unroll
    for (int j = 0; j < W + 3; ++j) { const int dt = j - (W - 1); rows[j] = (u32x4){0u, 0u, 0u, 0u}; if (s0 + dt >= 0) rows[j] = *(const u32x4*)(V + (size_t)(t0 + dt) * 2048 + c0); }
#pragma unroll
    for (int i = 0; i < 4; ++i) gts[i] = *(const u32x4*)(SG + (size_t)(t0 + i) * 2048 + c0);
    float sum[8];
#pragma unroll
    for (int j = 0; j < 8; ++j) sum[j] = 0.f;
#pragma unroll
    for (int j = 0; j < W - 1; ++j) { float f[8]; unpack8(rows[j], f);
#pragma unroll
        for (int k = 0; k < 8; ++k) sum[k] += f[k]; }
#pragma unroll
    for (int i = 0; i < 4; ++i) {
        float f[8], gt[8]; unpack8(rows[W - 1 + i], f); unpack8(gts[i], gt);
#pragma unroll
        for (int k = 0; k < 8; ++k) sum[k] += f[k];
        const int s = s0 + i; const float inv = 1.0f / (float)(s + 1 < W ? s + 1 : W);
        float o[8];
#pragma unroll
        for (int k = 0; k < 8; ++k) o[k] = (sum[k] * inv - f[k]) * sc[k] * gt[k];
        u32x4 wv; wv.x = cvt_pk_bf16(o[0], o[1]); wv.y = cvt_pk_bf16(o[2], o[3]); wv.z = cvt_pk_bf16(o[4], o[5]); wv.w = cvt_pk_bf16(o[6], o[7]);
        *(u32x4*)(SG + (size_t)(t0 + i) * 2048 + c0) = wv;
        float fo[8]; unpack8(rows[i], fo);
#pragma unroll
        for (int k = 0; k < 8; ++k) sum[k] -= fo[k];
    }
}
__device__ __forceinline__ void phase_pool(const bf16_t* V, bf16_t* SG, const float* scale) {
    const int tid = opaque(threadIdx.x), cth = tid & 255, sub = tid >> 8;
    const int c0 = cth * 8, grp = c0 >> 9;
    float sc[8];
    { const f32x4 a = *(const f32x4*)(scale + c0), b = *(const f32x4*)(scale + c0 + 4); sc[0] = a[0]; sc[1] = a[1]; sc[2] = a[2]; sc[3] = a[3]; sc[4] = b[0]; sc[5] = b[1]; sc[6] = b[2]; sc[7] = b[3]; }
#pragma unroll 1
    for (int q = blockIdx.x * 2 + sub; q < MT / 4; q += gridDim.x * 2) {
        const int t0 = q * 4;
        if (grp == 0) pool_item<2>(V, SG, sc, t0, c0);
        else if (grp == 1) pool_item<4>(V, SG, sc, t0, c0);
        else if (grp == 2) pool_item<8>(V, SG, sc, t0, c0);
        else pool_item<16>(V, SG, sc, t0, c0);
    }
}

template <int V_> struct AttIC { static constexpr int value = V_; };
struct AttGeo { int dsh, dil, L, nblk, g; };
__device__ __forceinline__ void att_decode(const AttGeo& G_, int it, int& hh, int& b, int& r, int& n) { n = it & (G_.nblk - 1); const int y = it >> (5 - G_.dsh); r = y & (G_.dil - 1); const int z = y >> G_.dsh; b = z & 3; hh = z >> 2; }
__device__ __forceinline__ void att_dma_half(const AttGeo& G_, const bf16_t* Kr, const bf16_t* Vt, int it, int which, int slot, LAS unsigned char* lds, int wid, int lane0) {
    int hh, b, r, n; att_decode(G_, it, hh, b, r, n);
    const int lane = opaque(lane0);
    int blk = n - 1 + which; blk = blk < 0 ? 0 : blk;
    const bf16_t* kb = Kr + ((size_t)(((G_.g * 16 + hh) * 4 + b) * SEQ + r * G_.L + blk * 128)) * 64;
    const bf16_t* vb = Vt + (size_t)(G_.g * 1024 + hh * 64) * MT + b * SEQ + r * G_.L + blk * 128;
    LAS unsigned char* kl = lds + slot * 32768; LAS unsigned char* vl = kl + 16384;
#pragma unroll
    for (int rd = 0; rd < 2; ++rd) { const int ch = rd * 8 + wid; const int rho = ch * 8 + (lane >> 3); const int cs = (lane & 7) ^ ((rho >> 1) & 7);
        __builtin_amdgcn_global_load_lds((const unsigned*)(kb + (size_t)rho * 64 + cs * 8), (LAS unsigned*)(kl + ch * 1024), 16, 0, 0); }
#pragma unroll
    for (int rd = 0; rd < 2; ++rd) { const int ch = rd * 8 + wid; const int d = ch * 4 + (lane >> 4); const int cs = (lane & 15) ^ (d & 15);
        __builtin_amdgcn_global_load_lds((const unsigned*)(vb + (size_t)d * MT + cs * 8), (LAS unsigned*)(vl + ch * 1024), 16, 0, 0); }
}
__device__ __forceinline__ int att_first_item() { return ((blockIdx.x & 7) * 32 + (blockIdx.x >> 3)) * 8; }
__device__ __forceinline__ void attn_issue_first(const bf16_t* Kr, const bf16_t* Vt, int g, LAS unsigned char* lds) {
    const int tid = opaque(threadIdx.x), wid = __builtin_amdgcn_readfirstlane(tid >> 6), lane0 = tid & 63;
    AttGeo G_; G_.g = g; G_.dsh = 2 * g; G_.dil = 1 << G_.dsh; G_.L = SEQ >> G_.dsh; G_.nblk = G_.L >> 7;
    const int it = att_first_item();
    att_dma_half(G_, Kr, Vt, it, 0, 3, lds, wid, lane0);
    att_dma_half(G_, Kr, Vt, it, 1, 0, lds, wid, lane0);
}
template <bool PRE>
__device__ __forceinline__ void phase_attn(const bf16_t* Q, const bf16_t* Kr, const bf16_t* Vt, bf16_t* ACC, float* LSE, int g, LAS unsigned char* lds) {
    const int tid = opaque(threadIdx.x), wid = __builtin_amdgcn_readfirstlane(tid >> 6), lane0 = tid & 63, q0 = lane0 & 15, q40 = lane0 >> 4;
    AttGeo G_; G_.g = g; G_.dsh = 2 * g; G_.dil = 1 << G_.dsh; G_.L = SEQ >> G_.dsh; G_.nblk = G_.L >> 7;
    const int dsh = G_.dsh, dil = G_.dil;
    const int it0 = att_first_item();
    bf16x8 qf[2]; u32x2 oldacc[4]; float oldlse = 0.f; int tq = 0, hh = 0, n = 0;
    {
        if constexpr (!PRE) { att_dma_half(G_, Kr, Vt, it0, 0, 3, lds, wid, lane0); att_dma_half(G_, Kr, Vt, it0, 1, 0, lds, wid, lane0); }
        int b, r; att_decode(G_, it0, hh, b, r, n);
        tq = b * SEQ + ((n * 128 + wid * 16 + q0) << dsh) + r;
#pragma unroll
        for (int ks = 0; ks < 2; ++ks) qf[ks] = *(const bf16x8*)(Q + (size_t)tq * 1024 + hh * 64 + ks * 32 + q40 * 8);
        if (g > 0) { oldlse = LSE[(size_t)tq * 16 + hh];
#pragma unroll
            for (int dt = 0; dt < 4; ++dt) oldacc[dt] = *(const u32x2*)(ACC + (size_t)tq * 1024 + hh * 64 + q40 * 4 + dt * 16); }
    }
    u32x2 pend[4]; float pend_lse = 0.f; int pend_tq = 0, pend_hh = 0; bool have_pend = false;
    auto item_body = [&](auto kkc, int k) __attribute__((always_inline)) {
        constexpr int KK = decltype(kkc)::value;
        constexpr int SC = KK, SP = (KK + 3) & 3, SN = (KK + 1) & 3;
        asm volatile("s_waitcnt vmcnt(0)" ::: "memory");
        __builtin_amdgcn_s_barrier();
        asm volatile("" ::: "memory");
        asm volatile("" : "+v"(qf[0]), "+v"(qf[1]), "+v"(oldacc[0]), "+v"(oldacc[1]), "+v"(oldacc[2]), "+v"(oldacc[3]), "+v"(oldlse));
        if (have_pend) {
            bf16_t* pp = ACC + (size_t)pend_tq * 1024 + pend_hh * 64 + q40 * 4;
#pragma unroll
            for (int dt = 0; dt < 4; ++dt) *(u32x2*)(pp + dt * 16) = pend[dt];
            if (q40 == 0) LSE[(size_t)pend_tq * 16 + pend_hh] = pend_lse;
        }
        const int q = opaque(q0), q4 = opaque(q40);
        bf16x8 qn[2]; u32x2 oldn[4]; float oldlsen = 0.f; int tqn = 0, hhn = 0, nn = 0;
        if (k + 1 < 8) {
            const int itn = it0 + k + 1;
            att_dma_half(G_, Kr, Vt, itn, 1, SN, lds, wid, lane0);
            int b, r; att_decode(G_, itn, hhn, b, r, nn);
            tqn = b * SEQ + ((nn * 128 + wid * 16 + q) << dsh) + r;
#pragma unroll
            for (int ks = 0; ks < 2; ++ks) qn[ks] = *(const bf16x8*)(Q + (size_t)tqn * 1024 + hhn * 64 + ks * 32 + q4 * 8);
            if (g > 0) { oldlsen = LSE[(size_t)tqn * 16 + hhn];
#pragma unroll
                for (int dt = 0; dt < 4; ++dt) oldn[dt] = *(const u32x2*)(ACC + (size_t)tqn * 1024 + hhn * 64 + q4 * 4 + dt * 16); }
        }
        const float slope = __builtin_amdgcn_exp2f(-8.0f * (float)(g * 16 + hh + 1) / 48.0f);
        const float bias2 = slope * (float)dil * LOG2E;
        f32x4 sacc[9];
        {
            bf16x8 kf[9][2];
#pragma unroll
            for (int kt = 0; kt < 9; ++kt) { const int t16 = wid + kt; const int rl = (t16 & 7) * 16 + q, sw = (rl >> 1) & 7;
                const LAS unsigned char* kb_ = (t16 >= 8) ? (lds + SC * 32768) : (lds + SP * 32768);
                kf[kt][0] = *(const LAS bf16x8*)(kb_ + rl * 128 + ((q4 ^ sw) * 16));
                kf[kt][1] = *(const LAS bf16x8*)(kb_ + rl * 128 + (((4 + q4) ^ sw) * 16)); }
            asm volatile("" : "+v"(kf[0][0]), "+v"(kf[0][1]), "+v"(kf[1][0]), "+v"(kf[1][1]), "+v"(kf[2][0]), "+v"(kf[2][1]), "+v"(kf[3][0]), "+v"(kf[3][1]), "+v"(kf[4][0]), "+v"(kf[4][1]));
            asm volatile("" : "+v"(kf[5][0]), "+v"(kf[5][1]), "+v"(kf[6][0]), "+v"(kf[6][1]), "+v"(kf[7][0]), "+v"(kf[7][1]), "+v"(kf[8][0]), "+v"(kf[8][1]));
#pragma unroll
            for (int kt = 0; kt < 9; ++kt) { f32x4 a = (f32x4){0.f, 0.f, 0.f, 0.f};
                a = __builtin_amdgcn_mfma_f32_16x16x32_bf16(kf[kt][0], qf[0], a, 0, 0, 0);
                sacc[kt] = a; }
#pragma unroll
            for (int kt = 0; kt < 9; ++kt) sacc[kt] = __builtin_amdgcn_mfma_f32_16x16x32_bf16(kf[kt][1], qf[1], sacc[kt], 0, 0, 0);
        }
        const float relb = (float)(128 + q - q4 * 4);
        const float a0 = -bias2 * relb;
        float mx = -1e30f;
#pragma unroll
        for (int kt = 0; kt < 9; ++kt)
#pragma unroll
            for (int jj = 0; jj < 4; ++jj) {
                float s = __builtin_fmaf(sacc[kt][jj], 0.125f * LOG2E, __builtin_fmaf(bias2, (float)(kt * 16 + jj), a0));
                if (kt == 0) { if (q4 * 4 + jj < q) s = -1e30f; }
                if (kt == 8) { if (q4 * 4 + jj > q) s = -1e30f; }
                sacc[kt][jj] = s; }
        if (n == 0) {
#pragma unroll
            for (int kt = 0; kt < 8; ++kt)
#pragma unroll
                for (int jj = 0; jj < 4; ++jj) if (wid * 16 + kt * 16 + q4 * 4 + jj < 128) sacc[kt][jj] = -1e30f;
        }
#pragma unroll
        for (int kt = 0; kt < 9; ++kt)
#pragma unroll
            for (int jj = 0; jj < 4; ++jj) mx = fmaxf(mx, sacc[kt][jj]);
        mx = fmaxf(mx, __shfl_xor(mx, 16)); mx = fmaxf(mx, __shfl_xor(mx, 32));
        float lsum = 0.f;
#pragma unroll
        for (int kt = 0; kt < 9; ++kt)
#pragma unroll
            for (int jj = 0; jj < 4; ++jj) { const float pv = __builtin_amdgcn_exp2f(sacc[kt][jj] - mx); sacc[kt][jj] = pv; lsum += pv; }
        lsum += __shfl_xor(lsum, 16); lsum += __shfl_xor(lsum, 32);
        f32x4 oacc[4];
#pragma unroll
        for (int dt = 0; dt < 4; ++dt) oacc[dt] = (f32x4){0.f, 0.f, 0.f, 0.f};
#pragma unroll
        for (int kp2 = 0; kp2 < 5; ++kp2) {
            u32x4 pw; pw.x = cvt_pk_bf16(sacc[2 * kp2][0], sacc[2 * kp2][1]); pw.y = cvt_pk_bf16(sacc[2 * kp2][2], sacc[2 * kp2][3]);
            if (kp2 < 4) { pw.z = cvt_pk_bf16(sacc[kp2 < 4 ? 2 * kp2 + 1 : 8][0], sacc[kp2 < 4 ? 2 * kp2 + 1 : 8][1]); pw.w = cvt_pk_bf16(sacc[kp2 < 4 ? 2 * kp2 + 1 : 8][2], sacc[kp2 < 4 ? 2 * kp2 + 1 : 8][3]); }
            else { pw.z = 0u; pw.w = 0u; }
            bf16x8 pf; __builtin_memcpy(&pf, &pw, 16);
            const int chb = 2 * wid + 4 * kp2;
            const LAS unsigned char* v0b = ((chb >> 4) ? (lds + SC * 32768) : (lds + SP * 32768)) + 16384;
            const LAS unsigned char* v1b = (((chb + 2) >> 4) ? (lds + SC * 32768) : (lds + SP * 32768)) + 16384;
            const int c0 = (chb & 15) + (q4 >> 1), c1 = ((chb + 2) & 15) + (q4 >> 1);
#pragma unroll
            for (int dt = 0; dt < 4; ++dt) {
                const int d = dt * 16 + q;
                const int roff = d * 256 + (q4 & 1) * 8;
                u32x4 vw; const u32x2 lo = *(const LAS u32x2*)(v0b + roff + ((c0 ^ q) * 16)); vw.x = lo.x; vw.y = lo.y;
                if (kp2 < 4) { const u32x2 hi = *(const LAS u32x2*)(v1b + roff + ((c1 ^ q) * 16)); vw.z = hi.x; vw.w = hi.y; } else { vw.z = 0u; vw.w = 0u; }
                bf16x8 vf; __builtin_memcpy(&vf, &vw, 16);
                oacc[dt] = __builtin_amdgcn_mfma_f32_16x16x32_bf16(vf, pf, oacc[dt], 0, 0, 0);
            }
            __builtin_amdgcn_sched_barrier(0);
        }
        const float inv = 1.0f / lsum;
        float lse = (mx + __log2f(lsum)) * LN2;
        float w_new = inv, w_old = 0.f;
        if (g > 0) {
            const float mm = fmaxf(oldlse, lse), e0 = __expf(oldlse - mm), e1 = __expf(lse - mm), tot = e0 + e1;
            w_old = e0 / tot; w_new = inv * (e1 / tot); lse = mm + __logf(tot);
        }
#pragma unroll
        for (int dt = 0; dt < 4; ++dt) {
            f32x4 o = oacc[dt] * w_new;
            if (g > 0) { const u32x2 pr = oldacc[dt]; o[0] += w_old * bf_lo(pr.x); o[1] += w_old * bf_hi(pr.x); o[2] += w_old * bf_lo(pr.y); o[3] += w_old * bf_hi(pr.y); }
            u32x2 w; w.x = cvt_pk_bf16(o[0], o[1]); w.y = cvt_pk_bf16(o[2], o[3]);
            pend[dt] = w;
        }
        pend_lse = lse; pend_tq = tq; pend_hh = hh; have_pend = true;
        qf[0] = qn[0]; qf[1] = qn[1]; oldlse = oldlsen; tq = tqn; hh = hhn; n = nn;
#pragma unroll
        for (int dt = 0; dt < 4; ++dt) oldacc[dt] = oldn[dt];
    };
#pragma unroll 1
    for (int kq = 0; kq < 2; ++kq) { item_body(AttIC<0>{}, 4 * kq); item_body(AttIC<1>{}, 4 * kq + 1); item_body(AttIC<2>{}, 4 * kq + 2); item_body(AttIC<3>{}, 4 * kq + 3); }
    if (have_pend) {
        bf16_t* pp = ACC + (size_t)pend_tq * 1024 + pend_hh * 64 + q40 * 4;
#pragma unroll
        for (int dt = 0; dt < 4; ++dt) *(u32x2*)(pp + dt * 16) = pend[dt];
        if (q40 == 0) LSE[(size_t)pend_tq * 16 + pend_hh] = pend_lse;
    }
    asm volatile("s_waitcnt vmcnt(0)" ::: "memory");
    __builtin_amdgcn_s_barrier();
}

__global__ void __launch_bounds__(512, 2) yoco_fwd(Params p) {
    extern __shared__ __attribute__((aligned(16))) unsigned char smem[];
    LAS unsigned char* lds = (LAS unsigned char*)smem;
    cg::grid_group grid = cg::this_grid();
    volatile LAS unsigned* xst = (volatile LAS unsigned*)(lds + 131072);
    if (threadIdx.x < 4) xst[threadIdx.x] = 0u;
    __syncthreads();
    const XcdBarrier xb = xcd_barrier_post((unsigned*)(p.ws + OFF_BAR), xst);
    if (p.ws == nullptr) grid.sync();
    unsigned char* ws = p.ws;
    const int G = gridDim.x, c = blockIdx.x;
    bf16_t* HB = (bf16_t*)(ws + OFF_HB);

    phase_prepA(p, lds);
    xcd_barrier(xb);
    { SingleUnit S; S.has = c < 64; const int lg = c >> 3, un = c & 7; S.u0.pm = un >> 2; S.u0.pn = un & 3;
      Gemm gm; gm.A = (const bf16_t*)(ws + OFF_WGT) + (size_t)lg * 512 * 512; gm.Bt = (const bf16_t*)(ws + OFF_WINU) + (size_t)lg * 1024 * 512; gm.M = 512; gm.N = 1024; gm.K = 512;
      EpiStore16<true> E; E.O = (bf16_t*)(ws + OFF_BTA) + (size_t)(lg >> 2) * 4096 * 1024 + (size_t)(lg & 3) * 512 * 1024; E.ldc = 1024;
      gemm_phase<EpiStore16<true>, SingleUnit, 0, true>(lds, gm, S, E); }
    phase_prepB(p, lds);
    xcd_barrier(xb);
    for (int l = 0; l < 2; ++l) {
        { StaticOrder S; S.init(MT, 4096, G, c); Gemm gm; gm.A = HB; gm.Bt = (const bf16_t*)(ws + OFF_BTA) + (size_t)l * 4096 * 1024; gm.M = MT; gm.N = 4096; gm.K = 1024;
          EpiAG1 E; E.V = (bf16_t*)(ws + OFF_V); E.SG = (bf16_t*)(ws + OFF_SG); gemm_phase<EpiAG1, StaticOrder, 0, true>(lds, gm, S, E); }
        xcd_barrier(xb);
        phase_pool((const bf16_t*)(ws + OFF_V), (bf16_t*)(ws + OFF_SG), p.scale_a + l * 2048);
        xcd_barrier(xb);
        { StaticOrder S; S.init(MT, 1024, G, c); Gemm gm; gm.A = (const bf16_t*)(ws + OFF_SG); gm.Bt = (const bf16_t*)(ws + OFF_WOA) + (size_t)l * 1024 * 2048; gm.M = MT; gm.N = 1024; gm.K = 2048;
          if (l == 0) { EpiLnFused<true, false, true, true> E; E.hin_f = p.x; E.hin_b = nullptr; E.out_f = nullptr; E.out_b = HB; E.gam = p.ln_g; E.bet = p.ln_b;
              E.xbuf = (unsigned long long*)(ws + OFF_XBUF); E.cnt = (unsigned*)(ws + OFF_CNT); E.want = 32u; gemm_phase(lds, gm, S, E); }
          else { EpiLnFused<false, false, true, true> E; E.hin_f = nullptr; E.hin_b = HB; E.out_f = nullptr; E.out_b = HB; E.gam = p.ln_g + DM; E.bet = p.ln_b + DM;
              E.xbuf = (unsigned long long*)(ws + OFF_XBUF); E.cnt = (unsigned*)(ws + OFF_CNT); E.want = 64u; gemm_phase(lds, gm, S, E); } }
        xcd_barrier(xb);
    }
    { StaticOrder S; S.init(MT, 3072, G, c); Gemm gm; gm.A = HB; gm.Bt = (const bf16_t*)(ws + OFF_KVT); gm.M = MT; gm.N = 3072; gm.K = 1024;
      EpiKr E; E.Kr = (bf16_t*)(ws + OFF_K); gemm_phase<EpiKr, StaticOrder, 0, true>(lds, gm, S, E); }
    { StaticOrder S; S.init(1024, MT, G, c); Gemm gm; gm.Bt = HB; gm.M = 1024; gm.N = MT; gm.K = 1024;
      gm.A = (const bf16_t*)(ws + OFF_KVT) + (size_t)(3072 + 0) * 1024;    { EpiVt<0> E; E.Vt = (bf16_t*)(ws + OFF_VT) + (size_t)0 * MT;    gemm_phase<EpiVt<0>, StaticOrder, 0, true>(lds, gm, S, E); }
      gm.A = (const bf16_t*)(ws + OFF_KVT) + (size_t)(3072 + 1024) * 1024; { EpiVt<2> E; E.Vt = (bf16_t*)(ws + OFF_VT) + (size_t)1024 * MT; gemm_phase<EpiVt<2>, StaticOrder, 2, true>(lds, gm, S, E); }
      gm.A = (const bf16_t*)(ws + OFF_KVT) + (size_t)(3072 + 2048) * 1024; { EpiVt<4> E; E.Vt = (bf16_t*)(ws + OFF_VT) + (size_t)2048 * MT; gemm_phase<EpiVt<4>, StaticOrder, 4, true>(lds, gm, S, E); } }
    bf16_t* QG = (bf16_t*)p.out; bf16_t* QY = (bf16_t*)p.out + (size_t)MT * DM; bf16_t* ACC = QG; float* LSE = (float*)(ws + OFF_LSE);
    for (int j = 0; j < 2; ++j) {
        const bf16_t* inb = (const bf16_t*)(ws + OFF_INB) + (size_t)j * 4096 * 1024;
        { StaticOrder S; S.init(MT, 2048, G, c); Gemm gm; gm.A = HB; gm.Bt = inb; gm.M = MT; gm.N = 2048; gm.K = 1024;
          EpiStoreSplit E; E.O0 = QG; E.O1 = QY; gemm_phase<EpiStoreSplit, StaticOrder, 0, true>(lds, gm, S, E); }
        if (j != 0) attn_issue_first((const bf16_t*)(ws + OFF_K), (const bf16_t*)(ws + OFF_VT), 0, lds);
        xcd_barrier(xb);
        if (j == 0) { tp_job(p.w_out_b, (size_t)1024 * 1024, 1024, 0, (bf16_t*)(ws + OFF_OUTB), (size_t)1024 * 1024, 1024, 1024, 1024, 2, (LAS float*)lds);
                      phase_attn<false>(QG, (const bf16_t*)(ws + OFF_K), (const bf16_t*)(ws + OFF_VT), QG, LSE, 0, lds); }
        else phase_attn<true>(QG, (const bf16_t*)(ws + OFF_K), (const bf16_t*)(ws + OFF_VT), QG, LSE, 0, lds);
        attn_issue_first((const bf16_t*)(ws + OFF_K), (const bf16_t*)(ws + OFF_VT), 1, lds);
        xcd_barrier(xb);
        phase_attn<true>(QY, (const bf16_t*)(ws + OFF_K), (const bf16_t*)(ws + OFF_VT), QG, LSE, 1, lds);
        xcd_barrier(xb);
        { StaticOrder S; S.init(MT, 1024, G, c); Gemm gm; gm.A = HB; gm.Bt = inb + (size_t)2 * 1024 * 1024; gm.M = MT; gm.N = 1024; gm.K = 1024;
          EpiStore16<false> E; E.O = QY; E.ldc = 1024; gemm_phase<EpiStore16<false>, StaticOrder, 0, true>(lds, gm, S, E); }
        attn_issue_first((const bf16_t*)(ws + OFF_K), (const bf16_t*)(ws + OFF_VT), 2, lds);
        xcd_barrier(xb);
        phase_attn<true>(QY, (const bf16_t*)(ws + OFF_K), (const bf16_t*)(ws + OFF_VT), QG, LSE, 2, lds);
        xcd_barrier(xb);
        bf16_t* ZB = j == 0 ? ACC : (bf16_t*)(ws + OFF_K);
        { StaticOrder S; S.init(MT, 1024, G, c); Gemm gm; gm.A = HB; gm.Bt = inb + (size_t)3 * 1024 * 1024; gm.M = MT; gm.N = 1024; gm.K = 1024;
          EpiGateMul E; E.Zin = ACC; E.Zout = ZB; gemm_phase<EpiGateMul, StaticOrder, 0, true>(lds, gm, S, E); }
        xcd_barrier(xb);
        { StaticOrder S; S.init(MT, 1024, G, c); Gemm gm; gm.A = ZB; gm.Bt = (const bf16_t*)(ws + OFF_OUTB) + (size_t)j * 1024 * 1024; gm.M = MT; gm.N = 1024; gm.K = 1024;
          if (j == 0) { EpiLnFused<false, false, true, true> E; E.hin_f = nullptr; E.hin_b = HB; E.out_f = nullptr; E.out_b = HB; E.gam = p.ln_g + 2 * DM; E.bet = p.ln_b + 2 * DM;
              E.xbuf = (unsigned long long*)(ws + OFF_XBUF); E.cnt = (unsigned*)(ws + OFF_CNT); E.want = 96u; gemm_phase(lds, gm, S, E); }
          else { EpiLnFused<false, true, false, true> E; E.hin_f = nullptr; E.hin_b = HB; E.out_f = p.out; E.out_b = nullptr; E.gam = p.ln_g + 3 * DM; E.bet = p.ln_b + 3 * DM;
              E.xbuf = (unsigned long long*)(ws + OFF_XBUF); E.cnt = (unsigned*)(ws + OFF_CNT); E.want = 128u; gemm_phase(lds, gm, S, E); } }
        xcd_barrier(xb);
    }
}

extern "C" void kernel_launch(void* const* d_in, const int* in_sizes, int n_in, void* d_out, int out_size, void* d_ws, size_t ws_size, hipStream_t stream) {
    static int grid = 0;
    if (grid == 0) {
        if (n_in != 10 || out_size != MT * DM || ws_size < WS_NEED) { fprintf(stderr, "kernel_launch: unexpected shapes / workspace (n_in %d out %d ws %zu)\n", n_in, out_size, ws_size); grid = -1; return; }
        int dev = 0, cus = 0, per_cu = 0;
        hipGetDevice(&dev);
        hipDeviceGetAttribute(&cus, hipDeviceAttributeMultiprocessorCount, dev);
        hipFuncSetAttribute((const void*)yoco_fwd, hipFuncAttributeMaxDynamicSharedMemorySize, LDS_BYTES);
        hipOccupancyMaxActiveBlocksPerMultiprocessor(&per_cu, (const void*)yoco_fwd, 512, LDS_BYTES);
        if (per_cu < 1) per_cu = 1;
        (void)hipGetLastError();
        grid = cus;
    }
    if (grid < 0) return;
    Params p{};
    p.x = (const float*)d_in[0]; p.w_in_a = (const float*)d_in[1]; p.w_grp_a = (const float*)d_in[2]; p.scale_a = (const float*)d_in[3]; p.w_out_a = (const float*)d_in[4];
    p.w_kv = (const float*)d_in[5]; p.w_in_b = (const float*)d_in[6]; p.w_out_b = (const float*)d_in[7]; p.ln_g = (const float*)d_in[8]; p.ln_b = (const float*)d_in[9];
    p.out = (float*)d_out; p.ws = (unsigned char*)d_ws;
    if (hipMemsetAsync((unsigned char*)d_ws + OFF_BAR, 0, 32768, stream) != hipSuccess) { fprintf(stderr, "memset failed\n"); return; }
    void* args[] = {&p};
    hipError_t e = hipLaunchCooperativeKernel((const void*)yoco_fwd, dim3(grid), dim3(512), args, LDS_BYTES, stream);
    if (e != hipSuccess) fprintf(stderr, "cooperative launch failed: %s (grid %d)\n", hipGetErrorString(e), grid);
}
```

```cpp
#include <hip/hip_runtime.h>
#include <hip/hip_cooperative_groups.h>
#include <cstdio>
namespace cg = cooperative_groups;

#define LAS __attribute__((address_space(3)))
typedef unsigned short bf16_t;
typedef short bf16x8 __attribute__((ext_vector_type(8)));
typedef short bf16x4 __attribute__((ext_vector_type(4)));
typedef float f32x4 __attribute__((ext_vector_type(4)));
typedef float f32x2 __attribute__((ext_vector_type(2)));
typedef unsigned u32x4 __attribute__((ext_vector_type(4)));
typedef unsigned u32x2 __attribute__((ext_vector_type(2)));

constexpr int MT = 16384, DM = 1024, SEQ = 4096;
constexpr int BM = 256, BK = 64, HALF = 128, HTB = HALF * BK * 2, STAGE_BYTES = 8 * HTB, NXCD = 8, WGM = 8;
constexpr int LDS_BYTES = 131072 + 1024;
constexpr float DN_ALPHA = 1.681792830507429f;
constexpr float LN_EPS = 1e-5f;
constexpr float LOG2E = 1.4426950408889634f, LN2 = 0.6931471805599453f;
constexpr size_t MiB = 1024 * 1024;
constexpr size_t OFF_V = 0, OFF_SG = 64 * MiB, OFF_BTA = 128 * MiB, OFF_WOA = 144 * MiB, OFF_WGT = 152 * MiB, OFF_WINU = 156 * MiB;
constexpr size_t OFF_KVT = 192 * MiB, OFF_INB = 204 * MiB, OFF_BAR = 220 * MiB, OFF_HB = 224 * MiB;
constexpr size_t OFF_CNT = OFF_BAR + 16384, OFF_XBUF = OFF_BAR + 32768;
constexpr size_t OFF_OUTB = 193 * MiB;
constexpr size_t OFF_K = 0, OFF_VT = 96 * MiB, OFF_LSE = 192 * MiB;
constexpr size_t WS_NEED = 256 * MiB;

typedef __bf16 bf16x2_t __attribute__((ext_vector_type(2)));
__device__ __forceinline__ unsigned cvt_pk_bf16(float lo, float hi) { const f32x2 v = {lo, hi}; const bf16x2_t b = __builtin_convertvector(v, bf16x2_t); return __builtin_bit_cast(unsigned, b); }
__device__ __forceinline__ float bf_lo(unsigned w) { return __uint_as_float(w << 16); }
__device__ __forceinline__ float bf_hi(unsigned w) { return __uint_as_float(w & 0xffff0000u); }
typedef _Float16 half8 __attribute__((ext_vector_type(8)));
__device__ __forceinline__ unsigned cvt_pk_f16(float lo, float hi) { const _Float16 a = (_Float16)lo, b = (_Float16)hi; return (unsigned)__builtin_bit_cast(unsigned short, a) | ((unsigned)__builtin_bit_cast(unsigned short, b) << 16); }
__device__ __forceinline__ float h_lo(unsigned w) { return (float)__builtin_bit_cast(_Float16, (unsigned short)(w & 0xffffu)); }
__device__ __forceinline__ float h_hi(unsigned w) { return (float)__builtin_bit_cast(_Float16, (unsigned short)(w >> 16)); }
template <bool F16> __device__ __forceinline__ unsigned cvt_pk16(float lo, float hi) { if constexpr (F16) return cvt_pk_f16(lo, hi); else return cvt_pk_bf16(lo, hi); }
__device__ __forceinline__ int opaque(int x) { asm volatile("" : "+v"(x)); return x; }
__device__ __forceinline__ float silu_f(float x) { return x * __builtin_amdgcn_rcpf(1.0f + __builtin_amdgcn_exp2f(-x * LOG2E)); }

__host__ __device__ __forceinline__ int lds_byte(int r, int c) { const int st = (r >> 4) * 2 + (c >> 5), rr = r & 15, cc = c & 31, ob = rr * 64 + cc * 2; return st * 1024 + (ob ^ (((ob >> 9) & 1) << 5)); }
__host__ __device__ __forceinline__ void stage_rc(int b, int& R, int& C) { const int st = b / 1024, sb = b % 1024, swz = sb ^ (((sb >> 9) & 1) << 5); R = (st >> 1) * 16 + swz / 64; C = (st & 1) * 32 + (swz % 64) / 2; }
__host__ __device__ __forceinline__ int perm32(int rho) { const int n = rho >> 4, i = rho & 15; return 8 * (i >> 2) + 4 * n + (i & 3); }

struct Unit { int pm, pn; };
struct Gemm { const bf16_t* A; const bf16_t* Bt; int M, N, K; };

struct StaticOrder {
    int nM, nN, nwg, G, c;
    __device__ void init(int M, int N, int G_, int c_) { nM = M / BM; nN = N / BM; nwg = nM * nN; G = G_; c = c_; }
    __device__ bool next(int i, Unit& u) const {
        const long L = (long)i * G + c; if (L >= nwg) return false;
        int wgid = (int)L; { const int q = nwg / NXCD, r = nwg % NXCD, xcd = wgid % NXCD, off = wgid / NXCD; wgid = (xcd < r ? xcd * (q + 1) : r * (q + 1) + (xcd - r) * q) + off; }
        const int nig = WGM * nN, gid = wgid / nig, fm = gid * WGM, gsz = (nM - fm) < WGM ? (nM - fm) : WGM;
        u.pm = fm + ((wgid % nig) % gsz); u.pn = (wgid % nig) / gsz; return true;
    }
};
struct SingleUnit {
    bool has; Unit u0;
    __device__ bool next(int i, Unit& u) const { if (i == 0 && has) { u = u0; return true; } return false; }
};

template <bool F16 = false> struct EpiStore16 {
    static constexpr bool PERM = true, AFTER_DRAIN = false;
    bf16_t* O; int ldc;
    __device__ __forceinline__ void operator()(const f32x4 (&acc)[2][2][4][2], const Unit& u, int wr, int wc, int fr, int fq) const {
        const int row0 = u.pm * BM + wr * 64 + fr, col0 = u.pn * BM + wc * 32 + 8 * fq;
#pragma unroll
        for (int ai = 0; ai < 2; ++ai)
#pragma unroll
            for (int m = 0; m < 4; ++m) { bf16_t* rowp = O + (size_t)(row0 + ai * HALF + m * 16) * ldc + col0;
#pragma unroll
                for (int bj = 0; bj < 2; ++bj) { const f32x4 v0 = acc[ai][bj][m][0], v1 = acc[ai][bj][m][1];
                    u32x4 w; w.x = cvt_pk16<F16>(v0[0], v0[1]); w.y = cvt_pk16<F16>(v0[2], v0[3]); w.z = cvt_pk16<F16>(v1[0], v1[1]); w.w = cvt_pk16<F16>(v1[2], v1[3]);
                    *(u32x4*)(rowp + bj * HALF) = w; } }
    }
};
struct EpiStoreSplit {
    static constexpr bool PERM = true, AFTER_DRAIN = false;
    bf16_t* O0; bf16_t* O1;
    __device__ __forceinline__ void operator()(const f32x4 (&acc)[2][2][4][2], const Unit& u, int wr, int wc, int fr, int fq) const {
        const int row0 = u.pm * BM + wr * 64 + fr, col0 = (u.pn & 3) * BM + wc * 32 + 8 * fq;
        bf16_t* base = u.pn >= 4 ? O1 : O0;
#pragma unroll
        for (int ai = 0; ai < 2; ++ai)
#pragma unroll
            for (int m = 0; m < 4; ++m) { bf16_t* rowp = base + (size_t)(row0 + ai * HALF + m * 16) * 1024 + col0;
#pragma unroll
                for (int bj = 0; bj < 2; ++bj) { const f32x4 v0 = acc[ai][bj][m][0], v1 = acc[ai][bj][m][1];
                    u32x4 w; w.x = cvt_pk_bf16(v0[0], v0[1]); w.y = cvt_pk_bf16(v0[2], v0[3]); w.z = cvt_pk_bf16(v1[0], v1[1]); w.w = cvt_pk_bf16(v1[2], v1[3]);
                    *(u32x4*)(rowp + bj * HALF) = w; } }
    }
};
struct EpiAG1 {
    static constexpr bool PERM = true, AFTER_DRAIN = false;
    bf16_t* V; bf16_t* SG;
    __device__ __forceinline__ void operator()(const f32x4 (&acc)[2][2][4][2], const Unit& u, int wr, int wc, int fr, int fq) const {
        const bool isg = u.pn >= 8;
        const int row0 = u.pm * BM + wr * 64 + fr, col0 = (isg ? u.pn - 8 : u.pn) * BM + wc * 32 + 8 * fq;
        bf16_t* base = isg ? SG : V;
#pragma unroll
        for (int ai = 0; ai < 2; ++ai)
#pragma unroll
            for (int m = 0; m < 4; ++m) { bf16_t* rowp = base + (size_t)(row0 + ai * HALF + m * 16) * 2048 + col0;
#pragma unroll
                for (int bj = 0; bj < 2; ++bj) { f32x4 v0 = acc[ai][bj][m][0], v1 = acc[ai][bj][m][1];
                    if (isg) {
#pragma unroll
                        for (int j = 0; j < 4; ++j) { v0[j] = silu_f(v0[j]); v1[j] = silu_f(v1[j]); } }
                    u32x4 w; w.x = cvt_pk_bf16(v0[0], v0[1]); w.y = cvt_pk_bf16(v0[2], v0[3]); w.z = cvt_pk_bf16(v1[0], v1[1]); w.w = cvt_pk_bf16(v1[2], v1[3]);
                    *(u32x4*)(rowp + bj * HALF) = w; } }
    }
};
struct EpiGateMul {
    static constexpr bool PERM = true, AFTER_DRAIN = false;
    const bf16_t* Zin; bf16_t* Zout;
    __device__ __forceinline__ void operator()(const f32x4 (&acc)[2][2][4][2], const Unit& u, int wr, int wc, int fr, int fq) const {
        const int row0 = u.pm * BM + wr * 64 + fr, col0 = u.pn * BM + wc * 32 + 8 * fq;
#pragma unroll
        for (int ai = 0; ai < 2; ++ai)
#pragma unroll
            for (int m = 0; m < 4; ++m) { const size_t roff = (size_t)(row0 + ai * HALF + m * 16) * DM + col0; const bf16_t* rowp = Zin + roff; bf16_t* rowo = Zout + roff;
#pragma unroll
                for (int bj = 0; bj < 2; ++bj) { const f32x4 v0 = acc[ai][bj][m][0], v1 = acc[ai][bj][m][1];
                    const u32x4 h = *(const u32x4*)(rowp + bj * HALF);
                    u32x4 w;
                    w.x = cvt_pk_bf16(bf_lo(h.x) * silu_f(v0[0]), bf_hi(h.x) * silu_f(v0[1]));
                    w.y = cvt_pk_bf16(bf_lo(h.y) * silu_f(v0[2]), bf_hi(h.y) * silu_f(v0[3]));
                    w.z = cvt_pk_bf16(bf_lo(h.z) * silu_f(v1[0]), bf_hi(h.z) * silu_f(v1[1]));
                    w.w = cvt_pk_bf16(bf_lo(h.w) * silu_f(v1[2]), bf_hi(h.w) * silu_f(v1[3]));
                    *(u32x4*)(rowo + bj * HALF) = w; } }
    }
};
struct EpiKr {
    static constexpr bool PERM = true, AFTER_DRAIN = false;
    bf16_t* Kr;
    __device__ __forceinline__ void operator()(const f32x4 (&acc)[2][2][4][2], const Unit& u, int wr, int wc, int fr, int fq) const {
        const int row0 = u.pm * BM + wr * 64 + fr, col0 = u.pn * BM + wc * 32 + 8 * fq;
        const int g = u.pn >> 2, dsh = 2 * g;
#pragma unroll
        for (int ai = 0; ai < 2; ++ai)
#pragma unroll
            for (int m = 0; m < 4; ++m) { const int t = row0 + ai * HALF + m * 16, b = t >> 12, s = t & 4095, r = s & ((1 << dsh) - 1), i = s >> dsh;
                const int rowidx = r * (SEQ >> dsh) + i;
#pragma unroll
                for (int bj = 0; bj < 2; ++bj) { const f32x4 v0 = acc[ai][bj][m][0], v1 = acc[ai][bj][m][1];
                    const int col = col0 + bj * HALF, hh = (col >> 6) & 15, d0 = col & 63;
                    u32x4 w; w.x = cvt_pk_bf16(v0[0], v0[1]); w.y = cvt_pk_bf16(v0[2], v0[3]); w.z = cvt_pk_bf16(v1[0], v1[1]); w.w = cvt_pk_bf16(v1[2], v1[3]);
                    *(u32x4*)(Kr + ((size_t)(((g * 16 + hh) * 4 + b) * SEQ + rowidx)) * 64 + d0) = w; } }
    }
};
template <int DSH> struct EpiVt {
    static constexpr bool PERM = true, AFTER_DRAIN = false;
    bf16_t* Vt;
    __device__ __forceinline__ void operator()(const f32x4 (&acc)[2][2][4][2], const Unit& u, int wr, int wc, int fr, int fq) const {
        const int row0 = u.pm * BM + wr * 64 + fr;
        const int t_tile = u.pn * BM, b = t_tile >> 12, s_tile = t_tile & 4095;
#pragma unroll
        for (int ai = 0; ai < 2; ++ai)
#pragma unroll
            for (int m = 0; m < 4; ++m) { bf16_t* rowp = Vt + (size_t)(row0 + ai * HALF + m * 16) * MT + b * SEQ + (s_tile >> DSH);
#pragma unroll
                for (int bj = 0; bj < 2; ++bj) { const f32x4 v0 = acc[ai][bj][m][0], v1 = acc[ai][bj][m][1];
                    const int c = bj * HALF + wc * 32 + 8 * fq, r = c >> (8 - DSH), il = c & ((256 >> DSH) - 1);
                    u32x4 w; w.x = cvt_pk_bf16(v0[0], v0[1]); w.y = cvt_pk_bf16(v0[2], v0[3]); w.z = cvt_pk_bf16(v1[0], v1[1]); w.w = cvt_pk_bf16(v1[2], v1[3]);
                    *(u32x4*)(rowp + r * (SEQ >> DSH) + il) = w; } }
    }
};

template <bool RES_F32, bool OUT_F, bool OUT_B, bool F16 = false> struct EpiLnFused {
    static constexpr bool PERM = false, AFTER_DRAIN = true;
    const float* hin_f; const bf16_t* hin_b;
    float* out_f; bf16_t* out_b;
    const float* gam; const float* bet;
    unsigned long long* xbuf; unsigned* cnt; unsigned want;
    __device__ __forceinline__ void fused(f32x4 (&acc)[2][2][4][2], const Unit& u, int wr, int wc, int fr, int fq, LAS unsigned char* lds, int wid, int lane) const {
        LAS f32x2* P = (LAS f32x2*)lds;
        LAS f32x2* S = (LAS f32x2*)(lds + 8192);
        const int col0 = u.pn * BM + wc * 32 + 4 * fq;
#pragma unroll
        for (int ai = 0; ai < 2; ++ai)
#pragma unroll
            for (int mp = 0; mp < 2; ++mp) {
                f32x4 hb_[2][2][2];
#pragma unroll
                for (int mi = 0; mi < 2; ++mi) { const int m = mp * 2 + mi; const unsigned off = (unsigned)(u.pm * BM + ai * HALF + wr * 64 + m * 16 + fr) * DM + col0;
#pragma unroll
                    for (int bj = 0; bj < 2; ++bj)
#pragma unroll
                        for (int n = 0; n < 2; ++n) {
                            if constexpr (RES_F32) hb_[mi][bj][n] = *(const f32x4*)(hin_f + off + bj * HALF + n * 16);
                            else { const u32x2 w = *(const u32x2*)(hin_b + off + bj * HALF + n * 16); hb_[mi][bj][n] = (f32x4){__uint_as_float(w.x), __uint_as_float(w.y), 0.f, 0.f}; } } }
                asm volatile("" : "+v"(hb_[0][0][0]), "+v"(hb_[0][0][1]), "+v"(hb_[0][1][0]), "+v"(hb_[0][1][1]), "+v"(hb_[1][0][0]), "+v"(hb_[1][0][1]), "+v"(hb_[1][1][0]), "+v"(hb_[1][1][1]));
#pragma unroll
                for (int mi = 0; mi < 2; ++mi) { const int m = mp * 2 + mi;
#pragma unroll
                    for (int bj = 0; bj < 2; ++bj)
#pragma unroll
                        for (int n = 0; n < 2; ++n) { f32x4 h = hb_[mi][bj][n];
                            if constexpr (!RES_F32) { const unsigned wx = __float_as_uint(h[0]), wy = __float_as_uint(h[1]); if constexpr (F16) h = (f32x4){h_lo(wx), h_hi(wx), h_lo(wy), h_hi(wy)}; else h = (f32x4){bf_lo(wx), bf_hi(wx), bf_lo(wy), bf_hi(wy)}; }
                            acc[ai][bj][m][n] = h * DN_ALPHA + acc[ai][bj][m][n]; }
                    asm volatile("" : "+v"(acc[ai][0][m][0]), "+v"(acc[ai][0][m][1]), "+v"(acc[ai][1][m][0]), "+v"(acc[ai][1][m][1])); }
                asm volatile("" ::: "memory"); }
#pragma unroll
        for (int ai = 0; ai < 2; ++ai)
#pragma unroll
            for (int m = 0; m < 4; ++m) {
                float s = 0.f;
#pragma unroll
                for (int bj = 0; bj < 2; ++bj)
#pragma unroll
                    for (int n = 0; n < 2; ++n) { const f32x4 x = acc[ai][bj][m][n]; s += (x[0] + x[1]) + (x[2] + x[3]); }
                s += __shfl_xor(s, 16); s += __shfl_xor(s, 32);
                const float mw = s * (1.0f / 64.0f); float qq = 0.f;
#pragma unroll
                for (int bj = 0; bj < 2; ++bj)
#pragma unroll
                    for (int n = 0; n < 2; ++n) { const f32x4 d = acc[ai][bj][m][n] - mw; qq += (d[0] * d[0] + d[1] * d[1]) + (d[2] * d[2] + d[3] * d[3]); }
                qq += __shfl_xor(qq, 16); qq += __shfl_xor(qq, 32);
                if (fq == 0) P[(ai * HALF + wr * 64 + m * 16 + fr) * 4 + wc] = (f32x2){mw, qq};
            }
        asm volatile("s_waitcnt lgkmcnt(0)" ::: "memory"); __builtin_amdgcn_s_barrier(); asm volatile("" ::: "memory");
        const int row = wid * 32 + (lane & 31);
        if (lane < 32) {
            const f32x2 a = P[row * 4 + 0], b = P[row * 4 + 1], c = P[row * 4 + 2], d = P[row * 4 + 3];
            const float mt = (a.x + b.x + c.x + d.x) * 0.25f;
            const float da = a.x - mt, db = b.x - mt, dc = c.x - mt, dd = d.x - mt;
            const float m2 = (a.y + b.y) + (c.y + d.y) + 64.0f * ((da * da + db * db) + (dc * dc + dd * dd));
            unsigned long long* slot = xbuf + ((size_t)(u.pm * BM + row) * 4 + u.pn);
            __hip_atomic_store(slot, ((unsigned long long)__float_as_uint(m2) << 32) | __float_as_uint(mt), __ATOMIC_RELAXED, __HIP_MEMORY_SCOPE_AGENT);
        }
        asm volatile("s_waitcnt vmcnt(0)" ::: "memory");
        if (lane == 0) __hip_atomic_fetch_add(cnt + 64 * u.pm, 1u, __ATOMIC_RELAXED, __HIP_MEMORY_SCOPE_AGENT);
        if (wid == 0) {
            unsigned sp = 0;
            while ((unsigned)__builtin_amdgcn_readfirstlane(__hip_atomic_load(cnt + 64 * u.pm, __ATOMIC_RELAXED, __HIP_MEMORY_SCOPE_AGENT)) < want) { __builtin_amdgcn_s_sleep(2); if (++sp > (1u << 22)) break; }
            __builtin_amdgcn_fence(__ATOMIC_ACQUIRE, "agent");
        }
        asm volatile("s_waitcnt vmcnt(0) lgkmcnt(0)" ::: "memory"); __builtin_amdgcn_s_barrier(); asm volatile("" ::: "memory");
        if (lane < 32) {
            const unsigned long long* slot = xbuf + (size_t)(u.pm * BM + row) * 4; float mt[4], m2[4]; float ms = 0.f;
#pragma unroll
            for (int t = 0; t < 4; ++t) { const unsigned long long w = __hip_atomic_load(slot + t, __ATOMIC_RELAXED, __HIP_MEMORY_SCOPE_AGENT); mt[t] = __uint_as_float((unsigned)w); m2[t] = __uint_as_float((unsigned)(w >> 32)); ms += mt[t]; }
            const float mean = ms * 0.25f; float qq = 0.f;
#pragma unroll
            for (int t = 0; t < 4; ++t) { const float dm = mt[t] - mean; qq += m2[t] + 256.0f * dm * dm; }
            S[row] = (f32x2){mean, 1.0f / sqrtf(qq * (1.0f / 1024.0f) + LN_EPS)};
        }
        asm volatile("s_waitcnt lgkmcnt(0)" ::: "memory"); __builtin_amdgcn_s_barrier(); asm volatile("" ::: "memory");
        f32x2 sr[2][4];
#pragma unroll
        for (int ai = 0; ai < 2; ++ai)
#pragma unroll
            for (int m = 0; m < 4; ++m) sr[ai][m] = S[ai * HALF + wr * 64 + m * 16 + fr];
#pragma unroll
        for (int bj = 0; bj < 2; ++bj)
#pragma unroll
            for (int n = 0; n < 2; ++n) { const f32x4 gv = *(const f32x4*)(gam + col0 + bj * HALF + n * 16), bv = *(const f32x4*)(bet + col0 + bj * HALF + n * 16);
#pragma unroll
                for (int ai = 0; ai < 2; ++ai)
#pragma unroll
                    for (int m = 0; m < 4; ++m) { const int r = ai * HALF + wr * 64 + m * 16 + fr; const unsigned off = (unsigned)(u.pm * BM + r) * DM + col0 + bj * HALF + n * 16;
                        const f32x4 o = (acc[ai][bj][m][n] - sr[ai][m].x) * sr[ai][m].y * gv + bv;
                        if constexpr (OUT_F) *(f32x4*)(out_f + off) = o;
                        if constexpr (OUT_B) { u32x2 w; w.x = cvt_pk16<F16>(o[0], o[1]); w.y = cvt_pk16<F16>(o[2], o[3]); *(u32x2*)(out_b + off) = w; } } }
    }
};

template <class Epi, class Sched, int DSH = 0, bool F16 = false, bool SP2 = true, bool ALIGN_EPI = true>
__device__ __forceinline__ void gemm_phase(LAS unsigned char* lds, const Gemm g, const Sched& S, const Epi& E) {
    const int tid = opaque(threadIdx.x), wid = __builtin_amdgcn_readfirstlane(tid >> 6), lane = tid & 63, wr = wid >> 2, wc = wid & 3, fr = lane & 15, fq = lane >> 4;
    const int K = g.K, nt = K / BK;
    unsigned voffA[2], voffB[2], voffB1[2];
#pragma unroll
    for (int i = 0; i < 2; ++i) { int R, C; stage_rc(tid * 16 + i * 8192, R, C); const int Rb = Epi::PERM ? ((R & ~31) + perm32(R & 31)) : R;
        voffA[i] = (unsigned)(R * K + C) * 2u;
        if constexpr (DSH == 0) { voffB[i] = (unsigned)(Rb * K + C) * 2u; voffB1[i] = (unsigned)((Rb + HALF) * K + C) * 2u; }
        else { const int c0_ = Rb, c1_ = Rb + HALF; const int t0_ = ((c0_ & ((256 >> DSH) - 1)) << DSH) + (c0_ >> (8 - DSH)), t1_ = ((c1_ & ((256 >> DSH) - 1)) << DSH) + (c1_ >> (8 - DSH));
            voffB[i] = (unsigned)(t0_ * K + C) * 2u; voffB1[i] = (unsigned)(t1_ * K + C) * 2u; } }
    const size_t kstep = (size_t)(BK * 2);
    const size_t hstep = (size_t)HALF * K * 2;
    const size_t tstep = 2 * hstep;
    const unsigned ldsw = (unsigned)wid * 1024u;
    const int aoff = lds_byte(wr * 64 + fr, fq * 8), boff = lds_byte(wc * 32 + fr, fq * 8);
#define PG8_SA(b, h) (((b) * 2 + (h)) * HTB)
#define PG8_SB(b, h) ((4 + (b) * 2 + (h)) * HTB)
#define PG8_STAGE(bufoff, gbase, voff) do { _Pragma("unroll") for (int _i = 0; _i < 2; ++_i) \
        __builtin_amdgcn_global_load_lds((const unsigned*)((const char*)(gbase) + (voff)[_i]), (LAS unsigned*)(lds + (bufoff) + ldsw + _i * 8192), 16, 0, 0); } while (0)
#define PG8_LDA(dst, b, h) do { _Pragma("unroll") for (int m = 0; m < 4; ++m) _Pragma("unroll") for (int k = 0; k < 2; ++k) dst[m][k] = *(const LAS bf16x8*)(lds + PG8_SA(b, h) + aoff + m * 2048 + k * 1024); } while (0)
#define PG8_LDB(dst, b, h) do { _Pragma("unroll") for (int n = 0; n < 2; ++n) _Pragma("unroll") for (int k = 0; k < 2; ++k) dst[n][k] = *(const LAS bf16x8*)(lds + PG8_SB(b, h) + boff + n * 2048 + k * 1024); } while (0)
#define PG8_MMA(ai, bj, At, Bt) do { __builtin_amdgcn_s_setprio(1); _Pragma("unroll") for (int m = 0; m < 4; ++m) _Pragma("unroll") for (int n = 0; n < 2; ++n) _Pragma("unroll") for (int k = 0; k < 2; ++k) \
        acc[ai][bj][m][n] = F16 ? __builtin_amdgcn_mfma_f32_16x16x32_f16(__builtin_bit_cast(half8, Bt[n][k]), __builtin_bit_cast(half8, At[m][k]), acc[ai][bj][m][n], 0, 0, 0) : __builtin_amdgcn_mfma_f32_16x16x32_bf16(Bt[n][k], At[m][k], acc[ai][bj][m][n], 0, 0, 0); __builtin_amdgcn_s_setprio(0); } while (0)
#define PG8_WAIT_V(n) asm volatile("s_waitcnt vmcnt(" #n ")" ::: "memory")
#define PG8_WAIT_L(n) asm volatile("s_waitcnt lgkmcnt(" #n ")" ::: "memory")
#define PG8_BAR __builtin_amdgcn_s_barrier()
#define PG8_SCHED __builtin_amdgcn_sched_barrier(0)
    Unit cur, nxt; int ui = 0;
    if (!S.next(0, cur)) return;
    f32x4 acc[2][2][4][2];
#pragma unroll
    for (int a = 0; a < 2; ++a)
#pragma unroll
        for (int b = 0; b < 2; ++b)
#pragma unroll
            for (int m = 0; m < 4; ++m)
#pragma unroll
                for (int n = 0; n < 2; ++n) acc[a][b][m][n] = (f32x4){0.f, 0.f, 0.f, 0.f};
    bf16x8 At[4][2], B0[2][2], B1[2][2];
    const char* cA = (const char*)g.A + (size_t)cur.pm * tstep; const char* cB = (const char*)g.Bt + (size_t)cur.pn * tstep;
    if constexpr (SP2) {
        PG8_STAGE(PG8_SB(0, 0), cB, voffB); PG8_STAGE(PG8_SB(0, 1), cB, voffB1); PG8_STAGE(PG8_SA(0, 0), cA, voffA); PG8_STAGE(PG8_SA(0, 1), cA + hstep, voffA);
        if (wr == 1) PG8_BAR;
        PG8_WAIT_V(2); PG8_BAR;
        PG8_STAGE(PG8_SB(1, 0), cB + kstep, voffB); PG8_STAGE(PG8_SA(1, 0), cA + kstep, voffA); PG8_STAGE(PG8_SB(1, 1), cB + kstep, voffB1);
        PG8_WAIT_V(6); PG8_BAR;
    } else {
    PG8_STAGE(PG8_SB(0, 0), cB, voffB); PG8_STAGE(PG8_SA(0, 0), cA, voffA); PG8_STAGE(PG8_SB(0, 1), cB, voffB1); PG8_STAGE(PG8_SA(0, 1), cA + hstep, voffA);
    if (wr == 1) PG8_BAR;
    PG8_WAIT_V(4); PG8_BAR;
    PG8_STAGE(PG8_SB(1, 0), cB + kstep, voffB); PG8_STAGE(PG8_SA(1, 0), cA + kstep, voffA); PG8_STAGE(PG8_SB(1, 1), cB + kstep, voffB1);
    PG8_WAIT_V(6); PG8_BAR;
    }
    for (;;) {
        const bool has_next = S.next(ui + 1, nxt);
        const char* nA = has_next ? (const char*)g.A + (size_t)nxt.pm * tstep : cA; const char* nB = has_next ? (const char*)g.Bt + (size_t)nxt.pn * tstep : cB;
        for (int t = 0; t < nt; t += 2) {
            const bool last = (t == nt - 2);
            const char* a1 = cA + (size_t)(t + 1) * kstep;
            const char* a2 = last ? nA : cA + (size_t)(t + 2) * kstep; const char* b2 = last ? nB : cB + (size_t)(t + 2) * kstep;
            const char* a3 = a2 + kstep; const char* b3 = b2 + kstep;
            if constexpr (SP2) {
            PG8_LDB(B0, 0, 0); PG8_LDB(B1, 0, 1); PG8_SCHED; PG8_LDA(At, 0, 0); PG8_STAGE(PG8_SA(1, 1), a1 + hstep, voffA);
            PG8_WAIT_V(8); PG8_WAIT_L(0); PG8_BAR; PG8_MMA(0, 0, At, B0); PG8_MMA(0, 1, At, B1); PG8_BAR; PG8_SCHED;
            PG8_LDA(At, 0, 1); PG8_STAGE(PG8_SB(0, 0), b2, voffB); PG8_STAGE(PG8_SB(0, 1), b2, voffB1); PG8_STAGE(PG8_SA(0, 0), a2, voffA);
            PG8_WAIT_V(8); PG8_WAIT_L(0); PG8_BAR; PG8_MMA(1, 0, At, B0); PG8_MMA(1, 1, At, B1); PG8_BAR; PG8_SCHED;
            PG8_LDB(B0, 1, 0); PG8_LDB(B1, 1, 1); PG8_SCHED; PG8_LDA(At, 1, 0); PG8_STAGE(PG8_SA(0, 1), a2 + hstep, voffA);
            PG8_WAIT_V(8); PG8_WAIT_L(0); PG8_BAR; PG8_MMA(0, 0, At, B0); PG8_MMA(0, 1, At, B1); PG8_BAR; PG8_SCHED;
            PG8_LDA(At, 1, 1); PG8_STAGE(PG8_SB(1, 0), b3, voffB); PG8_STAGE(PG8_SB(1, 1), b3, voffB1); PG8_STAGE(PG8_SA(1, 0), a3, voffA);
            PG8_WAIT_V(8); PG8_WAIT_L(0); PG8_BAR; PG8_MMA(1, 0, At, B0); PG8_MMA(1, 1, At, B1); PG8_BAR; PG8_SCHED;
            } else {
            PG8_LDB(B0, 0, 0); PG8_SCHED; PG8_LDA(At, 0, 0); PG8_STAGE(PG8_SA(1, 1), a1 + hstep, voffA);
            PG8_WAIT_L(8); PG8_BAR; PG8_WAIT_L(0); PG8_MMA(0, 0, At, B0); PG8_BAR; PG8_SCHED;
            PG8_LDB(B1, 0, 1); PG8_STAGE(PG8_SB(0, 0), b2, voffB);
            PG8_BAR; PG8_WAIT_L(0); PG8_MMA(0, 1, At, B1); PG8_BAR;
            PG8_LDA(At, 0, 1); PG8_STAGE(PG8_SA(0, 0), a2, voffA);
            PG8_BAR; PG8_WAIT_L(0); PG8_MMA(1, 0, At, B0); PG8_BAR; PG8_SCHED;
            PG8_STAGE(PG8_SB(0, 1), b2, voffB1);
            PG8_WAIT_V(6); PG8_BAR; PG8_MMA(1, 1, At, B1); PG8_BAR;
            PG8_LDB(B0, 1, 0); PG8_SCHED; PG8_LDA(At, 1, 0); PG8_STAGE(PG8_SA(0, 1), a2 + hstep, voffA);
            PG8_WAIT_L(8); PG8_BAR; PG8_WAIT_L(0); PG8_MMA(0, 0, At, B0); PG8_BAR; PG8_SCHED;
            PG8_LDB(B1, 1, 1); PG8_STAGE(PG8_SB(1, 0), b3, voffB);
            PG8_BAR; PG8_WAIT_L(0); PG8_MMA(0, 1, At, B1); PG8_BAR;
            PG8_LDA(At, 1, 1); PG8_STAGE(PG8_SA(1, 0), a3, voffA);
            PG8_BAR; PG8_WAIT_L(0); PG8_MMA(1, 0, At, B0); PG8_BAR; PG8_SCHED;
            PG8_STAGE(PG8_SB(1, 1), b3, voffB1);
            PG8_WAIT_V(6); PG8_BAR; PG8_MMA(1, 1, At, B1); PG8_BAR;
            }
        }
        if constexpr (ALIGN_EPI) { if (wr == 0) PG8_BAR; }
        if constexpr (!Epi::AFTER_DRAIN) E(acc, cur, wr, wc, fr, fq);
        if (!has_next) break;
#pragma unroll
        for (int a = 0; a < 2; ++a)
#pragma unroll
            for (int b = 0; b < 2; ++b)
#pragma unroll
                for (int m = 0; m < 4; ++m)
#pragma unroll
                    for (int n = 0; n < 2; ++n) acc[a][b][m][n] = (f32x4){0.f, 0.f, 0.f, 0.f};
        cur = nxt; cA = nA; cB = nB; ++ui;
        if constexpr (ALIGN_EPI) { if (wr == 1) PG8_BAR; }
    }
    PG8_WAIT_V(0);
    if constexpr (!ALIGN_EPI) { if (wr == 0) PG8_BAR; }
    PG8_BAR;
    if constexpr (Epi::AFTER_DRAIN) E.fused(acc, cur, wr, wc, fr, fq, lds, wid, lane);
#undef PG8_SA
#undef PG8_SB
#undef PG8_STAGE
#undef PG8_LDA
#undef PG8_LDB
#undef PG8_MMA
#undef PG8_WAIT_V
#undef PG8_WAIT_L
#undef PG8_BAR
#undef PG8_SCHED
}


#define XB_TMO      128
#define XB_XCNT(j)  (256  + 64 * (j))
#define XB_XSUB(j)  (1280 + 64 * (j))
#define XB_XGEN(j)  (2304 + 64 * (j))
#define XB_TOP      3328
#define XB_TOPGEN   3392
#define XCD_BAR_WORDS 3456
#define XB_SPIN_CAP (1u << 18)
__device__ __forceinline__ unsigned xb_ld(unsigned* p)              { return __hip_atomic_load(p, __ATOMIC_RELAXED, __HIP_MEMORY_SCOPE_AGENT); }
__device__ __forceinline__ unsigned xb_add(unsigned* p, unsigned v) { return __hip_atomic_fetch_add(p, v, __ATOMIC_RELAXED, __HIP_MEMORY_SCOPE_AGENT); }
__device__ __forceinline__ unsigned xb_xcc_id() { return (unsigned)__builtin_amdgcn_s_getreg((3 << 11) | 20) & 0xFu; }
#define XB_SPIN(cond, bar) do { unsigned _sp = 0; while (cond) { __builtin_amdgcn_s_sleep(1); \
    if ((++_sp & 255u) == 0u) { if (xb_ld(&(bar)[XB_TMO])) break; if (_sp > XB_SPIN_CAP) { atomicAdd(&(bar)[XB_TMO], 1u); break; } } } } while (0)
struct XcdBarrier { unsigned* bar; unsigned x; volatile LAS unsigned* st; };
__device__ __forceinline__ XcdBarrier xcd_barrier_post(unsigned* bar, volatile LAS unsigned* st) {
    XcdBarrier b; b.bar = bar; b.x = xb_xcc_id(); b.st = st;
    if (threadIdx.x == 0) (void)xb_add(&bar[XB_XCNT(b.x)], 1u);
    return b;
}
__device__ __forceinline__ void xcd_barrier_complete(unsigned* bar, unsigned x, unsigned& nloc, unsigned& nx) {
    const unsigned G = gridDim.x * gridDim.y * gridDim.z;
    unsigned sum, cnt, mine, sp = 0u;
    for (;;) {
        sum = 0u; cnt = 0u; mine = 0u;
#pragma unroll
        for (unsigned j = 0; j < 16; ++j) { const unsigned c = xb_ld(&bar[XB_XCNT(j)]); sum += c; cnt += (c > 0u) ? 1u : 0u; mine = (j == x) ? c : mine; }
        if (sum == G) break;
        __builtin_amdgcn_s_sleep(1);
        if ((++sp & 255u) == 0u) { if (xb_ld(&bar[XB_TMO])) break; if (sp > XB_SPIN_CAP) { atomicAdd(&bar[XB_TMO], 1u); break; } }
    }
    nloc = mine > 0u ? mine : 1u; nx = cnt > 0u ? cnt : 1u;
}
__device__ __forceinline__ void xcd_barrier(const XcdBarrier& b) {
    asm volatile("s_waitcnt vmcnt(0)" ::: "memory");
    __syncthreads();
    if (threadIdx.x == 0) {
        unsigned* bar = b.bar;
        const unsigned bx = xb_xcc_id();
        __builtin_amdgcn_s_waitcnt(0);
        unsigned nloc = b.st[0], nx = b.st[1];
        if (nloc == 0u) { xcd_barrier_complete(bar, bx, nloc, nx); b.st[0] = nloc; b.st[1] = nx; }
        const unsigned old = xb_add(&bar[XB_XSUB(bx)], 1u);
        const unsigned gen = old / nloc;
        if (old + 1u == (gen + 1u) * nloc) {
            __builtin_amdgcn_fence(__ATOMIC_RELEASE, "agent");
            asm volatile("s_waitcnt vmcnt(0)" ::: "memory");
            const unsigned og = xb_add(&bar[XB_TOP], 1u);
            const unsigned tg = og / nx;
            if (og + 1u == (tg + 1u) * nx) xb_add(&bar[XB_TOPGEN], 1u);
            else XB_SPIN(xb_ld(&bar[XB_TOPGEN]) == tg, bar);
            __builtin_amdgcn_fence(__ATOMIC_ACQUIRE, "agent");
            xb_add(&bar[XB_XGEN(bx)], 1u);
            asm volatile("s_waitcnt vmcnt(0)" ::: "memory");
        } else {
            XB_SPIN(xb_ld(&bar[XB_XGEN(bx)]) == gen, bar);
            __builtin_amdgcn_fence(__ATOMIC_ACQUIRE, "agent");
            asm volatile("s_waitcnt vmcnt(0)" ::: "memory");
        }
    }
    __syncthreads();
}

template <bool F16 = false>
__device__ __forceinline__ void tp_job(const float* src, size_t smat, int lsrc, int coff, bf16_t* dst, size_t dmat, int ldd, int R, int C, int nmat, LAS float* scr) {
    const int tid = opaque(threadIdx.x);
    const int ntc = C / 64, per = (R / 64) * ntc, total = per * nmat;
    const int G = gridDim.x;
    f32x4 v[2];
    int t = blockIdx.x;
#define TP_LOAD(tt_) do { const int i_ = (tt_) / per, t2_ = (tt_) % per, tr_ = t2_ / ntc, tc_ = t2_ % ntc; const float* s_ = src + (size_t)i_ * smat + coff; \
        _Pragma("unroll") for (int k_ = 0; k_ < 2; ++k_) { const int idx_ = tid + 512 * k_, row_ = idx_ >> 4, c4_ = idx_ & 15; v[k_] = *(const f32x4*)(s_ + (size_t)(tr_ * 64 + row_) * lsrc + tc_ * 64 + c4_ * 4); } } while (0)
    if (t < total) TP_LOAD(t);
#pragma unroll 1
    for (; t < total; t += G) {
#pragma unroll
        for (int k = 0; k < 2; ++k) { const int idx = tid + 512 * k, row = idx >> 4, c4 = idx & 15; LAS float* pp = scr + row * 65 + c4 * 4; pp[0] = v[k][0]; pp[1] = v[k][1]; pp[2] = v[k][2]; pp[3] = v[k][3]; }
        if (t + G < total) TP_LOAD(t + G);
        __syncthreads();
        { const int i = t / per, t2 = t % per, tr = t2 / ntc, tc = t2 % ntc; bf16_t* d = dst + (size_t)i * dmat;
          const int c = tid >> 3, ch = tid & 7; const LAS float* sp = scr + (ch * 8) * 65 + c;
          u32x4 o; o.x = cvt_pk16<F16>(sp[0], sp[65]); o.y = cvt_pk16<F16>(sp[2 * 65], sp[3 * 65]); o.z = cvt_pk16<F16>(sp[4 * 65], sp[5 * 65]); o.w = cvt_pk16<F16>(sp[6 * 65], sp[7 * 65]);
          *(u32x4*)(d + (size_t)(tc * 64 + c) * ldd + tr * 64 + ch * 8) = o; }
        __syncthreads();
    }
#undef TP_LOAD
}

struct Params {
    const float *x, *w_in_a, *w_grp_a, *scale_a, *w_out_a, *w_kv, *w_in_b, *w_out_b, *ln_g, *ln_b;
    float* out; unsigned char* ws;
};

__device__ __forceinline__ void phase_prep(const Params& p, LAS unsigned char* lds) {
    LAS float* scr = (LAS float*)lds;
    unsigned char* ws = p.ws;
    tp_job<true>(p.w_in_a, (size_t)1024 * 4096, 4096, 2048, (bf16_t*)(ws + OFF_BTA) + (size_t)2048 * 1024, (size_t)4096 * 1024, 1024, 1024, 2048, 2, scr);
    tp_job(p.w_out_a, (size_t)2048 * 1024, 1024, 0, (bf16_t*)(ws + OFF_WOA), (size_t)1024 * 2048, 2048, 2048, 1024, 2, scr);
    tp_job<true>(p.w_kv, 0, 6144, 0, (bf16_t*)(ws + OFF_KVT), 0, 1024, 1024, 6144, 1, scr);
    tp_job<true>(p.w_in_b, (size_t)1024 * 4096, 4096, 0, (bf16_t*)(ws + OFF_INB), (size_t)4096 * 1024, 1024, 1024, 4096, 2, scr);
    tp_job<true>(p.w_grp_a, (size_t)512 * 512, 512, 0, (bf16_t*)(ws + OFF_WGT), (size_t)512 * 512, 512, 512, 512, 8, scr);
    { bf16_t* winu = (bf16_t*)(ws + OFF_WINU);
      const int total = 2 * 4 * 1024 * 64;
      const int tid = opaque(threadIdx.x);
#pragma unroll 1
      for (int i0 = blockIdx.x * 512 + tid; i0 < total; i0 += gridDim.x * 512 * 4) {
          f32x4 a[4], b[4];
#pragma unroll
          for (int u = 0; u < 4; ++u) { const int i = i0 + u * gridDim.x * 512; if (i < total) { const int c8 = i & 63, k = (i >> 6) & 1023, lg = i >> 16, l = lg >> 2, g = lg & 3;
              const float* s = p.w_in_a + ((size_t)l * 1024 + k) * 4096 + g * 512 + c8 * 8; a[u] = *(const f32x4*)s; b[u] = *(const f32x4*)(s + 4); } }
#pragma unroll
          for (int u = 0; u < 4; ++u) { const int i = i0 + u * gridDim.x * 512; if (i < total) {
              u32x4 o; o.x = cvt_pk_f16(a[u][0], a[u][1]); o.y = cvt_pk_f16(a[u][2], a[u][3]); o.z = cvt_pk_f16(b[u][0], b[u][1]); o.w = cvt_pk_f16(b[u][2], b[u][3]);
              *(u32x4*)(winu + (size_t)i * 8) = o; } } } }
    { bf16_t* hb = (bf16_t*)(ws + OFF_HB);
      const int total = MT * DM / 8;
      const int tid = opaque(threadIdx.x);
#pragma unroll 1
      for (int i0 = blockIdx.x * 512 + tid; i0 < total; i0 += gridDim.x * 512 * 4) {
          f32x4 a[4], b[4];
#pragma unroll
          for (int u = 0; u < 4; ++u) { const int i = i0 + u * gridDim.x * 512; if (i < total) { const float* s = p.x + (size_t)i * 8; a[u] = *(const f32x4*)s; b[u] = *(const f32x4*)(s + 4); } }
#pragma unroll
          for (int u = 0; u < 4; ++u) { const int i = i0 + u * gridDim.x * 512; if (i < total) {
              u32x4 o; o.x = cvt_pk_f16(a[u][0], a[u][1]); o.y = cvt_pk_f16(a[u][2], a[u][3]); o.z = cvt_pk_f16(b[u][0], b[u][1]); o.w = cvt_pk_f16(b[u][2], b[u][3]);
              *(u32x4*)(hb + (size_t)i * 8) = o; } } } }
}

__device__ __forceinline__ void unpack8(const u32x4 w, float (&f)[8]) { f[0] = bf_lo(w.x); f[1] = bf_hi(w.x); f[2] = bf_lo(w.y); f[3] = bf_hi(w.y); f[4] = bf_lo(w.z); f[5] = bf_hi(w.z); f[6] = bf_lo(w.w); f[7] = bf_hi(w.w); }
template <int W>
__device__ __forceinline__ void pool_item(const bf16_t* V, bf16_t* SG, const float (&sc)[8], int t0, int c0) {
    const int s0 = t0 & (SEQ - 1);
    u32x4 rows[W + 3], gts[4];
#pragma unroll
    for (int j = 0; j < W + 3; ++j) { const int dt = j - (W - 1); rows[j] = (u32x4){0u, 0u, 0u, 0u}; if (s0 + dt >= 0) rows[j] = *(const u32x4*)(V + (size_t)(t0 + dt) * 2048 + c0); }
#pragma unroll
    for (int i = 0; i < 4; ++i) gts[i] = *(const u32x4*)(SG + (size_t)(t0 + i) * 2048 + c0);
    float sum[8];
#pragma unroll
    for (int j = 0; j < 8; ++j) sum[j] = 0.f;
#pragma unroll
    for (int j = 0; j < W - 1; ++j) { float f[8]; unpack8(rows[j], f);
#pragma unroll
        for (int k = 0; k < 8; ++k) sum[k] += f[k]; }
#pragma unroll
    for (int i = 0; i < 4; ++i) {
        float f[8], gt[8]; unpack8(rows[W - 1 + i], f); unpack8(gts[i], gt);
#pragma unroll
        for (int k = 0; k < 8; ++k) sum[k] += f[k];
        const int s = s0 + i; const float inv = 1.0f / (float)(s + 1 < W ? s + 1 : W);
        float o[8];
#pragma unroll
        for (int k = 0; k < 8; ++k) o[k] = (sum[k] * inv - f[k]) * sc[k] * gt[k];
        u32x4 wv; wv.x = cvt_pk_bf16(o[0], o[1]); wv.y = cvt_pk_bf16(o[2], o[3]); wv.z = cvt_pk_bf16(o[4], o[5]); wv.w = cvt_pk_bf16(o[6], o[7]);
        *(u32x4*)(SG + (size_t)(t0 + i) * 2048 + c0) = wv;
        float fo[8]; unpack8(rows[i], fo);
#pragma unroll
        for (int k = 0; k < 8; ++k) sum[k] -= fo[k];
    }
}
__device__ __forceinline__ void phase_pool(const bf16_t* V, bf16_t* SG, const float* scale) {
    const int tid = opaque(threadIdx.x), cth = tid & 255, sub = tid >> 8;
    const int c0 = cth * 8, grp = c0 >> 9;
    float sc[8];
    { const f32x4 a = *(const f32x4*)(scale + c0), b = *(const f32x4*)(scale + c0 + 4); sc[0] = a[0]; sc[1] = a[1]; sc[2] = a[2]; sc[3] = a[3]; sc[4] = b[0]; sc[5] = b[1]; sc[6] = b[2]; sc[7] = b[3]; }
#pragma unroll 1
    for (int q = blockIdx.x * 2 + sub; q < MT / 4; q += gridDim.x * 2) {
        const int t0 = q * 4;
        if (grp == 0) pool_item<2>(V, SG, sc, t0, c0);
        else if (grp == 1) pool_item<4>(V, SG, sc, t0, c0);
        else if (grp == 2) pool_item<8>(V, SG, sc, t0, c0);
        else pool_item<16>(V, SG, sc, t0, c0);
    }
}

template <int V_> struct AttIC { static constexpr int value = V_; };
struct AttGeo { int dsh, dil, L, nblk, g; };
__device__ __forceinline__ void att_decode(const AttGeo& G_, int it, int& hh, int& b, int& r, int& n) { n = it & (G_.nblk - 1); const int y = it >> (5 - G_.dsh); r = y & (G_.dil - 1); const int z = y >> G_.dsh; b = z & 3; hh = z >> 2; }
__device__ __forceinline__ void att_dma_half(const AttGeo& G_, const bf16_t* Kr, const bf16_t* Vt, int it, int which, int slot, LAS unsigned char* lds, int wid, int lane0) {
    int hh, b, r, n; att_decode(G_, it, hh, b, r, n);
    const int lane = opaque(lane0);
    int blk = n - 1 + which; blk = blk < 0 ? 0 : blk;
    const bf16_t* kb = Kr + ((size_t)(((G_.g * 16 + hh) * 4 + b) * SEQ + r * G_.L + blk * 128)) * 64;
    const bf16_t* vb = Vt + (size_t)(G_.g * 1024 + hh * 64) * MT + b * SEQ + r * G_.L + blk * 128;
    LAS unsigned char* kl = lds + slot * 32768; LAS unsigned char* vl = kl + 16384;
#pragma unroll
    for (int rd = 0; rd < 2; ++rd) { const int ch = rd * 8 + wid; const int rho = ch * 8 + (lane >> 3); const int cs = (lane & 7) ^ ((rho >> 1) & 7);
        __builtin_amdgcn_global_load_lds((const unsigned*)(kb + (size_t)rho * 64 + cs * 8), (LAS unsigned*)(kl + ch * 1024), 16, 0, 0); }
#pragma unroll
    for (int rd = 0; rd < 2; ++rd) { const int ch = rd * 8 + wid; const int d = ch * 4 + (lane >> 4); const int cs = (lane & 15) ^ (d & 15);
        __builtin_amdgcn_global_load_lds((const unsigned*)(vb + (size_t)d * MT + cs * 8), (LAS unsigned*)(vl + ch * 1024), 16, 0, 0); }
}
__device__ __forceinline__ int att_first_item() { return ((blockIdx.x & 7) * 32 + (blockIdx.x >> 3)) * 8; }
__device__ __forceinline__ void attn_issue_first(const bf16_t* Kr, const bf16_t* Vt, int g, LAS unsigned char* lds) {
    const int tid = opaque(threadIdx.x), wid = __builtin_amdgcn_readfirstlane(tid >> 6), lane0 = tid & 63;
    AttGeo G_; G_.g = g; G_.dsh = 2 * g; G_.dil = 1 << G_.dsh; G_.L = SEQ >> G_.dsh; G_.nblk = G_.L >> 7;
    const int it = att_first_item();
    att_dma_half(G_, Kr, Vt, it, 0, 3, lds, wid, lane0);
    att_dma_half(G_, Kr, Vt, it, 1, 0, lds, wid, lane0);
}
template <bool PRE>
__device__ __forceinline__ void phase_attn(const bf16_t* Q, const bf16_t* Kr, const bf16_t* Vt, bf16_t* ACC, float* LSE, int g, LAS unsigned char* lds) {
    const int tid = opaque(threadIdx.x), wid = __builtin_amdgcn_readfirstlane(tid >> 6), lane0 = tid & 63, q0 = lane0 & 15, q40 = lane0 >> 4;
    AttGeo G_; G_.g = g; G_.dsh = 2 * g; G_.dil = 1 << G_.dsh; G_.L = SEQ >> G_.dsh; G_.nblk = G_.L >> 7;
    const int dsh = G_.dsh, dil = G_.dil;
    const int it0 = att_first_item();
    bf16x8 qf[2]; u32x2 oldacc[4]; float oldlse = 0.f; int tq = 0, hh = 0, n = 0;
    {
        if constexpr (!PRE) { att_dma_half(G_, Kr, Vt, it0, 0, 3, lds, wid, lane0); att_dma_half(G_, Kr, Vt, it0, 1, 0, lds, wid, lane0); }
        int b, r; att_decode(G_, it0, hh, b, r, n);
        tq = b * SEQ + ((n * 128 + wid * 16 + q0) << dsh) + r;
#pragma unroll
        for (int ks = 0; ks < 2; ++ks) qf[ks] = *(const bf16x8*)(Q + (size_t)tq * 1024 + hh * 64 + ks * 32 + q40 * 8);
        if (g > 0) { oldlse = LSE[(size_t)tq * 16 + hh];
#pragma unroll
            for (int dt = 0; dt < 4; ++dt) oldacc[dt] = *(const u32x2*)(ACC + (size_t)tq * 1024 + hh * 64 + q40 * 4 + dt * 16); }
    }
    u32x2 pend[4]; float pend_lse = 0.f; int pend_tq = 0, pend_hh = 0; bool have_pend = false;
    auto item_body = [&](auto kkc, int k) __attribute__((always_inline)) {
        constexpr int KK = decltype(kkc)::value;
        constexpr int SC = KK, SP = (KK + 3) & 3, SN = (KK + 1) & 3;
        asm volatile("s_waitcnt vmcnt(0)" ::: "memory");
        __builtin_amdgcn_s_barrier();
        asm volatile("" ::: "memory");
        asm volatile("" : "+v"(qf[0]), "+v"(qf[1]), "+v"(oldacc[0]), "+v"(oldacc[1]), "+v"(oldacc[2]), "+v"(oldacc[3]), "+v"(oldlse));
        if (have_pend) {
            bf16_t* pp = ACC + (size_t)pend_tq * 1024 + pend_hh * 64 + q40 * 4;
#pragma unroll
            for (int dt = 0; dt < 4; ++dt) *(u32x2*)(pp + dt * 16) = pend[dt];
            if (q40 == 0) LSE[(size_t)pend_tq * 16 + pend_hh] = pend_lse;
        }
        const int q = opaque(q0), q4 = opaque(q40);
        bf16x8 qn[2]; u32x2 oldn[4]; float oldlsen = 0.f; int tqn = 0, hhn = 0, nn = 0;
        if (k + 1 < 8) {
            const int itn = it0 + k + 1;
            att_dma_half(G_, Kr, Vt, itn, 1, SN, lds, wid, lane0);
            int b, r; att_decode(G_, itn, hhn, b, r, nn);
            tqn = b * SEQ + ((nn * 128 + wid * 16 + q) << dsh) + r;
#pragma unroll
            for (int ks = 0; ks < 2; ++ks) qn[ks] = *(const bf16x8*)(Q + (size_t)tqn * 1024 + hhn * 64 + ks * 32 + q4 * 8);
            if (g > 0) { oldlsen = LSE[(size_t)tqn * 16 + hhn];
#pragma unroll
                for (int dt = 0; dt < 4; ++dt) oldn[dt] = *(const u32x2*)(ACC + (size_t)tqn * 1024 + hhn * 64 + q4 * 4 + dt * 16); }
        }
        const float slope = __builtin_amdgcn_exp2f(-8.0f * (float)(g * 16 + hh + 1) / 48.0f);
        const float bias2 = slope * (float)dil * LOG2E;
        f32x4 sacc[9];
        {
            bf16x8 kf[9][2];
#pragma unroll
            for (int kt = 0; kt < 9; ++kt) { const int t16 = wid + kt; const int rl = (t16 & 7) * 16 + q, sw = (rl >> 1) & 7;
                const LAS unsigned char* kb_ = (t16 >= 8) ? (lds + SC * 32768) : (lds + SP * 32768);
                kf[kt][0] = *(const LAS bf16x8*)(kb_ + rl * 128 + ((q4 ^ sw) * 16));
                kf[kt][1] = *(const LAS bf16x8*)(kb_ + rl * 128 + (((4 + q4) ^ sw) * 16)); }
            asm volatile("" : "+v"(kf[0][0]), "+v"(kf[0][1]), "+v"(kf[1][0]), "+v"(kf[1][1]), "+v"(kf[2][0]), "+v"(kf[2][1]), "+v"(kf[3][0]), "+v"(kf[3][1]), "+v"(kf[4][0]), "+v"(kf[4][1]));
            asm volatile("" : "+v"(kf[5][0]), "+v"(kf[5][1]), "+v"(kf[6][0]), "+v"(kf[6][1]), "+v"(kf[7][0]), "+v"(kf[7][1]), "+v"(kf[8][0]), "+v"(kf[8][1]));
#pragma unroll
            for (int kt = 0; kt < 9; ++kt) { f32x4 a = (f32x4){0.f, 0.f, 0.f, 0.f};
                a = __builtin_amdgcn_mfma_f32_16x16x32_bf16(kf[kt][0], qf[0], a, 0, 0, 0);
                sacc[kt] = a; }
#pragma unroll
            for (int kt = 0; kt < 9; ++kt) sacc[kt] = __builtin_amdgcn_mfma_f32_16x16x32_bf16(kf[kt][1], qf[1], sacc[kt], 0, 0, 0);
        }
        const float relb = (float)(128 + q - q4 * 4);
        const float a0 = -bias2 * relb;
        float mx = -1e30f;
#pragma unroll
        for (int kt = 0; kt < 9; ++kt)
#pragma unroll
            for (int jj = 0; jj < 4; ++jj) {
                float s = __builtin_fmaf(sacc[kt][jj], 0.125f * LOG2E, __builtin_fmaf(bias2, (float)(kt * 16 + jj), a0));
                if (kt == 0) { if (q4 * 4 + jj < q) s = -1e30f; }
                if (kt == 8) { if (q4 * 4 + jj > q) s = -1e30f; }
                sacc[kt][jj] = s; }
        if (n == 0) {
#pragma unroll
            for (int kt = 0; kt < 8; ++kt)
#pragma unroll
                for (int jj = 0; jj < 4; ++jj) if (wid * 16 + kt * 16 + q4 * 4 + jj < 128) sacc[kt][jj] = -1e30f;
        }
#pragma unroll
        for (int kt = 0; kt < 9; ++kt)
#pragma unroll
            for (int jj = 0; jj < 4; ++jj) mx = fmaxf(mx, sacc[kt][jj]);
        mx = fmaxf(mx, __shfl_xor(mx, 16)); mx = fmaxf(mx, __shfl_xor(mx, 32));
        float lsum = 0.f;
#pragma unroll
        for (int kt = 0; kt < 9; ++kt)
#pragma unroll
            for (int jj = 0; jj < 4; ++jj) { const float pv = __builtin_amdgcn_exp2f(sacc[kt][jj] - mx); sacc[kt][jj] = pv; lsum += pv; }
        lsum += __shfl_xor(lsum, 16); lsum += __shfl_xor(lsum, 32);
        f32x4 oacc[4];
#pragma unroll
        for (int dt = 0; dt < 4; ++dt) oacc[dt] = (f32x4){0.f, 0.f, 0.f, 0.f};
#pragma unroll
        for (int kp2 = 0; kp2 < 5; ++kp2) {
            u32x4 pw; pw.x = cvt_pk_bf16(sacc[2 * kp2][0], sacc[2 * kp2][1]); pw.y = cvt_pk_bf16(sacc[2 * kp2][2], sacc[2 * kp2][3]);
            if (kp2 < 4) { pw.z = cvt_pk_bf16(sacc[kp2 < 4 ? 2 * kp2 + 1 : 8][0], sacc[kp2 < 4 ? 2 * kp2 + 1 : 8][1]); pw.w = cvt_pk_bf16(sacc[kp2 < 4 ? 2 * kp2 + 1 : 8][2], sacc[kp2 < 4 ? 2 * kp2 + 1 : 8][3]); }
            else { pw.z = 0u; pw.w = 0u; }
            bf16x8 pf; __builtin_memcpy(&pf, &pw, 16);
            const int chb = 2 * wid + 4 * kp2;
            const LAS unsigned char* v0b = ((chb >> 4) ? (lds + SC * 32768) : (lds + SP * 32768)) + 16384;
            const LAS unsigned char* v1b = (((chb + 2) >> 4) ? (lds + SC * 32768) : (lds + SP * 32768)) + 16384;
            const int c0 = (chb & 15) + (q4 >> 1), c1 = ((chb + 2) & 15) + (q4 >> 1);
#pragma unroll
            for (int dt = 0; dt < 4; ++dt) {
                const int d = dt * 16 + q;
                const int roff = d * 256 + (q4 & 1) * 8;
                u32x4 vw; const u32x2 lo = *(const LAS u32x2*)(v0b + roff + ((c0 ^ q) * 16)); vw.x = lo.x; vw.y = lo.y;
                if (kp2 < 4) { const u32x2 hi = *(const LAS u32x2*)(v1b + roff + ((c1 ^ q) * 16)); vw.z = hi.x; vw.w = hi.y; } else { vw.z = 0u; vw.w = 0u; }
                bf16x8 vf; __builtin_memcpy(&vf, &vw, 16);
                oacc[dt] = __builtin_amdgcn_mfma_f32_16x16x32_bf16(vf, pf, oacc[dt], 0, 0, 0);
            }
            __builtin_amdgcn_sched_barrier(0);
        }
        const float inv = 1.0f / lsum;
        float lse = (mx + __log2f(lsum)) * LN2;
        float w_new = inv, w_old = 0.f;
        if (g > 0) {
            const float mm = fmaxf(oldlse, lse), e0 = __expf(oldlse - mm), e1 = __expf(lse - mm), tot = e0 + e1;
            w_old = e0 / tot; w_new = inv * (e1 / tot); lse = mm + __logf(tot);
        }
#pragma unroll
        for (int dt = 0; dt < 4; ++dt) {
            f32x4 o = oacc[dt] * w_new;
            if (g > 0) { const u32x2 pr = oldacc[dt]; o[0] += w_old * bf_lo(pr.x); o[1] += w_old * bf_hi(pr.x); o[2] += w_old * bf_lo(pr.y); o[3] += w_old * bf_hi(pr.y); }
            u32x2 w; w.x = cvt_pk_bf16(o[0], o[1]); w.y = cvt_pk_bf16(o[2], o[3]);
            pend[dt] = w;
        }
        pend_lse = lse; pend_tq = tq; pend_hh = hh; have_pend = true;
        qf[0] = qn[0]; qf[1] = qn[1]; oldlse = oldlsen; tq = tqn; hh = hhn; n = nn;
#pragma unroll
        for (int dt = 0; dt < 4; ++dt) oldacc[dt] = oldn[dt];
    };
#pragma unroll 1
    for (int kq = 0; kq < 2; ++kq) { item_body(AttIC<0>{}, 4 * kq); item_body(AttIC<1>{}, 4 * kq + 1); item_body(AttIC<2>{}, 4 * kq + 2); item_body(AttIC<3>{}, 4 * kq + 3); }
    if (have_pend) {
        bf16_t* pp = ACC + (size_t)pend_tq * 1024 + pend_hh * 64 + q40 * 4;
#pragma unroll
        for (int dt = 0; dt < 4; ++dt) *(u32x2*)(pp + dt * 16) = pend[dt];
        if (q40 == 0) LSE[(size_t)pend_tq * 16 + pend_hh] = pend_lse;
    }
    asm volatile("s_waitcnt vmcnt(0)" ::: "memory");
    __builtin_amdgcn_s_barrier();
}

__global__ void __launch_bounds__(512, 2) yoco_fwd(Params p) {
    extern __shared__ __attribute__((aligned(16))) unsigned char smem[];
    LAS unsigned char* lds = (LAS unsigned char*)smem;
    cg::grid_group grid = cg::this_grid();
    volatile LAS unsigned* xst = (volatile LAS unsigned*)(lds + 131072);
    if (threadIdx.x < 4) xst[threadIdx.x] = 0u;
    __syncthreads();
    const XcdBarrier xb = xcd_barrier_post((unsigned*)(p.ws + OFF_BAR), xst);
    if (p.ws == nullptr) grid.sync();
    unsigned char* ws = p.ws;
    const int G = gridDim.x, c = blockIdx.x;
    bf16_t* HB = (bf16_t*)(ws + OFF_HB);

    phase_prep(p, lds);
    xcd_barrier(xb);
    { SingleUnit S; S.has = c < 64; const int lg = c >> 3, un = c & 7; S.u0.pm = un >> 2; S.u0.pn = un & 3;
      Gemm gm; gm.A = (const bf16_t*)(ws + OFF_WGT) + (size_t)lg * 512 * 512; gm.Bt = (const bf16_t*)(ws + OFF_WINU) + (size_t)lg * 1024 * 512; gm.M = 512; gm.N = 1024; gm.K = 512;
      EpiStore16<true> E; E.O = (bf16_t*)(ws + OFF_BTA) + (size_t)(lg >> 2) * 4096 * 1024 + (size_t)(lg & 3) * 512 * 1024; E.ldc = 1024;
      gemm_phase<EpiStore16<true>, SingleUnit, 0, true>(lds, gm, S, E); }
    xcd_barrier(xb);
    for (int l = 0; l < 2; ++l) {
        { StaticOrder S; S.init(MT, 4096, G, c); Gemm gm; gm.A = HB; gm.Bt = (const bf16_t*)(ws + OFF_BTA) + (size_t)l * 4096 * 1024; gm.M = MT; gm.N = 4096; gm.K = 1024;
          EpiAG1 E; E.V = (bf16_t*)(ws + OFF_V); E.SG = (bf16_t*)(ws + OFF_SG); gemm_phase<EpiAG1, StaticOrder, 0, true>(lds, gm, S, E); }
        xcd_barrier(xb);
        phase_pool((const bf16_t*)(ws + OFF_V), (bf16_t*)(ws + OFF_SG), p.scale_a + l * 2048);
        xcd_barrier(xb);
        { StaticOrder S; S.init(MT, 1024, G, c); Gemm gm; gm.A = (const bf16_t*)(ws + OFF_SG); gm.Bt = (const bf16_t*)(ws + OFF_WOA) + (size_t)l * 1024 * 2048; gm.M = MT; gm.N = 1024; gm.K = 2048;
          if (l == 0) { EpiLnFused<true, false, true, true> E; E.hin_f = p.x; E.hin_b = nullptr; E.out_f = nullptr; E.out_b = HB; E.gam = p.ln_g; E.bet = p.ln_b;
              E.xbuf = (unsigned long long*)(ws + OFF_XBUF); E.cnt = (unsigned*)(ws + OFF_CNT); E.want = 32u; gemm_phase(lds, gm, S, E); }
          else { EpiLnFused<false, false, true, true> E; E.hin_f = nullptr; E.hin_b = HB; E.out_f = nullptr; E.out_b = HB; E.gam = p.ln_g + DM; E.bet = p.ln_b + DM;
              E.xbuf = (unsigned long long*)(ws + OFF_XBUF); E.cnt = (unsigned*)(ws + OFF_CNT); E.want = 64u; gemm_phase(lds, gm, S, E); } }
        xcd_barrier(xb);
    }
    { StaticOrder S; S.init(MT, 3072, G, c); Gemm gm; gm.A = HB; gm.Bt = (const bf16_t*)(ws + OFF_KVT); gm.M = MT; gm.N = 3072; gm.K = 1024;
      EpiKr E; E.Kr = (bf16_t*)(ws + OFF_K); gemm_phase<EpiKr, StaticOrder, 0, true>(lds, gm, S, E); }
    { StaticOrder S; S.init(1024, MT, G, c); Gemm gm; gm.Bt = HB; gm.M = 1024; gm.N = MT; gm.K = 1024;
      gm.A = (const bf16_t*)(ws + OFF_KVT) + (size_t)(3072 + 0) * 1024;    { EpiVt<0> E; E.Vt = (bf16_t*)(ws + OFF_VT) + (size_t)0 * MT;    gemm_phase<EpiVt<0>, StaticOrder, 0, true>(lds, gm, S, E); }
      gm.A = (const bf16_t*)(ws + OFF_KVT) + (size_t)(3072 + 1024) * 1024; { EpiVt<2> E; E.Vt = (bf16_t*)(ws + OFF_VT) + (size_t)1024 * MT; gemm_phase<EpiVt<2>, StaticOrder, 2, true>(lds, gm, S, E); }
      gm.A = (const bf16_t*)(ws + OFF_KVT) + (size_t)(3072 + 2048) * 1024; { EpiVt<4> E; E.Vt = (bf16_t*)(ws + OFF_VT) + (size_t)2048 * MT; gemm_phase<EpiVt<4>, StaticOrder, 4, true>(lds, gm, S, E); } }
    bf16_t* QG = (bf16_t*)p.out; bf16_t* QY = (bf16_t*)p.out + (size_t)MT * DM; bf16_t* ACC = QG; float* LSE = (float*)(ws + OFF_LSE);
    for (int j = 0; j < 2; ++j) {
        const bf16_t* inb = (const bf16_t*)(ws + OFF_INB) + (size_t)j * 4096 * 1024;
        { StaticOrder S; S.init(MT, 2048, G, c); Gemm gm; gm.A = HB; gm.Bt = inb; gm.M = MT; gm.N = 2048; gm.K = 1024;
          EpiStoreSplit E; E.O0 = QG; E.O1 = QY; gemm_phase<EpiStoreSplit, StaticOrder, 0, true>(lds, gm, S, E); }
        if (j != 0) attn_issue_first((const bf16_t*)(ws + OFF_K), (const bf16_t*)(ws + OFF_VT), 0, lds);
        xcd_barrier(xb);
        if (j == 0) { tp_job(p.w_out_b, (size_t)1024 * 1024, 1024, 0, (bf16_t*)(ws + OFF_OUTB), (size_t)1024 * 1024, 1024, 1024, 1024, 2, (LAS float*)lds);
                      phase_attn<false>(QG, (const bf16_t*)(ws + OFF_K), (const bf16_t*)(ws + OFF_VT), QG, LSE, 0, lds); }
        else phase_attn<true>(QG, (const bf16_t*)(ws + OFF_K), (const bf16_t*)(ws + OFF_VT), QG, LSE, 0, lds);
        attn_issue_first((const bf16_t*)(ws + OFF_K), (const bf16_t*)(ws + OFF_VT), 1, lds);
        xcd_barrier(xb);
        phase_attn<true>(QY, (const bf16_t*)(ws + OFF_K), (const bf16_t*)(ws + OFF_VT), QG, LSE, 1, lds);
        xcd_barrier(xb);
        { StaticOrder S; S.init(MT, 1024, G, c); Gemm gm; gm.A = HB; gm.Bt = inb + (size_t)2 * 1024 * 1024; gm.M = MT; gm.N = 1024; gm.K = 1024;
          EpiStore16<false> E; E.O = QY; E.ldc = 1024; gemm_phase<EpiStore16<false>, StaticOrder, 0, true>(lds, gm, S, E); }
        attn_issue_first((const bf16_t*)(ws + OFF_K), (const bf16_t*)(ws + OFF_VT), 2, lds);
        xcd_barrier(xb);
        phase_attn<true>(QY, (const bf16_t*)(ws + OFF_K), (const bf16_t*)(ws + OFF_VT), QG, LSE, 2, lds);
        xcd_barrier(xb);
        bf16_t* ZB = j == 0 ? ACC : (bf16_t*)(ws + OFF_K);
        { StaticOrder S; S.init(MT, 1024, G, c); Gemm gm; gm.A = HB; gm.Bt = inb + (size_t)3 * 1024 * 1024; gm.M = MT; gm.N = 1024; gm.K = 1024;
          EpiGateMul E; E.Zin = ACC; E.Zout = ZB; gemm_phase<EpiGateMul, StaticOrder, 0, true>(lds, gm, S, E); }
        xcd_barrier(xb);
        { StaticOrder S; S.init(MT, 1024, G, c); Gemm gm; gm.A = ZB; gm.Bt = (const bf16_t*)(ws + OFF_OUTB) + (size_t)j * 1024 * 1024; gm.M = MT; gm.N = 1024; gm.K = 1024;
          if (j == 0) { EpiLnFused<false, false, true, true> E; E.hin_f = nullptr; E.hin_b = HB; E.out_f = nullptr; E.out_b = HB; E.gam = p.ln_g + 2 * DM; E.bet = p.ln_b + 2 * DM;
              E.xbuf = (unsigned long long*)(ws + OFF_XBUF); E.cnt = (unsigned*)(ws + OFF_CNT); E.want = 96u; gemm_phase(lds, gm, S, E); }
          else { EpiLnFused<false, true, false, true> E; E.hin_f = nullptr; E.hin_b = HB; E.out_f = p.out; E.out_b = nullptr; E.gam = p.ln_g + 3 * DM; E.bet = p.ln_b + 3 * DM;
              E.xbuf = (unsigned long long*)(ws + OFF_XBUF); E.cnt = (unsigned*)(ws + OFF_CNT); E.want = 128u; gemm_phase(lds, gm, S, E); } }
        xcd_barrier(xb);
    }
}

extern "C" void kernel_launch(void* const* d_in, const int* in_sizes, int n_in, void* d_out, int out_size, void* d_ws, size_t ws_size, hipStream_t stream) {
    static int grid = 0;
    if (grid == 0) {
        if (n_in != 10 || out_size != MT * DM || ws_size < WS_NEED) { fprintf(stderr, "kernel_launch: unexpected shapes / workspace (n_in %d out %d ws %zu)\n", n_in, out_size, ws_size); grid = -1; return; }
        int dev = 0, cus = 0, per_cu = 0;
        hipGetDevice(&dev);
        hipDeviceGetAttribute(&cus, hipDeviceAttributeMultiprocessorCount, dev);
        hipFuncSetAttribute((const void*)yoco_fwd, hipFuncAttributeMaxDynamicSharedMemorySize, LDS_BYTES);
        hipOccupancyMaxActiveBlocksPerMultiprocessor(&per_cu, (const void*)yoco_fwd, 512, LDS_BYTES);
        if (per_cu < 1) per_cu = 1;
        (void)hipGetLastError();
        grid = cus;
    }
    if (grid < 0) return;
    Params p{};
    p.x = (const float*)d_in[0]; p.w_in_a = (const float*)d_in[1]; p.w_grp_a = (const float*)d_in[2]; p.scale_a = (const float*)d_in[3]; p.w_out_a = (const float*)d_in[4];
    p.w_kv = (const float*)d_in[5]; p.w_in_b = (const float*)d_in[6]; p.w_out_b = (const float*)d_in[7]; p.ln_g = (const float*)d_in[8]; p.ln_b = (const float*)d_in[9];
    p.out = (float*)d_out; p.ws = (unsigned char*)d_ws;
    if (hipMemsetAsync((unsigned char*)d_ws + OFF_BAR, 0, 32768, stream) != hipSuccess) { fprintf(stderr, "memset failed\n"); return; }
    void* args[] = {&p};
    hipError_t e = hipLaunchCooperativeKernel((const void*)yoco_fwd, dim3(grid), dim3(512), args, LDS_BYTES, stream);
    if (e != hipSuccess) fprintf(stderr, "cooperative launch failed: %s (grid %d)\n", hipGetErrorString(e), grid);
}
```

```cpp
#include <hip/hip_runtime.h>
#include <hip/hip_cooperative_groups.h>
#include <cstdio>
namespace cg = cooperative_groups;

#define LAS __attribute__((address_space(3)))
typedef unsigned short bf16_t;
typedef short bf16x8 __attribute__((ext_vector_type(8)));
typedef short bf16x4 __attribute__((ext_vector_type(4)));
typedef float f32x4 __attribute__((ext_vector_type(4)));
typedef float f32x2 __attribute__((ext_vector_type(2)));
typedef unsigned u32x4 __attribute__((ext_vector_type(4)));
typedef unsigned u32x2 __attribute__((ext_vector_type(2)));

constexpr int MT = 16384, DM = 1024, SEQ = 4096;
constexpr int BM = 256, BK = 64, HALF = 128, HTB = HALF * BK * 2, STAGE_BYTES = 8 * HTB, NXCD = 8, WGM = 8;
constexpr int LDS_BYTES = 131072 + 1024;
constexpr float DN_ALPHA = 1.681792830507429f;
constexpr float LN_EPS = 1e-5f;
constexpr float LOG2E = 1.4426950408889634f, LN2 = 0.6931471805599453f;
constexpr size_t MiB = 1024 * 1024;
constexpr size_t OFF_V = 0, OFF_SG = 64 * MiB, OFF_BTA = 128 * MiB, OFF_WOA = 144 * MiB, OFF_WGT = 152 * MiB, OFF_WINU = 156 * MiB;
constexpr size_t OFF_KVT = 192 * MiB, OFF_INB = 204 * MiB, OFF_BAR = 220 * MiB, OFF_HB = 224 * MiB;
constexpr size_t OFF_CNT = OFF_BAR + 16384, OFF_XBUF = OFF_BAR + 32768;
constexpr size_t OFF_OUTB = 193 * MiB;
constexpr size_t OFF_K = 0, OFF_VT = 96 * MiB, OFF_LSE = 192 * MiB;
constexpr size_t WS_NEED = 256 * MiB;

typedef __bf16 bf16x2_t __attribute__((ext_vector_type(2)));
__device__ __forceinline__ unsigned cvt_pk_bf16(float lo, float hi) { const f32x2 v = {lo, hi}; const bf16x2_t b = __builtin_convertvector(v, bf16x2_t); return __builtin_bit_cast(unsigned, b); }
__device__ __forceinline__ float bf_lo(unsigned w) { return __uint_as_float(w << 16); }
__device__ __forceinline__ float bf_hi(unsigned w) { return __uint_as_float(w & 0xffff0000u); }
typedef _Float16 half8 __attribute__((ext_vector_type(8)));
__device__ __forceinline__ unsigned cvt_pk_f16(float lo, float hi) { const _Float16 a = (_Float16)lo, b = (_Float16)hi; return (unsigned)__builtin_bit_cast(unsigned short, a) | ((unsigned)__builtin_bit_cast(unsigned short, b) << 16); }
__device__ __forceinline__ float h_lo(unsigned w) { return (float)__builtin_bit_cast(_Float16, (unsigned short)(w & 0xffffu)); }
__device__ __forceinline__ float h_hi(unsigned w) { return (float)__builtin_bit_cast(_Float16, (unsigned short)(w >> 16)); }
template <bool F16> __device__ __forceinline__ unsigned cvt_pk16(float lo, float hi) { if constexpr (F16) return cvt_pk_f16(lo, hi); else return cvt_pk_bf16(lo, hi); }
__device__ __forceinline__ int opaque(int x) { asm volatile("" : "+v"(x)); return x; }
__device__ __forceinline__ float silu_f(float x) { return x * __builtin_amdgcn_rcpf(1.0f + __builtin_amdgcn_exp2f(-x * LOG2E)); }

__host__ __device__ __forceinline__ int lds_byte(int r, int c) { const int st = (r >> 4) * 2 + (c >> 5), rr = r & 15, cc = c & 31, ob = rr * 64 + cc * 2; return st * 1024 + (ob ^ (((ob >> 9) & 1) << 5)); }
__host__ __device__ __forceinline__ void stage_rc(int b, int& R, int& C) { const int st = b / 1024, sb = b % 1024, swz = sb ^ (((sb >> 9) & 1) << 5); R = (st >> 1) * 16 + swz / 64; C = (st & 1) * 32 + (swz % 64) / 2; }
__host__ __device__ __forceinline__ int perm32(int rho) { const int n = rho >> 4, i = rho & 15; return 8 * (i >> 2) + 4 * n + (i & 3); }

struct Unit { int pm, pn; };
struct Gemm { const bf16_t* A; const bf16_t* Bt; int M, N, K; };

struct StaticOrder {
    int nM, nN, nwg, G, c;
    __device__ void init(int M, int N, int G_, int c_) { nM = M / BM; nN = N / BM; nwg = nM * nN; G = G_; c = c_; }
    __device__ bool next(int i, Unit& u) const {
        const long L = (long)i * G + c; if (L >= nwg) return false;
        int wgid = (int)L; { const int q = nwg / NXCD, r = nwg % NXCD, xcd = wgid % NXCD, off = wgid / NXCD; wgid = (xcd < r ? xcd * (q + 1) : r * (q + 1) + (xcd - r) * q) + off; }
        const int nig = WGM * nN, gid = wgid / nig, fm = gid * WGM, gsz = (nM - fm) < WGM ? (nM - fm) : WGM;
        u.pm = fm + ((wgid % nig) % gsz); u.pn = (wgid % nig) / gsz; return true;
    }
};
struct SingleUnit {
    bool has; Unit u0;
    __device__ bool next(int i, Unit& u) const { if (i == 0 && has) { u = u0; return true; } return false; }
};

template <bool F16 = false> struct EpiStore16 {
    static constexpr bool PERM = true, AFTER_DRAIN = false;
    bf16_t* O; int ldc;
    __device__ __forceinline__ void operator()(const f32x4 (&acc)[2][2][4][2], const Unit& u, int wr, int wc, int fr, int fq) const {
        const int row0 = u.pm * BM + wr * 64 + fr, col0 = u.pn * BM + wc * 32 + 8 * fq;
#pragma unroll
        for (int ai = 0; ai < 2; ++ai)
#pragma unroll
            for (int m = 0; m < 4; ++m) { bf16_t* rowp = O + (size_t)(row0 + ai * HALF + m * 16) * ldc + col0;
#pragma unroll
                for (int bj = 0; bj < 2; ++bj) { const f32x4 v0 = acc[ai][bj][m][0], v1 = acc[ai][bj][m][1];
                    u32x4 w; w.x = cvt_pk16<F16>(v0[0], v0[1]); w.y = cvt_pk16<F16>(v0[2], v0[3]); w.z = cvt_pk16<F16>(v1[0], v1[1]); w.w = cvt_pk16<F16>(v1[2], v1[3]);
                    *(u32x4*)(rowp + bj * HALF) = w; } }
    }
};
struct EpiStoreSplit {
    static constexpr bool PERM = true, AFTER_DRAIN = false;
    bf16_t* O0; bf16_t* O1;
    __device__ __forceinline__ void operator()(const f32x4 (&acc)[2][2][4][2], const Unit& u, int wr, int wc, int fr, int fq) const {
        const int row0 = u.pm * BM + wr * 64 + fr, col0 = (u.pn & 3) * BM + wc * 32 + 8 * fq;
        bf16_t* base = u.pn >= 4 ? O1 : O0;
#pragma unroll
        for (int ai = 0; ai < 2; ++ai)
#pragma unroll
            for (int m = 0; m < 4; ++m) { bf16_t* rowp = base + (size_t)(row0 + ai * HALF + m * 16) * 1024 + col0;
#pragma unroll
                for (int bj = 0; bj < 2; ++bj) { const f32x4 v0 = acc[ai][bj][m][0], v1 = acc[ai][bj][m][1];
                    u32x4 w; w.x = cvt_pk_bf16(v0[0], v0[1]); w.y = cvt_pk_bf16(v0[2], v0[3]); w.z = cvt_pk_bf16(v1[0], v1[1]); w.w = cvt_pk_bf16(v1[2], v1[3]);
                    *(u32x4*)(rowp + bj * HALF) = w; } }
    }
};
struct EpiAG1 {
    static constexpr bool PERM = true, AFTER_DRAIN = false;
    bf16_t* V; bf16_t* SG;
    __device__ __forceinline__ void operator()(const f32x4 (&acc)[2][2][4][2], const Unit& u, int wr, int wc, int fr, int fq) const {
        const bool isg = u.pn >= 8;
        const int row0 = u.pm * BM + wr * 64 + fr, col0 = (isg ? u.pn - 8 : u.pn) * BM + wc * 32 + 8 * fq;
        bf16_t* base = isg ? SG : V;
#pragma unroll
        for (int ai = 0; ai < 2; ++ai)
#pragma unroll
            for (int m = 0; m < 4; ++m) { bf16_t* rowp = base + (size_t)(row0 + ai * HALF + m * 16) * 2048 + col0;
#pragma unroll
                for (int bj = 0; bj < 2; ++bj) { f32x4 v0 = acc[ai][bj][m][0], v1 = acc[ai][bj][m][1];
                    if (isg) {
#pragma unroll
                        for (int j = 0; j < 4; ++j) { v0[j] = silu_f(v0[j]); v1[j] = silu_f(v1[j]); } }
                    u32x4 w; w.x = cvt_pk_bf16(v0[0], v0[1]); w.y = cvt_pk_bf16(v0[2], v0[3]); w.z = cvt_pk_bf16(v1[0], v1[1]); w.w = cvt_pk_bf16(v1[2], v1[3]);
                    *(u32x4*)(rowp + bj * HALF) = w; } }
    }
};
struct EpiGateMul {
    static constexpr bool PERM = true, AFTER_DRAIN = false;
    const bf16_t* Zin; bf16_t* Zout;
    __device__ __forceinline__ void operator()(const f32x4 (&acc)[2][2][4][2], const Unit& u, int wr, int wc, int fr, int fq) const {
        const int row0 = u.pm * BM + wr * 64 + fr, col0 = u.pn * BM + wc * 32 + 8 * fq;
#pragma unroll
        for (int ai = 0; ai < 2; ++ai)
#pragma unroll
            for (int m = 0; m < 4; ++m) { const size_t roff = (size_t)(row0 + ai * HALF + m * 16) * DM + col0; const bf16_t* rowp = Zin + roff; bf16_t* rowo = Zout + roff;
#pragma unroll
                for (int bj = 0; bj < 2; ++bj) { const f32x4 v0 = acc[ai][bj][m][0], v1 = acc[ai][bj][m][1];
                    const u32x4 h = *(const u32x4*)(rowp + bj * HALF);
                    u32x4 w;
                    w.x = cvt_pk_bf16(bf_lo(h.x) * silu_f(v0[0]), bf_hi(h.x) * silu_f(v0[1]));
                    w.y = cvt_pk_bf16(bf_lo(h.y) * silu_f(v0[2]), bf_hi(h.y) * silu_f(v0[3]));
                    w.z = cvt_pk_bf16(bf_lo(h.z) * silu_f(v1[0]), bf_hi(h.z) * silu_f(v1[1]));
                    w.w = cvt_pk_bf16(bf_lo(h.w) * silu_f(v1[2]), bf_hi(h.w) * silu_f(v1[3]));
                    *(u32x4*)(rowo + bj * HALF) = w; } }
    }
};
struct EpiKr {
    static constexpr bool PERM = true, AFTER_DRAIN = false;
    bf16_t* Kr;
    __device__ __forceinline__ void operator()(const f32x4 (&acc)[2][2][4][2], const Unit& u, int wr, int wc, int fr, int fq) const {
        const int row0 = u.pm * BM + wr * 64 + fr, col0 = u.pn * BM + wc * 32 + 8 * fq;
        const int g = u.pn >> 2, dsh = 2 * g;
#pragma unroll
        for (int ai = 0; ai < 2; ++ai)
#pragma unroll
            for (int m = 0; m < 4; ++m) { const int t = row0 + ai * HALF + m * 16, b = t >> 12, s = t & 4095, r = s & ((1 << dsh) - 1), i = s >> dsh;
                const int rowidx = r * (SEQ >> dsh) + i;
#pragma unroll
                for (int bj = 0; bj < 2; ++bj) { const f32x4 v0 = acc[ai][bj][m][0], v1 = acc[ai][bj][m][1];
                    const int col = col0 + bj * HALF, hh = (col >> 6) & 15, d0 = col & 63;
                    u32x4 w; w.x = cvt_pk_bf16(v0[0], v0[1]); w.y = cvt_pk_bf16(v0[2], v0[3]); w.z = cvt_pk_bf16(v1[0], v1[1]); w.w = cvt_pk_bf16(v1[2], v1[3]);
                    *(u32x4*)(Kr + ((size_t)(((g * 16 + hh) * 4 + b) * SEQ + rowidx)) * 64 + d0) = w; } }
    }
};
template <int DSH> struct EpiVt {
    static constexpr bool PERM = true, AFTER_DRAIN = false;
    bf16_t* Vt;
    __device__ __forceinline__ void operator()(const f32x4 (&acc)[2][2][4][2], const Unit& u, int wr, int wc, int fr, int fq) const {
        const int row0 = u.pm * BM + wr * 64 + fr;
        const int t_tile = u.pn * BM, b = t_tile >> 12, s_tile = t_tile & 4095;
#pragma unroll
        for (int ai = 0; ai < 2; ++ai)
#pragma unroll
            for (int m = 0; m < 4; ++m) { bf16_t* rowp = Vt + (size_t)(row0 + ai * HALF + m * 16) * MT + b * SEQ + (s_tile >> DSH);
#pragma unroll
                for (int bj = 0; bj < 2; ++bj) { const f32x4 v0 = acc[ai][bj][m][0], v1 = acc[ai][bj][m][1];
                    const int c = bj * HALF + wc * 32 + 8 * fq, r = c >> (8 - DSH), il = c & ((256 >> DSH) - 1);
                    u32x4 w; w.x = cvt_pk_bf16(v0[0], v0[1]); w.y = cvt_pk_bf16(v0[2], v0[3]); w.z = cvt_pk_bf16(v1[0], v1[1]); w.w = cvt_pk_bf16(v1[2], v1[3]);
                    *(u32x4*)(rowp + r * (SEQ >> DSH) + il) = w; } }
    }
};

template <bool RES_F32, bool OUT_F, bool OUT_B, bool F16 = false> struct EpiLnFused {
    static constexpr bool PERM = false, AFTER_DRAIN = true;
    const float* hin_f; const bf16_t* hin_b;
    float* out_f; bf16_t* out_b;
    const float* gam; const float* bet;
    unsigned long long* xbuf; unsigned* cnt; unsigned want;
    __device__ __forceinline__ void fused(f32x4 (&acc)[2][2][4][2], const Unit& u, int wr, int wc, int fr, int fq, LAS unsigned char* lds, int wid, int lane) const {
        LAS f32x2* P = (LAS f32x2*)lds;
        LAS f32x2* S = (LAS f32x2*)(lds + 8192);
        const int col0 = u.pn * BM + wc * 32 + 4 * fq;
#pragma unroll
        for (int ai = 0; ai < 2; ++ai)
#pragma unroll
            for (int mp = 0; mp < 2; ++mp) {
                f32x4 hb_[2][2][2];
#pragma unroll
                for (int mi = 0; mi < 2; ++mi) { const int m = mp * 2 + mi; const unsigned off = (unsigned)(u.pm * BM + ai * HALF + wr * 64 + m * 16 + fr) * DM + col0;
#pragma unroll
                    for (int bj = 0; bj < 2; ++bj)
#pragma unroll
                        for (int n = 0; n < 2; ++n) {
                            if constexpr (RES_F32) hb_[mi][bj][n] = *(const f32x4*)(hin_f + off + bj * HALF + n * 16);
                            else { const u32x2 w = *(const u32x2*)(hin_b + off + bj * HALF + n * 16); hb_[mi][bj][n] = (f32x4){__uint_as_float(w.x), __uint_as_float(w.y), 0.f, 0.f}; } } }
                asm volatile("" : "+v"(hb_[0][0][0]), "+v"(hb_[0][0][1]), "+v"(hb_[0][1][0]), "+v"(hb_[0][1][1]), "+v"(hb_[1][0][0]), "+v"(hb_[1][0][1]), "+v"(hb_[1][1][0]), "+v"(hb_[1][1][1]));
#pragma unroll
                for (int mi = 0; mi < 2; ++mi) { const int m = mp * 2 + mi;
#pragma unroll
                    for (int bj = 0; bj < 2; ++bj)
#pragma unroll
                        for (int n = 0; n < 2; ++n) { f32x4 h = hb_[mi][bj][n];
                            if constexpr (!RES_F32) { const unsigned wx = __float_as_uint(h[0]), wy = __float_as_uint(h[1]); if constexpr (F16) h = (f32x4){h_lo(wx), h_hi(wx), h_lo(wy), h_hi(wy)}; else h = (f32x4){bf_lo(wx), bf_hi(wx), bf_lo(wy), bf_hi(wy)}; }
                            acc[ai][bj][m][n] = h * DN_ALPHA + acc[ai][bj][m][n]; }
                    asm volatile("" : "+v"(acc[ai][0][m][0]), "+v"(acc[ai][0][m][1]), "+v"(acc[ai][1][m][0]), "+v"(acc[ai][1][m][1])); }
                asm volatile("" ::: "memory"); }
#pragma unroll
        for (int ai = 0; ai < 2; ++ai)
#pragma unroll
            for (int m = 0; m < 4; ++m) {
                float s = 0.f;
#pragma unroll
                for (int bj = 0; bj < 2; ++bj)
#pragma unroll
                    for (int n = 0; n < 2; ++n) { const f32x4 x = acc[ai][bj][m][n]; s += (x[0] + x[1]) + (x[2] + x[3]); }
                s += __shfl_xor(s, 16); s += __shfl_xor(s, 32);
                const float mw = s * (1.0f / 64.0f); float qq = 0.f;
#pragma unroll
                for (int bj = 0; bj < 2; ++bj)
#pragma unroll
                    for (int n = 0; n < 2; ++n) { const f32x4 d = acc[ai][bj][m][n] - mw; qq += (d[0] * d[0] + d[1] * d[1]) + (d[2] * d[2] + d[3] * d[3]); }
                qq += __shfl_xor(qq, 16); qq += __shfl_xor(qq, 32);
                if (fq == 0) P[(ai * HALF + wr * 64 + m * 16 + fr) * 4 + wc] = (f32x2){mw, qq};
            }
        asm volatile("s_waitcnt lgkmcnt(0)" ::: "memory"); __builtin_amdgcn_s_barrier(); asm volatile("" ::: "memory");
        const int row = wid * 32 + (lane & 31);
        if (lane < 32) {
            const f32x2 a = P[row * 4 + 0], b = P[row * 4 + 1], c = P[row * 4 + 2], d = P[row * 4 + 3];
            const float mt = (a.x + b.x + c.x + d.x) * 0.25f;
            const float da = a.x - mt, db = b.x - mt, dc = c.x - mt, dd = d.x - mt;
            const float m2 = (a.y + b.y) + (c.y + d.y) + 64.0f * ((da * da + db * db) + (dc * dc + dd * dd));
            unsigned long long* slot = xbuf + ((size_t)(u.pm * BM + row) * 4 + u.pn);
            __hip_atomic_store(slot, ((unsigned long long)__float_as_uint(m2) << 32) | __float_as_uint(mt), __ATOMIC_RELAXED, __HIP_MEMORY_SCOPE_AGENT);
        }
        asm volatile("s_waitcnt vmcnt(0)" ::: "memory");
        if (lane == 0) __hip_atomic_fetch_add(cnt + 64 * u.pm, 1u, __ATOMIC_RELAXED, __HIP_MEMORY_SCOPE_AGENT);
        if (wid == 0) {
            unsigned sp = 0;
            while ((unsigned)__builtin_amdgcn_readfirstlane(__hip_atomic_load(cnt + 64 * u.pm, __ATOMIC_RELAXED, __HIP_MEMORY_SCOPE_AGENT)) < want) { __builtin_amdgcn_s_sleep(2); if (++sp > (1u << 22)) break; }
            __builtin_amdgcn_fence(__ATOMIC_ACQUIRE, "agent");
        }
        asm volatile("s_waitcnt vmcnt(0) lgkmcnt(0)" ::: "memory"); __builtin_amdgcn_s_barrier(); asm volatile("" ::: "memory");
        if (lane < 32) {
            const unsigned long long* slot = xbuf + (size_t)(u.pm * BM + row) * 4; float mt[4], m2[4]; float ms = 0.f;
#pragma unroll
            for (int t = 0; t < 4; ++t) { const unsigned long long w = __hip_atomic_load(slot + t, __ATOMIC_RELAXED, __HIP_MEMORY_SCOPE_AGENT); mt[t] = __uint_as_float((unsigned)w); m2[t] = __uint_as_float((unsigned)(w >> 32)); ms += mt[t]; }
            const float mean = ms * 0.25f; float qq = 0.f;
#pragma unroll
            for (int t = 0; t < 4; ++t) { const float dm = mt[t] - mean; qq += m2[t] + 256.0f * dm * dm; }
            S[row] = (f32x2){mean, 1.0f / sqrtf(qq * (1.0f / 1024.0f) + LN_EPS)};
        }
        asm volatile("s_waitcnt lgkmcnt(0)" ::: "memory"); __builtin_amdgcn_s_barrier(); asm volatile("" ::: "memory");
        f32x2 sr[2][4];
#pragma unroll
        for (int ai = 0; ai < 2; ++ai)
#pragma unroll
            for (int m = 0; m < 4; ++m) sr[ai][m] = S[ai * HALF + wr * 64 + m * 16 + fr];
#pragma unroll
        for (int bj = 0; bj < 2; ++bj)
#pragma unroll
            for (int n = 0; n < 2; ++n) { const f32x4 gv = *(const f32x4*)(gam + col0 + bj * HALF + n * 16), bv = *(const f32x4*)(bet + col0 + bj * HALF + n * 16);
#pragma unroll
                for (int ai = 0; ai < 2; ++ai)
#pragma unroll
                    for (int m = 0; m < 4; ++m) { const int r = ai * HALF + wr * 64 + m * 16 + fr; const unsigned off = (unsigned)(u.pm * BM + r) * DM + col0 + bj * HALF + n * 16;
                        const f32x4 o = (acc[ai][bj][m][n] - sr[ai][m].x) * sr[ai][m].y * gv + bv;
                        if constexpr (OUT_F) *(f32x4*)(out_f + off) = o;
                        if constexpr (OUT_B) { u32x2 w; w.x = cvt_pk16<F16>(o[0], o[1]); w.y = cvt_pk16<F16>(o[2], o[3]); *(u32x2*)(out_b + off) = w; } } }
    }
};

template <class Epi, class Sched, int DSH = 0, bool F16 = false, bool SP2 = true, bool ALIGN_EPI = true>
__device__ __forceinline__ void gemm_phase(LAS unsigned char* lds, const Gemm g, const Sched& S, const Epi& E) {
    const int tid = opaque(threadIdx.x), wid = __builtin_amdgcn_readfirstlane(tid >> 6), lane = tid & 63, wr = wid >> 2, wc = wid & 3, fr = lane & 15, fq = lane >> 4;
    const int K = g.K, nt = K / BK;
    unsigned voffA[2], voffB[2], voffB1[2];
#pragma unroll
    for (int i = 0; i < 2; ++i) { int R, C; stage_rc(tid * 16 + i * 8192, R, C); const int Rb = Epi::PERM ? ((R & ~31) + perm32(R & 31)) : R;
        voffA[i] = (unsigned)(R * K + C) * 2u;
        if constexpr (DSH == 0) { voffB[i] = (unsigned)(Rb * K + C) * 2u; voffB1[i] = (unsigned)((Rb + HALF) * K + C) * 2u; }
        else { const int c0_ = Rb, c1_ = Rb + HALF; const int t0_ = ((c0_ & ((256 >> DSH) - 1)) << DSH) + (c0_ >> (8 - DSH)), t1_ = ((c1_ & ((256 >> DSH) - 1)) << DSH) + (c1_ >> (8 - DSH));
            voffB[i] = (unsigned)(t0_ * K + C) * 2u; voffB1[i] = (unsigned)(t1_ * K + C) * 2u; } }
    const size_t kstep = (size_t)(BK * 2);
    const size_t hstep = (size_t)HALF * K * 2;
    const size_t tstep = 2 * hstep;
    const unsigned ldsw = (unsigned)wid * 1024u;
    const int aoff = lds_byte(wr * 64 + fr, fq * 8), boff = lds_byte(wc * 32 + fr, fq * 8);
#define PG8_SA(b, h) (((b) * 2 + (h)) * HTB)
#define PG8_SB(b, h) ((4 + (b) * 2 + (h)) * HTB)
#define PG8_STAGE(bufoff, gbase, voff) do { _Pragma("unroll") for (int _i = 0; _i < 2; ++_i) \
        __builtin_amdgcn_global_load_lds((const unsigned*)((const char*)(gbase) + (voff)[_i]), (LAS unsigned*)(lds + (bufoff) + ldsw + _i * 8192), 16, 0, 0); } while (0)
#define PG8_LDA(dst, b, h) do { _Pragma("unroll") for (int m = 0; m < 4; ++m) _Pragma("unroll") for (int k = 0; k < 2; ++k) dst[m][k] = *(const LAS bf16x8*)(lds + PG8_SA(b, h) + aoff + m * 2048 + k * 1024); } while (0)
#define PG8_LDB(dst, b, h) do { _Pragma("unroll") for (int n = 0; n < 2; ++n) _Pragma("unroll") for (int k = 0; k < 2; ++k) dst[n][k] = *(const LAS bf16x8*)(lds + PG8_SB(b, h) + boff + n * 2048 + k * 1024); } while (0)
#define PG8_MMA(ai, bj, At, Bt) do { __builtin_amdgcn_s_setprio(1); _Pragma("unroll") for (int m = 0; m < 4; ++m) _Pragma("unroll") for (int n = 0; n < 2; ++n) _Pragma("unroll") for (int k = 0; k < 2; ++k) \
        acc[ai][bj][m][n] = F16 ? __builtin_amdgcn_mfma_f32_16x16x32_f16(__builtin_bit_cast(half8, Bt[n][k]), __builtin_bit_cast(half8, At[m][k]), acc[ai][bj][m][n], 0, 0, 0) : __builtin_amdgcn_mfma_f32_16x16x32_bf16(Bt[n][k], At[m][k], acc[ai][bj][m][n], 0, 0, 0); __builtin_amdgcn_s_setprio(0); } while (0)
#define PG8_WAIT_V(n) asm volatile("s_waitcnt vmcnt(" #n ")" ::: "memory")
#define PG8_WAIT_L(n) asm volatile("s_waitcnt lgkmcnt(" #n ")" ::: "memory")
#define PG8_BAR __builtin_amdgcn_s_barrier()
#define PG8_SCHED __builtin_amdgcn_sched_barrier(0)
    Unit cur, nxt; int ui = 0;
    if (!S.next(0, cur)) return;
    f32x4 acc[2][2][4][2];
#pragma unroll
    for (int a = 0; a < 2; ++a)
#pragma unroll
        for (int b = 0; b < 2; ++b)
#pragma unroll
            for (int m = 0; m < 4; ++m)
#pragma unroll
                for (int n = 0; n < 2; ++n) acc[a][b][m][n] = (f32x4){0.f, 0.f, 0.f, 0.f};
    bf16x8 At[4][2], B0[2][2], B1[2][2];
    const char* cA = (const char*)g.A + (size_t)cur.pm * tstep; const char* cB = (const char*)g.Bt + (size_t)cur.pn * tstep;
    if constexpr (SP2) {
        PG8_STAGE(PG8_SB(0, 0), cB, voffB); PG8_STAGE(PG8_SB(0, 1), cB, voffB1); PG8_STAGE(PG8_SA(0, 0), cA, voffA); PG8_STAGE(PG8_SA(0, 1), cA + hstep, voffA);
        if (wr == 1) PG8_BAR;
        PG8_WAIT_V(2); PG8_BAR;
        PG8_STAGE(PG8_SB(1, 0), cB + kstep, voffB); PG8_STAGE(PG8_SA(1, 0), cA + kstep, voffA); PG8_STAGE(PG8_SB(1, 1), cB + kstep, voffB1);
        PG8_WAIT_V(6); PG8_BAR;
    } else {
    PG8_STAGE(PG8_SB(0, 0), cB, voffB); PG8_STAGE(PG8_SA(0, 0), cA, voffA); PG8_STAGE(PG8_SB(0, 1), cB, voffB1); PG8_STAGE(PG8_SA(0, 1), cA + hstep, voffA);
    if (wr == 1) PG8_BAR;
    PG8_WAIT_V(4); PG8_BAR;
    PG8_STAGE(PG8_SB(1, 0), cB + kstep, voffB); PG8_STAGE(PG8_SA(1, 0), cA + kstep, voffA); PG8_STAGE(PG8_SB(1, 1), cB + kstep, voffB1);
    PG8_WAIT_V(6); PG8_BAR;
    }
    for (;;) {
        const bool has_next = S.next(ui + 1, nxt);
        const char* nA = has_next ? (const char*)g.A + (size_t)nxt.pm * tstep : cA; const char* nB = has_next ? (const char*)g.Bt + (size_t)nxt.pn * tstep : cB;
        for (int t = 0; t < nt; t += 2) {
            const bool last = (t == nt - 2);
            const char* a1 = cA + (size_t)(t + 1) * kstep;
            const char* a2 = last ? nA : cA + (size_t)(t + 2) * kstep; const char* b2 = last ? nB : cB + (size_t)(t + 2) * kstep;
            const char* a3 = a2 + kstep; const char* b3 = b2 + kstep;
            if constexpr (SP2) {
            PG8_LDB(B0, 0, 0); PG8_LDB(B1, 0, 1); PG8_SCHED; PG8_LDA(At, 0, 0); PG8_STAGE(PG8_SA(1, 1), a1 + hstep, voffA);
            PG8_WAIT_V(8); PG8_WAIT_L(0); PG8_BAR; PG8_MMA(0, 0, At, B0); PG8_MMA(0, 1, At, B1); PG8_BAR; PG8_SCHED;
            PG8_LDA(At, 0, 1); PG8_STAGE(PG8_SB(0, 0), b2, voffB); PG8_STAGE(PG8_SB(0, 1), b2, voffB1); PG8_STAGE(PG8_SA(0, 0), a2, voffA);
            PG8_WAIT_V(8); PG8_WAIT_L(0); PG8_BAR; PG8_MMA(1, 0, At, B0); PG8_MMA(1, 1, At, B1); PG8_BAR; PG8_SCHED;
            PG8_LDB(B0, 1, 0); PG8_LDB(B1, 1, 1); PG8_SCHED; PG8_LDA(At, 1, 0); PG8_STAGE(PG8_SA(0, 1), a2 + hstep, voffA);
            PG8_WAIT_V(8); PG8_WAIT_L(0); PG8_BAR; PG8_MMA(0, 0, At, B0); PG8_MMA(0, 1, At, B1); PG8_BAR; PG8_SCHED;
            PG8_LDA(At, 1, 1); PG8_STAGE(PG8_SB(1, 0), b3, voffB); PG8_STAGE(PG8_SB(1, 1), b3, voffB1); PG8_STAGE(PG8_SA(1, 0), a3, voffA);
            PG8_WAIT_V(8); PG8_WAIT_L(0); PG8_BAR; PG8_MMA(1, 0, At, B0); PG8_MMA(1, 1, At, B1); PG8_BAR; PG8_SCHED;
            } else {
            PG8_LDB(B0, 0, 0); PG8_SCHED; PG8_LDA(At, 0, 0); PG8_STAGE(PG8_SA(1, 1), a1 + hstep, voffA);
            PG8_WAIT_L(8); PG8_BAR; PG8_WAIT_L(0); PG8_MMA(0, 0, At, B0); PG8_BAR; PG8_SCHED;
            PG8_LDB(B1, 0, 1); PG8_STAGE(PG8_SB(0, 0), b2, voffB);
            PG8_BAR; PG8_WAIT_L(0); PG8_MMA(0, 1, At, B1); PG8_BAR;
            PG8_LDA(At, 0, 1); PG8_STAGE(PG8_SA(0, 0), a2, voffA);
            PG8_BAR; PG8_WAIT_L(0); PG8_MMA(1, 0, At, B0); PG8_BAR; PG8_SCHED;
            PG8_STAGE(PG8_SB(0, 1), b2, voffB1);
            PG8_WAIT_V(6); PG8_BAR; PG8_MMA(1, 1, At, B1); PG8_BAR;
            PG8_LDB(B0, 1, 0); PG8_SCHED; PG8_LDA(At, 1, 0); PG8_STAGE(PG8_SA(0, 1), a2 + hstep, voffA);
            PG8_WAIT_L(8); PG8_BAR; PG8_WAIT_L(0); PG8_MMA(0, 0, At, B0); PG8_BAR; PG8_SCHED;
            PG8_LDB(B1, 1, 1); PG8_STAGE(PG8_SB(1, 0), b3, voffB);
            PG8_BAR; PG8_WAIT_L(0); PG8_MMA(0, 1, At, B1); PG8_BAR;
            PG8_LDA(At, 1, 1); PG8_STAGE(PG8_SA(1, 0), a3, voffA);
            PG8_BAR; PG8_WAIT_L(0); PG8_MMA(1, 0, At, B0); PG8_BAR; PG8_SCHED;
            PG8_STAGE(PG8_SB(1, 1), b3, voffB1);
            PG8_WAIT_V(6); PG8_BAR; PG8_MMA(1, 1, At, B1); PG8_BAR;
            }
        }
        if constexpr (ALIGN_EPI) { if (wr == 0) PG8_BAR; }
        if constexpr (!Epi::AFTER_DRAIN) E(acc, cur, wr, wc, fr, fq);
        if (!has_next) break;
#pragma unroll
        for (int a = 0; a < 2; ++a)
#pragma unroll
            for (int b = 0; b < 2; ++b)
#pragma unroll
                for (int m = 0; m < 4; ++m)
#pragma unroll
                    for (int n = 0; n < 2; ++n) acc[a][b][m][n] = (f32x4){0.f, 0.f, 0.f, 0.f};
        cur = nxt; cA = nA; cB = nB; ++ui;
        if constexpr (ALIGN_EPI) { if (wr == 1) PG8_BAR; }
    }
    PG8_WAIT_V(0);
    if constexpr (!ALIGN_EPI) { if (wr == 0) PG8_BAR; }
    PG8_BAR;
    if constexpr (Epi::AFTER_DRAIN) E.fused(acc, cur, wr, wc, fr, fq, lds, wid, lane);
#undef PG8_SA
#undef PG8_SB
#undef PG8_STAGE
#undef PG8_LDA
#undef PG8_LDB
#undef PG8_MMA
#undef PG8_WAIT_V
#undef PG8_WAIT_L
#undef PG8_BAR
#undef PG8_SCHED
}


#define XB_TMO      128
#define XB_XCNT(j)  (256  + 64 * (j))
#define XB_XSUB(j)  (1280 + 64 * (j))
#define XB_XGEN(j)  (2304 + 64 * (j))
#define XB_TOP      3328
#define XB_TOPGEN   3392
#define XCD_BAR_WORDS 3456
#define XB_SPIN_CAP (1u << 18)
__device__ __forceinline__ unsigned xb_ld(unsigned* p)              { return __hip_atomic_load(p, __ATOMIC_RELAXED, __HIP_MEMORY_SCOPE_AGENT); }
__device__ __forceinline__ unsigned xb_add(unsigned* p, unsigned v) { return __hip_atomic_fetch_add(p, v, __ATOMIC_RELAXED, __HIP_MEMORY_SCOPE_AGENT); }
__device__ __forceinline__ unsigned xb_xcc_id() { return (unsigned)__builtin_amdgcn_s_getreg((3 << 11) | 20) & 0xFu; }
#define XB_SPIN(cond, bar) do { unsigned _sp = 0; while (cond) { __builtin_amdgcn_s_sleep(1); \
    if ((++_sp & 255u) == 0u) { if (xb_ld(&(bar)[XB_TMO])) break; if (_sp > XB_SPIN_CAP) { atomicAdd(&(bar)[XB_TMO], 1u); break; } } } } while (0)
struct XcdBarrier { unsigned* bar; unsigned x; volatile LAS unsigned* st; };
__device__ __forceinline__ XcdBarrier xcd_barrier_post(unsigned* bar, volatile LAS unsigned* st) {
    XcdBarrier b; b.bar = bar; b.x = xb_xcc_id(); b.st = st;
    if (threadIdx.x == 0) (void)xb_add(&bar[XB_XCNT(b.x)], 1u);
    return b;
}
__device__ __forceinline__ void xcd_barrier_complete(unsigned* bar, unsigned x, unsigned& nloc, unsigned& nx) {
    const unsigned G = gridDim.x * gridDim.y * gridDim.z;
    unsigned sum, cnt, mine, sp = 0u;
    for (;;) {
        sum = 0u; cnt = 0u; mine = 0u;
#pragma unroll
        for (unsigned j = 0; j < 16; ++j) { const unsigned c = xb_ld(&bar[XB_XCNT(j)]); sum += c; cnt += (c > 0u) ? 1u : 0u; mine = (j == x) ? c : mine; }
        if (sum == G) break;
        __builtin_amdgcn_s_sleep(1);
        if ((++sp & 255u) == 0u) { if (xb_ld(&bar[XB_TMO])) break; if (sp > XB_SPIN_CAP) { atomicAdd(&bar[XB_TMO], 1u); break; } }
    }
    nloc = mine > 0u ? mine : 1u; nx = cnt > 0u ? cnt : 1u;
}
__device__ __forceinline__ void xcd_barrier(const XcdBarrier& b) {
    asm volatile("s_waitcnt vmcnt(0)" ::: "memory");
    __syncthreads();
    if (threadIdx.x == 0) {
        unsigned* bar = b.bar;
        const unsigned bx = xb_xcc_id();
        __builtin_amdgcn_s_waitcnt(0);
        unsigned nloc = b.st[0], nx = b.st[1];
        if (nloc == 0u) { xcd_barrier_complete(bar, bx, nloc, nx); b.st[0] = nloc; b.st[1] = nx; }
        const unsigned old = xb_add(&bar[XB_XSUB(bx)], 1u);
        const unsigned gen = old / nloc;
        if (old + 1u == (gen + 1u) * nloc) {
            __builtin_amdgcn_fence(__ATOMIC_RELEASE, "agent");
            asm volatile("s_waitcnt vmcnt(0)" ::: "memory");
            const unsigned og = xb_add(&bar[XB_TOP], 1u);
            const unsigned tg = og / nx;
            if (og + 1u == (tg + 1u) * nx) xb_add(&bar[XB_TOPGEN], 1u);
            else XB_SPIN(xb_ld(&bar[XB_TOPGEN]) == tg, bar);
            __builtin_amdgcn_fence(__ATOMIC_ACQUIRE, "agent");
            xb_add(&bar[XB_XGEN(bx)], 1u);
            asm volatile("s_waitcnt vmcnt(0)" ::: "memory");
        } else {
            XB_SPIN(xb_ld(&bar[XB_XGEN(bx)]) == gen, bar);
            __builtin_amdgcn_fence(__ATOMIC_ACQUIRE, "agent");
            asm volatile("s_waitcnt vmcnt(0)" ::: "memory");
        }
    }
    __syncthreads();
}

template <bool F16 = false>
__device__ __forceinline__ void tp_job(const float* src, size_t smat, int lsrc, int coff, bf16_t* dst, size_t dmat, int ldd, int R, int C, int nmat, LAS float* scr) {
    const int tid = opaque(threadIdx.x);
    const int ntc = C / 64, per = (R / 64) * ntc, total = per * nmat;
    const int G = gridDim.x;
    f32x4 v[2];
    int t = blockIdx.x;
#define TP_LOAD(tt_) do { const int i_ = (tt_) / per, t2_ = (tt_) % per, tr_ = t2_ / ntc, tc_ = t2_ % ntc; const float* s_ = src + (size_t)i_ * smat + coff; \
        _Pragma("unroll") for (int k_ = 0; k_ < 2; ++k_) { const int idx_ = tid + 512 * k_, row_ = idx_ >> 4, c4_ = idx_ & 15; v[k_] = *(const f32x4*)(s_ + (size_t)(tr_ * 64 + row_) * lsrc + tc_ * 64 + c4_ * 4); } } while (0)
    if (t < total) TP_LOAD(t);
#pragma unroll 1
    for (; t < total; t += G) {
#pragma unroll
        for (int k = 0; k < 2; ++k) { const int idx = tid + 512 * k, row = idx >> 4, c4 = idx & 15; LAS float* pp = scr + row * 65 + c4 * 4; pp[0] = v[k][0]; pp[1] = v[k][1]; pp[2] = v[k][2]; pp[3] = v[k][3]; }
        if (t + G < total) TP_LOAD(t + G);
        __syncthreads();
        { const int i = t / per, t2 = t % per, tr = t2 / ntc, tc = t2 % ntc; bf16_t* d = dst + (size_t)i * dmat;
          const int c = tid >> 3, ch = tid & 7; const LAS float* sp = scr + (ch * 8) * 65 + c;
          u32x4 o; o.x = cvt_pk16<F16>(sp[0], sp[65]); o.y = cvt_pk16<F16>(sp[2 * 65], sp[3 * 65]); o.z = cvt_pk16<F16>(sp[4 * 65], sp[5 * 65]); o.w = cvt_pk16<F16>(sp[6 * 65], sp[7 * 65]);
          *(u32x4*)(d + (size_t)(tc * 64 + c) * ldd + tr * 64 + ch * 8) = o; }
        __syncthreads();
    }
#undef TP_LOAD
}

struct Params {
    const float *x, *w_in_a, *w_grp_a, *scale_a, *w_out_a, *w_kv, *w_in_b, *w_out_b, *ln_g, *ln_b;
    float* out; unsigned char* ws;
};

__device__ __forceinline__ void phase_prep(const Params& p, LAS unsigned char* lds) {
    LAS float* scr = (LAS float*)lds;
    unsigned char* ws = p.ws;
    tp_job<true>(p.w_in_a, (size_t)1024 * 4096, 4096, 2048, (bf16_t*)(ws + OFF_BTA) + (size_t)2048 * 1024, (size_t)4096 * 1024, 1024, 1024, 2048, 2, scr);
    tp_job(p.w_out_a, (size_t)2048 * 1024, 1024, 0, (bf16_t*)(ws + OFF_WOA), (size_t)1024 * 2048, 2048, 2048, 1024, 2, scr);
    tp_job<true>(p.w_kv, 0, 6144, 0, (bf16_t*)(ws + OFF_KVT), 0, 1024, 1024, 6144, 1, scr);
    tp_job<true>(p.w_in_b, (size_t)1024 * 4096, 4096, 0, (bf16_t*)(ws + OFF_INB), (size_t)4096 * 1024, 1024, 1024, 4096, 2, scr);
    tp_job<true>(p.w_grp_a, (size_t)512 * 512, 512, 0, (bf16_t*)(ws + OFF_WGT), (size_t)512 * 512, 512, 512, 512, 8, scr);
    { bf16_t* winu = (bf16_t*)(ws + OFF_WINU);
      const int total = 2 * 4 * 1024 * 64;
      const int tid = opaque(threadIdx.x);
#pragma unroll 1
      for (int i0 = blockIdx.x * 512 + tid; i0 < total; i0 += gridDim.x * 512 * 4) {
          f32x4 a[4], b[4];
#pragma unroll
          for (int u = 0; u < 4; ++u) { const int i = i0 + u * gridDim.x * 512; if (i < total) { const int c8 = i & 63, k = (i >> 6) & 1023, lg = i >> 16, l = lg >> 2, g = lg & 3;
              const float* s = p.w_in_a + ((size_t)l * 1024 + k) * 4096 + g * 512 + c8 * 8; a[u] = *(const f32x4*)s; b[u] = *(const f32x4*)(s + 4); } }
#pragma unroll
          for (int u = 0; u < 4; ++u) { const int i = i0 + u * gridDim.x * 512; if (i < total) {
              u32x4 o; o.x = cvt_pk_f16(a[u][0], a[u][1]); o.y = cvt_pk_f16(a[u][2], a[u][3]); o.z = cvt_pk_f16(b[u][0], b[u][1]); o.w = cvt_pk_f16(b[u][2], b[u][3]);
              *(u32x4*)(winu + (size_t)i * 8) = o; } } } }
    { bf16_t* hb = (bf16_t*)(ws + OFF_HB);
      const int total = MT * DM / 8;
      const int tid = opaque(threadIdx.x);
#pragma unroll 1
      for (int i0 = blockIdx.x * 512 + tid; i0 < total; i0 += gridDim.x * 512 * 4) {
          f32x4 a[4], b[4];
#pragma unroll
          for (int u = 0; u < 4; ++u) { const int i = i0 + u * gridDim.x * 512; if (i < total) { const float* s = p.x + (size_t)i * 8; a[u] = *(const f32x4*)s; b[u] = *(const f32x4*)(s + 4); } }
#pragma unroll
          for (int u = 0; u < 4; ++u) { const int i = i0 + u * gridDim.x * 512; if (i < total) {
              u32x4 o; o.x = cvt_pk_f16(a[u][0], a[u][1]); o.y = cvt_pk_f16(a[u][2], a[u][3]); o.z = cvt_pk_f16(b[u][0], b[u][1]); o.w = cvt_pk_f16(b[u][2], b[u][3]);
              *(u32x4*)(hb + (size_t)i * 8) = o; } } } }
}

__device__ __forceinline__ void unpack8(const u32x4 w, float (&f)[8]) { f[0] = bf_lo(w.x); f[1] = bf_hi(w.x); f[2] = bf_lo(w.y); f[3] = bf_hi(w.y); f[4] = bf_lo(w.z); f[5] = bf_hi(w.z); f[6] = bf_lo(w.w); f[7] = bf_hi(w.w); }
template <int W>
__device__ __forceinline__ void pool_item(const bf16_t* V, bf16_t* SG, const float (&sc)[8], int t0, int c0) {
    const int s0 = t0 & (SEQ - 1);
    u32x4 rows[W + 3], gts[4];
#pragma unroll
    for (int j = 0; j < W + 3; ++j) { const int dt = j - (W - 1); rows[j] = (u32x4){0u, 0u, 0u, 0u}; if (s0 + dt >= 0) rows[j] = *(const u32x4*)(V + (size_t)(t0 + dt) * 2048 + c0); }
#pragma unroll
    for (int i = 0; i < 4; ++i) gts[i] = *(const u32x4*)(SG + (size_t)(t0 + i) * 2048 + c0);
    float sum[8];
#pragma unroll
    for (int j = 0; j < 8; ++j) sum[j] = 0.f;
#pragma unroll
    for (int j = 0; j < W - 1; ++j) { float f[8]; unpack8(rows[j], f);
#pragma unroll
        for (int k = 0; k < 8; ++k) sum[k] += f[k]; }
#pragma unroll
    for (int i = 0; i < 4; ++i) {
        float f[8], gt[8]; unpack8(rows[W - 1 + i], f); unpack8(gts[i], gt);
#pragma unroll
        for (int k = 0; k < 8; ++k) sum[k] += f[k];
        const int s = s0 + i; const float inv = 1.0f / (float)(s + 1 < W ? s + 1 : W);
        float o[8];
#pragma unroll
        for (int k = 0; k < 8; ++k) o[k] = (sum[k] * inv - f[k]) * sc[k] * gt[k];
        u32x4 wv; wv.x = cvt_pk_bf16(o[0], o[1]); wv.y = cvt_pk_bf16(o[2], o[3]); wv.z = cvt_pk_bf16(o[4], o[5]); wv.w = cvt_pk_bf16(o[6], o[7]);
        *(u32x4*)(SG + (size_t)(t0 + i) * 2048 + c0) = wv;
        float fo[8]; unpack8(rows[i], fo);
#pragma unroll
        for (int k = 0; k < 8; ++k) sum[k] -= fo[k];
    }
}
__device__ __forceinline__ void phase_pool(const bf16_t* V, bf16_t* SG, const float* scale) {
    const int tid = opaque(threadIdx.x), cth = tid & 255, sub = tid >> 8;
    const int c0 = cth * 8, grp = c0 >> 9;
    float sc[8];
    { const f32x4 a = *(const f32x4*)(scale + c0), b = *(const f32x4*)(scale + c0 + 4); sc[0] = a[0]; sc[1] = a[1]; sc[2] = a[2]; sc[3] = a[3]; sc[4] = b[0]; sc[5] = b[1]; sc[6] = b[2]; sc[7] = b[3]; }
    const int qper = (MT / 4) / (int)gridDim.x;
#pragma unroll 1
    for (int qi = sub; qi < qper; qi += 2) {
        const int q = blockIdx.x * qper + qi;
        const int t0 = q * 4;
        if (grp == 0) pool_item<2>(V, SG, sc, t0, c0);
        else if (grp == 1) pool_item<4>(V, SG, sc, t0, c0);
        else if (grp == 2) pool_item<8>(V, SG, sc, t0, c0);
        else pool_item<16>(V, SG, sc, t0, c0);
    }
}

template <int V_> struct AttIC { static constexpr int value = V_; };
struct AttGeo { int dsh, dil, L, nblk, g; };
__device__ __forceinline__ void att_decode(const AttGeo& G_, int it, int& hh, int& b, int& r, int& n) { n = it & (G_.nblk - 1); const int y = it >> (5 - G_.dsh); r = y & (G_.dil - 1); const int z = y >> G_.dsh; b = z & 3; hh = z >> 2; }
__device__ __forceinline__ void att_dma_half(const AttGeo& G_, const bf16_t* Kr, const bf16_t* Vt, int it, int which, int slot, LAS unsigned char* lds, int wid, int lane0) {
    int hh, b, r, n; att_decode(G_, it, hh, b, r, n);
    const int lane = opaque(lane0);
    int blk = n - 1 + which; blk = blk < 0 ? 0 : blk;
    const bf16_t* kb = Kr + ((size_t)(((G_.g * 16 + hh) * 4 + b) * SEQ + r * G_.L + blk * 128)) * 64;
    const bf16_t* vb = Vt + (size_t)(G_.g * 1024 + hh * 64) * MT + b * SEQ + r * G_.L + blk * 128;
    LAS unsigned char* kl = lds + slot * 32768; LAS unsigned char* vl = kl + 16384;
#pragma unroll
    for (int rd = 0; rd < 2; ++rd) { const int ch = rd * 8 + wid; const int rho = ch * 8 + (lane >> 3); const int cs = (lane & 7) ^ ((rho >> 1) & 7);
        __builtin_amdgcn_global_load_lds((const unsigned*)(kb + (size_t)rho * 64 + cs * 8), (LAS unsigned*)(kl + ch * 1024), 16, 0, 0); }
#pragma unroll
    for (int rd = 0; rd < 2; ++rd) { const int ch = rd * 8 + wid; const int d = ch * 4 + (lane >> 4); const int cs = (lane & 15) ^ (d & 15);
        __builtin_amdgcn_global_load_lds((const unsigned*)(vb + (size_t)d * MT + cs * 8), (LAS unsigned*)(vl + ch * 1024), 16, 0, 0); }
}
__device__ __forceinline__ int att_first_item() { return ((blockIdx.x & 7) * 32 + (blockIdx.x >> 3)) * 8; }
__device__ __forceinline__ void attn_issue_first(const bf16_t* Kr, const bf16_t* Vt, int g, LAS unsigned char* lds) {
    const int tid = opaque(threadIdx.x), wid = __builtin_amdgcn_readfirstlane(tid >> 6), lane0 = tid & 63;
    AttGeo G_; G_.g = g; G_.dsh = 2 * g; G_.dil = 1 << G_.dsh; G_.L = SEQ >> G_.dsh; G_.nblk = G_.L >> 7;
    const int it = att_first_item();
    att_dma_half(G_, Kr, Vt, it, 0, 3, lds, wid, lane0);
    att_dma_half(G_, Kr, Vt, it, 1, 0, lds, wid, lane0);
}
template <bool PRE>
__device__ __forceinline__ void phase_attn(const bf16_t* Q, const bf16_t* Kr, const bf16_t* Vt, bf16_t* ACC, float* LSE, int g, LAS unsigned char* lds) {
    const int tid = opaque(threadIdx.x), wid = __builtin_amdgcn_readfirstlane(tid >> 6), lane0 = tid & 63, q0 = lane0 & 15, q40 = lane0 >> 4;
    AttGeo G_; G_.g = g; G_.dsh = 2 * g; G_.dil = 1 << G_.dsh; G_.L = SEQ >> G_.dsh; G_.nblk = G_.L >> 7;
    const int dsh = G_.dsh, dil = G_.dil;
    const int it0 = att_first_item();
    bf16x8 qf[2]; u32x2 oldacc[4]; float oldlse = 0.f; int tq = 0, hh = 0, n = 0;
    {
        if constexpr (!PRE) { att_dma_half(G_, Kr, Vt, it0, 0, 3, lds, wid, lane0); att_dma_half(G_, Kr, Vt, it0, 1, 0, lds, wid, lane0); }
        int b, r; att_decode(G_, it0, hh, b, r, n);
        tq = b * SEQ + ((n * 128 + wid * 16 + q0) << dsh) + r;
#pragma unroll
        for (int ks = 0; ks < 2; ++ks) qf[ks] = *(const bf16x8*)(Q + (size_t)tq * 1024 + hh * 64 + ks * 32 + q40 * 8);
        if (g > 0) { oldlse = LSE[(size_t)tq * 16 + hh];
#pragma unroll
            for (int dt = 0; dt < 4; ++dt) oldacc[dt] = *(const u32x2*)(ACC + (size_t)tq * 1024 + hh * 64 + q40 * 4 + dt * 16); }
    }
    u32x2 pend[4]; float pend_lse = 0.f; int pend_tq = 0, pend_hh = 0; bool have_pend = false;
    auto item_body = [&](auto kkc, int k) __attribute__((always_inline)) {
        constexpr int KK = decltype(kkc)::value;
        constexpr int SC = KK, SP = (KK + 3) & 3, SN = (KK + 1) & 3;
        asm volatile("s_waitcnt vmcnt(0)" ::: "memory");
        __builtin_amdgcn_s_barrier();
        asm volatile("" ::: "memory");
        asm volatile("" : "+v"(qf[0]), "+v"(qf[1]), "+v"(oldacc[0]), "+v"(oldacc[1]), "+v"(oldacc[2]), "+v"(oldacc[3]), "+v"(oldlse));
        if (have_pend) {
            bf16_t* pp = ACC + (size_t)pend_tq * 1024 + pend_hh * 64 + q40 * 4;
#pragma unroll
            for (int dt = 0; dt < 4; ++dt) *(u32x2*)(pp + dt * 16) = pend[dt];
            if (q40 == 0) LSE[(size_t)pend_tq * 16 + pend_hh] = pend_lse;
        }
        const int q = opaque(q0), q4 = opaque(q40);
        bf16x8 qn[2]; u32x2 oldn[4]; float oldlsen = 0.f; int tqn = 0, hhn = 0, nn = 0;
        if (k + 1 < 8) {
            const int itn = it0 + k + 1;
            att_dma_half(G_, Kr, Vt, itn, 1, SN, lds, wid, lane0);
            int b, r; att_decode(G_, itn, hhn, b, r, nn);
            tqn = b * SEQ + ((nn * 128 + wid * 16 + q) << dsh) + r;
#pragma unroll
            for (int ks = 0; ks < 2; ++ks) qn[ks] = *(const bf16x8*)(Q + (size_t)tqn * 1024 + hhn * 64 + ks * 32 + q4 * 8);
            if (g > 0) { oldlsen = LSE[(size_t)tqn * 16 + hhn];
#pragma unroll
                for (int dt = 0; dt < 4; ++dt) oldn[dt] = *(const u32x2*)(ACC + (size_t)tqn * 1024 + hhn * 64 + q4 * 4 + dt * 16); }
        }
        const float slope = __builtin_amdgcn_exp2f(-8.0f * (float)(g * 16 + hh + 1) / 48.0f);
        const float bias2 = slope * (float)dil * LOG2E;
        f32x4 sacc[9];
        {
            bf16x8 kf[9][2];
#pragma unroll
            for (int kt = 0; kt < 9; ++kt) { const int t16 = wid + kt; const int rl = (t16 & 7) * 16 + q, sw = (rl >> 1) & 7;
                const LAS unsigned char* kb_ = (t16 >= 8) ? (lds + SC * 32768) : (lds + SP * 32768);
                kf[kt][0] = *(const LAS bf16x8*)(kb_ + rl * 128 + ((q4 ^ sw) * 16));
                kf[kt][1] = *(const LAS bf16x8*)(kb_ + rl * 128 + (((4 + q4) ^ sw) * 16)); }
            asm volatile("" : "+v"(kf[0][0]), "+v"(kf[0][1]), "+v"(kf[1][0]), "+v"(kf[1][1]), "+v"(kf[2][0]), "+v"(kf[2][1]), "+v"(kf[3][0]), "+v"(kf[3][1]), "+v"(kf[4][0]), "+v"(kf[4][1]));
            asm volatile("" : "+v"(kf[5][0]), "+v"(kf[5][1]), "+v"(kf[6][0]), "+v"(kf[6][1]), "+v"(kf[7][0]), "+v"(kf[7][1]), "+v"(kf[8][0]), "+v"(kf[8][1]));
#pragma unroll
            for (int kt = 0; kt < 9; ++kt) { f32x4 a = (f32x4){0.f, 0.f, 0.f, 0.f};
                a = __builtin_amdgcn_mfma_f32_16x16x32_bf16(kf[kt][0], qf[0], a, 0, 0, 0);
                sacc[kt] = a; }
#pragma unroll
            for (int kt = 0; kt < 9; ++kt) sacc[kt] = __builtin_amdgcn_mfma_f32_16x16x32_bf16(kf[kt][1], qf[1], sacc[kt], 0, 0, 0);
        }
        const float relb = (float)(128 + q - q4 * 4);
        const float a0 = -bias2 * relb;
        float mx = -1e30f;
#pragma unroll
        for (int kt = 0; kt < 9; ++kt)
#pragma unroll
            for (int jj = 0; jj < 4; ++jj) {
                float s = __builtin_fmaf(sacc[kt][jj], 0.125f * LOG2E, __builtin_fmaf(bias2, (float)(kt * 16 + jj), a0));
                if (kt == 0) { if (q4 * 4 + jj < q) s = -1e30f; }
                if (kt == 8) { if (q4 * 4 + jj > q) s = -1e30f; }
                sacc[kt][jj] = s; }
        if (n == 0) {
#pragma unroll
            for (int kt = 0; kt < 8; ++kt)
#pragma unroll
                for (int jj = 0; jj < 4; ++jj) if (wid * 16 + kt * 16 + q4 * 4 + jj < 128) sacc[kt][jj] = -1e30f;
        }
#pragma unroll
        for (int kt = 0; kt < 9; ++kt)
#pragma unroll
            for (int jj = 0; jj < 4; ++jj) mx = fmaxf(mx, sacc[kt][jj]);
        mx = fmaxf(mx, __shfl_xor(mx, 16)); mx = fmaxf(mx, __shfl_xor(mx, 32));
        float lsum = 0.f;
#pragma unroll
        for (int kt = 0; kt < 9; ++kt)
#pragma unroll
            for (int jj = 0; jj < 4; ++jj) { const float pv = __builtin_amdgcn_exp2f(sacc[kt][jj] - mx); sacc[kt][jj] = pv; lsum += pv; }
        lsum += __shfl_xor(lsum, 16); lsum += __shfl_xor(lsum, 32);
        f32x4 oacc[4];
#pragma unroll
        for (int dt = 0; dt < 4; ++dt) oacc[dt] = (f32x4){0.f, 0.f, 0.f, 0.f};
#pragma unroll
        for (int kp2 = 0; kp2 < 5; ++kp2) {
            u32x4 pw; pw.x = cvt_pk_bf16(sacc[2 * kp2][0], sacc[2 * kp2][1]); pw.y = cvt_pk_bf16(sacc[2 * kp2][2], sacc[2 * kp2][3]);
            if (kp2 < 4) { pw.z = cvt_pk_bf16(sacc[kp2 < 4 ? 2 * kp2 + 1 : 8][0], sacc[kp2 < 4 ? 2 * kp2 + 1 : 8][1]); pw.w = cvt_pk_bf16(sacc[kp2 < 4 ? 2 * kp2 + 1 : 8][2], sacc[kp2 < 4 ? 2 * kp2 + 1 : 8][3]); }
            else { pw.z = 0u; pw.w = 0u; }
            bf16x8 pf; __builtin_memcpy(&pf, &pw, 16);
            const int chb = 2 * wid + 4 * kp2;
            const LAS unsigned char* v0b = ((chb >> 4) ? (lds + SC * 32768) : (lds + SP * 32768)) + 16384;
            const LAS unsigned char* v1b = (((chb + 2) >> 4) ? (lds + SC * 32768) : (lds + SP * 32768)) + 16384;
            const int c0 = (chb & 15) + (q4 >> 1), c1 = ((chb + 2) & 15) + (q4 >> 1);
#pragma unroll
            for (int dt = 0; dt < 4; ++dt) {
                const int d = dt * 16 + q;
                const int roff = d * 256 + (q4 & 1) * 8;
                u32x4 vw; const u32x2 lo = *(const LAS u32x2*)(v0b + roff + ((c0 ^ q) * 16)); vw.x = lo.x; vw.y = lo.y;
                if (kp2 < 4) { const u32x2 hi = *(const LAS u32x2*)(v1b + roff + ((c1 ^ q) * 16)); vw.z = hi.x; vw.w = hi.y; } else { vw.z = 0u; vw.w = 0u; }
                bf16x8 vf; __builtin_memcpy(&vf, &vw, 16);
                oacc[dt] = __builtin_amdgcn_mfma_f32_16x16x32_bf16(vf, pf, oacc[dt], 0, 0, 0);
            }
            __builtin_amdgcn_sched_barrier(0);
        }
        const float inv = 1.0f / lsum;
        float lse = (mx + __log2f(lsum)) * LN2;
        float w_new = inv, w_old = 0.f;
        if (g > 0) {
            const float mm = fmaxf(oldlse, lse), e0 = __expf(oldlse - mm), e1 = __expf(lse - mm), tot = e0 + e1;
            w_old = e0 / tot; w_new = inv * (e1 / tot); lse = mm + __logf(tot);
        }
#pragma unroll
        for (int dt = 0; dt < 4; ++dt) {
            f32x4 o = oacc[dt] * w_new;
            if (g > 0) { const u32x2 pr = oldacc[dt]; o[0] += w_old * bf_lo(pr.x); o[1] += w_old * bf_hi(pr.x); o[2] += w_old * bf_lo(pr.y); o[3] += w_old * bf_hi(pr.y); }
            u32x2 w; w.x = cvt_pk_bf16(o[0], o[1]); w.y = cvt_pk_bf16(o[2], o[3]);
            pend[dt] = w;
        }
        pend_lse = lse; pend_tq = tq; pend_hh = hh; have_pend = true;
        qf[0] = qn[0]; qf[1] = qn[1]; oldlse = oldlsen; tq = tqn; hh = hhn; n = nn;
#pragma unroll
        for (int dt = 0; dt < 4; ++dt) oldacc[dt] = oldn[dt];
    };
#pragma unroll 1
    for (int kq = 0; kq < 2; ++kq) { item_body(AttIC<0>{}, 4 * kq); item_body(AttIC<1>{}, 4 * kq + 1); item_body(AttIC<2>{}, 4 * kq + 2); item_body(AttIC<3>{}, 4 * kq + 3); }
    if (have_pend) {
        bf16_t* pp = ACC + (size_t)pend_tq * 1024 + pend_hh * 64 + q40 * 4;
#pragma unroll
        for (int dt = 0; dt < 4; ++dt) *(u32x2*)(pp + dt * 16) = pend[dt];
        if (q40 == 0) LSE[(size_t)pend_tq * 16 + pend_hh] = pend_lse;
    }
    asm volatile("s_waitcnt vmcnt(0)" ::: "memory");
    __builtin_amdgcn_s_barrier();
}

__global__ void __launch_bounds__(512, 2) yoco_fwd(Params p) {
    extern __shared__ __attribute__((aligned(16))) unsigned char smem[];
    LAS unsigned char* lds = (LAS unsigned char*)smem;
    cg::grid_group grid = cg::this_grid();
    volatile LAS unsigned* xst = (volatile LAS unsigned*)(lds + 131072);
    if (threadIdx.x < 4) xst[threadIdx.x] = 0u;
    __syncthreads();
    const XcdBarrier xb = xcd_barrier_post((unsigned*)(p.ws + OFF_BAR), xst);
    if (p.ws == nullptr) grid.sync();
    unsigned char* ws = p.ws;
    const int G = gridDim.x, c = blockIdx.x;
    bf16_t* HB = (bf16_t*)(ws + OFF_HB);

    phase_prep(p, lds);
    xcd_barrier(xb);
    { SingleUnit S; S.has = c < 64; const int lg = c >> 3, un = c & 7; S.u0.pm = un >> 2; S.u0.pn = un & 3;
      Gemm gm; gm.A = (const bf16_t*)(ws + OFF_WGT) + (size_t)lg * 512 * 512; gm.Bt = (const bf16_t*)(ws + OFF_WINU) + (size_t)lg * 1024 * 512; gm.M = 512; gm.N = 1024; gm.K = 512;
      EpiStore16<true> E; E.O = (bf16_t*)(ws + OFF_BTA) + (size_t)(lg >> 2) * 4096 * 1024 + (size_t)(lg & 3) * 512 * 1024; E.ldc = 1024;
      gemm_phase<EpiStore16<true>, SingleUnit, 0, true>(lds, gm, S, E); }
    xcd_barrier(xb);
    for (int l = 0; l < 2; ++l) {
        { StaticOrder S; S.init(MT, 4096, G, c); Gemm gm; gm.A = HB; gm.Bt = (const bf16_t*)(ws + OFF_BTA) + (size_t)l * 4096 * 1024; gm.M = MT; gm.N = 4096; gm.K = 1024;
          EpiAG1 E; E.V = (bf16_t*)(ws + OFF_V); E.SG = (bf16_t*)(ws + OFF_SG); gemm_phase<EpiAG1, StaticOrder, 0, true>(lds, gm, S, E); }
        xcd_barrier(xb);
        phase_pool((const bf16_t*)(ws + OFF_V), (bf16_t*)(ws + OFF_SG), p.scale_a + l * 2048);
        xcd_barrier(xb);
        { StaticOrder S; S.init(MT, 1024, G, c); Gemm gm; gm.A = (const bf16_t*)(ws + OFF_SG); gm.Bt = (const bf16_t*)(ws + OFF_WOA) + (size_t)l * 1024 * 2048; gm.M = MT; gm.N = 1024; gm.K = 2048;
          if (l == 0) { EpiLnFused<true, false, true, true> E; E.hin_f = p.x; E.hin_b = nullptr; E.out_f = nullptr; E.out_b = HB; E.gam = p.ln_g; E.bet = p.ln_b;
              E.xbuf = (unsigned long long*)(ws + OFF_XBUF); E.cnt = (unsigned*)(ws + OFF_CNT); E.want = 32u; gemm_phase(lds, gm, S, E); }
          else { EpiLnFused<false, false, true, true> E; E.hin_f = nullptr; E.hin_b = HB; E.out_f = nullptr; E.out_b = HB; E.gam = p.ln_g + DM; E.bet = p.ln_b + DM;
              E.xbuf = (unsigned long long*)(ws + OFF_XBUF); E.cnt = (unsigned*)(ws + OFF_CNT); E.want = 64u; gemm_phase(lds, gm, S, E); } }
        xcd_barrier(xb);
    }
    { StaticOrder S; S.init(MT, 3072, G, c); Gemm gm; gm.A = HB; gm.Bt = (const bf16_t*)(ws + OFF_KVT); gm.M = MT; gm.N = 3072; gm.K = 1024;
      EpiKr E; E.Kr = (bf16_t*)(ws + OFF_K); gemm_phase<EpiKr, StaticOrder, 0, true>(lds, gm, S, E); }
    { StaticOrder S; S.init(1024, MT, G, c); Gemm gm; gm.Bt = HB; gm.M = 1024; gm.N = MT; gm.K = 1024;
      gm.A = (const bf16_t*)(ws + OFF_KVT) + (size_t)(3072 + 0) * 1024;    { EpiVt<0> E; E.Vt = (bf16_t*)(ws + OFF_VT) + (size_t)0 * MT;    gemm_phase<EpiVt<0>, StaticOrder, 0, true>(lds, gm, S, E); }
      gm.A = (const bf16_t*)(ws + OFF_KVT) + (size_t)(3072 + 1024) * 1024; { EpiVt<2> E; E.Vt = (bf16_t*)(ws + OFF_VT) + (size_t)1024 * MT; gemm_phase<EpiVt<2>, StaticOrder, 2, true>(lds, gm, S, E); }
      gm.A = (const bf16_t*)(ws + OFF_KVT) + (size_t)(3072 + 2048) * 1024; { EpiVt<4> E; E.Vt = (bf16_t*)(ws + OFF_VT) + (size_t)2048 * MT; gemm_phase<EpiVt<4>, StaticOrder, 4, true>(lds, gm, S, E); } }
    bf16_t* QG = (bf16_t*)p.out; bf16_t* QY = (bf16_t*)p.out + (size_t)MT * DM; bf16_t* ACC = QG; float* LSE = (float*)(ws + OFF_LSE);
    for (int j = 0; j < 2; ++j) {
        const bf16_t* inb = (const bf16_t*)(ws + OFF_INB) + (size_t)j * 4096 * 1024;
        { StaticOrder S; S.init(MT, 2048, G, c); Gemm gm; gm.A = HB; gm.Bt = inb; gm.M = MT; gm.N = 2048; gm.K = 1024;
          EpiStoreSplit E; E.O0 = QG; E.O1 = QY; gemm_phase<EpiStoreSplit, StaticOrder, 0, true>(lds, gm, S, E); }
        if (j != 0) attn_issue_first((const bf16_t*)(ws + OFF_K), (const bf16_t*)(ws + OFF_VT), 0, lds);
        xcd_barrier(xb);
        if (j == 0) { tp_job(p.w_out_b, (size_t)1024 * 1024, 1024, 0, (bf16_t*)(ws + OFF_OUTB), (size_t)1024 * 1024, 1024, 1024, 1024, 2, (LAS float*)lds);
                      phase_attn<false>(QG, (const bf16_t*)(ws + OFF_K), (const bf16_t*)(ws + OFF_VT), QG, LSE, 0, lds); }
        else phase_attn<true>(QG, (const bf16_t*)(ws + OFF_K), (const bf16_t*)(ws + OFF_VT), QG, LSE, 0, lds);
        attn_issue_first((const bf16_t*)(ws + OFF_K), (const bf16_t*)(ws + OFF_VT), 1, lds);
        xcd_barrier(xb);
        phase_attn<true>(QY, (const bf16_t*)(ws + OFF_K), (const bf16_t*)(ws + OFF_VT), QG, LSE, 1, lds);
        xcd_barrier(xb);
        { StaticOrder S; S.init(MT, 1024, G, c); Gemm gm; gm.A = HB; gm.Bt = inb + (size_t)2 * 1024 * 1024; gm.M = MT; gm.N = 1024; gm.K = 1024;
          EpiStore16<false> E; E.O = QY; E.ldc = 1024; gemm_phase<EpiStore16<false>, StaticOrder, 0, true>(lds, gm, S, E); }
        attn_issue_first((const bf16_t*)(ws + OFF_K), (const bf16_t*)(ws + OFF_VT), 2, lds);
        xcd_barrier(xb);
        phase_attn<true>(QY, (const bf16_t*)(ws + OFF_K), (const bf16_t*)(ws + OFF_VT), QG, LSE, 2, lds);
        xcd_barrier(xb);
        bf16_t* ZB = j == 0 ? ACC : (bf16_t*)(ws + OFF_K);
        { StaticOrder S; S.init(MT, 1024, G, c); Gemm gm; gm.A = HB; gm.Bt = inb + (size_t)3 * 1024 * 1024; gm.M = MT; gm.N = 1024; gm.K = 1024;
          EpiGateMul E; E.Zin = ACC; E.Zout = ZB; gemm_phase<EpiGateMul, StaticOrder, 0, true>(lds, gm, S, E); }
        xcd_barrier(xb);
        { StaticOrder S; S.init(MT, 1024, G, c); Gemm gm; gm.A = ZB; gm.Bt = (const bf16_t*)(ws + OFF_OUTB) + (size_t)j * 1024 * 1024; gm.M = MT; gm.N = 1024; gm.K = 1024;
          if (j == 0) { EpiLnFused<false, false, true, true> E; E.hin_f = nullptr; E.hin_b = HB; E.out_f = nullptr; E.out_b = HB; E.gam = p.ln_g + 2 * DM; E.bet = p.ln_b + 2 * DM;
              E.xbuf = (unsigned long long*)(ws + OFF_XBUF); E.cnt = (unsigned*)(ws + OFF_CNT); E.want = 96u; gemm_phase(lds, gm, S, E); }
          else { EpiLnFused<false, true, false, true> E; E.hin_f = nullptr; E.hin_b = HB; E.out_f = p.out; E.out_b = nullptr; E.gam = p.ln_g + 3 * DM; E.bet = p.ln_b + 3 * DM;
              E.xbuf = (unsigned long long*)(ws + OFF_XBUF); E.cnt = (unsigned*)(ws + OFF_CNT); E.want = 128u; gemm_phase(lds, gm, S, E); } }
        xcd_barrier(xb);
    }
}

extern "C" void kernel_launch(void* const* d_in, const int* in_sizes, int n_in, void* d_out, int out_size, void* d_ws, size_t ws_size, hipStream_t stream) {
    static int grid = 0;
    if (grid == 0) {
        if (n_in != 10 || out_size != MT * DM || ws_size < WS_NEED) { fprintf(stderr, "kernel_launch: unexpected shapes / workspace (n_in %d out %d ws %zu)\n", n_in, out_size, ws_size); grid = -1; return; }
        int dev = 0, cus = 0, per_cu = 0;
        hipGetDevice(&dev);
        hipDeviceGetAttribute(&cus, hipDeviceAttributeMultiprocessorCount, dev);
        hipFuncSetAttribute((const void*)yoco_fwd, hipFuncAttributeMaxDynamicSharedMemorySize, LDS_BYTES);
        hipOccupancyMaxActiveBlocksPerMultiprocessor(&per_cu, (const void*)yoco_fwd, 512, LDS_BYTES);
        if (per_cu < 1) per_cu = 1;
        (void)hipGetLastError();
        grid = cus;
    }
    if (grid < 0) return;
    Params p{};
    p.x = (const float*)d_in[0]; p.w_in_a = (const float*)d_in[1]; p.w_grp_a = (const float*)d_in[2]; p.scale_a = (const float*)d_in[3]; p.w_out_a = (const float*)d_in[4];
    p.w_kv = (const float*)d_in[5]; p.w_in_b = (const float*)d_in[6]; p.w_out_b = (const float*)d_in[7]; p.ln_g = (const float*)d_in[8]; p.ln_b = (const float*)d_in[9];
    p.out = (float*)d_out; p.ws = (unsigned char*)d_ws;
    if (hipMemsetAsync((unsigned char*)d_ws + OFF_BAR, 0, 32768, stream) != hipSuccess) { fprintf(stderr, "memset failed\n"); return; }
    void* args[] = {&p};
    hipError_t e = hipLaunchCooperativeKernel((const void*)yoco_fwd, dim3(grid), dim3(512), args, LDS_BYTES, stream);
    if (e != hipSuccess) fprintf(stderr, "cooperative launch failed: %s (grid %d)\n", hipGetErrorString(e), grid);
}
```

```cpp
#include <hip/hip_runtime.h>
#include <hip/hip_cooperative_groups.h>
#include <cstdio>
namespace cg = cooperative_groups;

#define LAS __attribute__((address_space(3)))
typedef unsigned short bf16_t;
typedef short bf16x8 __attribute__((ext_vector_type(8)));
typedef short bf16x4 __attribute__((ext_vector_type(4)));
typedef float f32x4 __attribute__((ext_vector_type(4)));
typedef float f32x2 __attribute__((ext_vector_type(2)));
typedef unsigned u32x4 __attribute__((ext_vector_type(4)));
typedef unsigned u32x2 __attribute__((ext_vector_type(2)));

constexpr int MT = 16384, DM = 1024, SEQ = 4096;
constexpr int BM = 256, BK = 64, HALF = 128, HTB = HALF * BK * 2, STAGE_BYTES = 8 * HTB, NXCD = 8, WGM = 8;
constexpr int LDS_BYTES = 131072 + 1024;
constexpr float DN_ALPHA = 1.681792830507429f;
constexpr float LN_EPS = 1e-5f;
constexpr float LOG2E = 1.4426950408889634f, LN2 = 0.6931471805599453f;
constexpr size_t MiB = 1024 * 1024;
constexpr size_t OFF_V = 0, OFF_SG = 64 * MiB, OFF_BTA = 128 * MiB, OFF_WOA = 144 * MiB, OFF_WGT = 152 * MiB, OFF_WINU = 156 * MiB;
constexpr size_t OFF_KVT = 192 * MiB, OFF_INB = 204 * MiB, OFF_BAR = 220 * MiB, OFF_HB = 224 * MiB;
constexpr size_t OFF_CNT = OFF_BAR + 16384, OFF_XBUF = OFF_BAR + 32768;
constexpr size_t OFF_OUTB = 193 * MiB;
constexpr size_t OFF_K = 0, OFF_VT = 96 * MiB, OFF_LSE = 192 * MiB;
constexpr size_t WS_NEED = 256 * MiB;

typedef __bf16 bf16x2_t __attribute__((ext_vector_type(2)));
__device__ __forceinline__ unsigned cvt_pk_bf16(float lo, float hi) { const f32x2 v = {lo, hi}; const bf16x2_t b = __builtin_convertvector(v, bf16x2_t); return __builtin_bit_cast(unsigned, b); }
__device__ __forceinline__ float bf_lo(unsigned w) { return __uint_as_float(w << 16); }
__device__ __forceinline__ float bf_hi(unsigned w) { return __uint_as_float(w & 0xffff0000u); }
typedef _Float16 half8 __attribute__((ext_vector_type(8)));
__device__ __forceinline__ unsigned cvt_pk_f16(float lo, float hi) { const _Float16 a = (_Float16)lo, b = (_Float16)hi; return (unsigned)__builtin_bit_cast(unsigned short, a) | ((unsigned)__builtin_bit_cast(unsigned short, b) << 16); }
__device__ __forceinline__ float h_lo(unsigned w) { return (float)__builtin_bit_cast(_Float16, (unsigned short)(w & 0xffffu)); }
__device__ __forceinline__ float h_hi(unsigned w) { return (float)__builtin_bit_cast(_Float16, (unsigned short)(w >> 16)); }
template <bool F16> __device__ __forceinline__ unsigned cvt_pk16(float lo, float hi) { if constexpr (F16) return cvt_pk_f16(lo, hi); else return cvt_pk_bf16(lo, hi); }
__device__ __forceinline__ int opaque(int x) { asm volatile("" : "+v"(x)); return x; }
__device__ __forceinline__ float silu_f(float x) { return x * __builtin_amdgcn_rcpf(1.0f + __builtin_amdgcn_exp2f(-x * LOG2E)); }

__host__ __device__ __forceinline__ int lds_byte(int r, int c) { const int st = (r >> 4) * 2 + (c >> 5), rr = r & 15, cc = c & 31, ob = rr * 64 + cc * 2; return st * 1024 + (ob ^ (((ob >> 9) & 1) << 5)); }
__host__ __device__ __forceinline__ void stage_rc(int b, int& R, int& C) { const int st = b / 1024, sb = b % 1024, swz = sb ^ (((sb >> 9) & 1) << 5); R = (st >> 1) * 16 + swz / 64; C = (st & 1) * 32 + (swz % 64) / 2; }
__host__ __device__ __forceinline__ int perm32(int rho) { const int n = rho >> 4, i = rho & 15; return 8 * (i >> 2) + 4 * n + (i & 3); }

struct Unit { int pm, pn; };
struct Gemm { const bf16_t* A; const bf16_t* Bt; int M, N, K; };

struct StaticOrder {
    int nM, nN, nwg, G, c;
    __device__ void init(int M, int N, int G_, int c_) { nM = M / BM; nN = N / BM; nwg = nM * nN; G = G_; c = c_; }
    __device__ bool next(int i, Unit& u) const {
        const long L = (long)i * G + c; if (L >= nwg) return false;
        int wgid = (int)L; { const int q = nwg / NXCD, r = nwg % NXCD, xcd = wgid % NXCD, off = wgid / NXCD; wgid = (xcd < r ? xcd * (q + 1) : r * (q + 1) + (xcd - r) * q) + off; }
        const int nig = WGM * nN, gid = wgid / nig, fm = gid * WGM, gsz = (nM - fm) < WGM ? (nM - fm) : WGM;
        u.pm = fm + ((wgid % nig) % gsz); u.pn = (wgid % nig) / gsz; return true;
    }
};
struct SingleUnit {
    bool has; Unit u0;
    __device__ bool next(int i, Unit& u) const { if (i == 0 && has) { u = u0; return true; } return false; }
};

template <bool F16 = false> struct EpiStore16 {
    static constexpr bool PERM = true, AFTER_DRAIN = false;
    bf16_t* O; int ldc;
    __device__ __forceinline__ void operator()(const f32x4 (&acc)[2][2][4][2], const Unit& u, int wr, int wc, int fr, int fq) const {
        const int row0 = u.pm * BM + wr * 64 + fr, col0 = u.pn * BM + wc * 32 + 8 * fq;
#pragma unroll
        for (int ai = 0; ai < 2; ++ai)
#pragma unroll
            for (int m = 0; m < 4; ++m) { bf16_t* rowp = O + (size_t)(row0 + ai * HALF + m * 16) * ldc + col0;
#pragma unroll
                for (int bj = 0; bj < 2; ++bj) { const f32x4 v0 = acc[ai][bj][m][0], v1 = acc[ai][bj][m][1];
                    u32x4 w; w.x = cvt_pk16<F16>(v0[0], v0[1]); w.y = cvt_pk16<F16>(v0[2], v0[3]); w.z = cvt_pk16<F16>(v1[0], v1[1]); w.w = cvt_pk16<F16>(v1[2], v1[3]);
                    *(u32x4*)(rowp + bj * HALF) = w; } }
    }
};
struct EpiStoreSplit {
    static constexpr bool PERM = true, AFTER_DRAIN = false;
    bf16_t* O0; bf16_t* O1;
    __device__ __forceinline__ void operator()(const f32x4 (&acc)[2][2][4][2], const Unit& u, int wr, int wc, int fr, int fq) const {
        const int row0 = u.pm * BM + wr * 64 + fr, col0 = (u.pn & 3) * BM + wc * 32 + 8 * fq;
        bf16_t* base = u.pn >= 4 ? O1 : O0;
#pragma unroll
        for (int ai = 0; ai < 2; ++ai)
#pragma unroll
            for (int m = 0; m < 4; ++m) { bf16_t* rowp = base + (size_t)(row0 + ai * HALF + m * 16) * 1024 + col0;
#pragma unroll
                for (int bj = 0; bj < 2; ++bj) { const f32x4 v0 = acc[ai][bj][m][0], v1 = acc[ai][bj][m][1];
                    u32x4 w; w.x = cvt_pk_bf16(v0[0], v0[1]); w.y = cvt_pk_bf16(v0[2], v0[3]); w.z = cvt_pk_bf16(v1[0], v1[1]); w.w = cvt_pk_bf16(v1[2], v1[3]);
                    *(u32x4*)(rowp + bj * HALF) = w; } }
    }
};
struct EpiAG1 {
    static constexpr bool PERM = true, AFTER_DRAIN = false;
    bf16_t* V; bf16_t* SG;
    __device__ __forceinline__ void operator()(const f32x4 (&acc)[2][2][4][2], const Unit& u, int wr, int wc, int fr, int fq) const {
        const bool isg = u.pn >= 8;
        const int row0 = u.pm * BM + wr * 64 + fr, col0 = (isg ? u.pn - 8 : u.pn) * BM + wc * 32 + 8 * fq;
        bf16_t* base = isg ? SG : V;
#pragma unroll
        for (int ai = 0; ai < 2; ++ai)
#pragma unroll
            for (int m = 0; m < 4; ++m) { bf16_t* rowp = base + (size_t)(row0 + ai * HALF + m * 16) * 2048 + col0;
#pragma unroll
                for (int bj = 0; bj < 2; ++bj) { f32x4 v0 = acc[ai][bj][m][0], v1 = acc[ai][bj][m][1];
                    if (isg) {
#pragma unroll
                        for (int j = 0; j < 4; ++j) { v0[j] = silu_f(v0[j]); v1[j] = silu_f(v1[j]); } }
                    u32x4 w; w.x = cvt_pk_bf16(v0[0], v0[1]); w.y = cvt_pk_bf16(v0[2], v0[3]); w.z = cvt_pk_bf16(v1[0], v1[1]); w.w = cvt_pk_bf16(v1[2], v1[3]);
                    *(u32x4*)(rowp + bj * HALF) = w; } }
    }
};
struct EpiGateMul {
    static constexpr bool PERM = true, AFTER_DRAIN = false;
    const bf16_t* Zin; bf16_t* Zout;
    __device__ __forceinline__ void operator()(const f32x4 (&acc)[2][2][4][2], const Unit& u, int wr, int wc, int fr, int fq) const {
        const int row0 = u.pm * BM + wr * 64 + fr, col0 = u.pn * BM + wc * 32 + 8 * fq;
#pragma unroll
        for (int ai = 0; ai < 2; ++ai)
#pragma unroll
            for (int m = 0; m < 4; ++m) { const size_t roff = (size_t)(row0 + ai * HALF + m * 16) * DM + col0; const bf16_t* rowp = Zin + roff; bf16_t* rowo = Zout + roff;
#pragma unroll
                for (int bj = 0; bj < 2; ++bj) { const f32x4 v0 = acc[ai][bj][m][0], v1 = acc[ai][bj][m][1];
                    const u32x4 h = *(const u32x4*)(rowp + bj * HALF);
                    u32x4 w;
                    w.x = cvt_pk_bf16(bf_lo(h.x) * silu_f(v0[0]), bf_hi(h.x) * silu_f(v0[1]));
                    w.y = cvt_pk_bf16(bf_lo(h.y) * silu_f(v0[2]), bf_hi(h.y) * silu_f(v0[3]));
                    w.z = cvt_pk_bf16(bf_lo(h.z) * silu_f(v1[0]), bf_hi(h.z) * silu_f(v1[1]));
                    w.w = cvt_pk_bf16(bf_lo(h.w) * silu_f(v1[2]), bf_hi(h.w) * silu_f(v1[3]));
                    *(u32x4*)(rowo + bj * HALF) = w; } }
    }
};
struct EpiKr {
    static constexpr bool PERM = true, AFTER_DRAIN = false;
    bf16_t* Kr;
    __device__ __forceinline__ void operator()(const f32x4 (&acc)[2][2][4][2], const Unit& u, int wr, int wc, int fr, int fq) const {
        const int row0 = u.pm * BM + wr * 64 + fr, col0 = u.pn * BM + wc * 32 + 8 * fq;
        const int g = u.pn >> 2, dsh = 2 * g;
#pragma unroll
        for (int ai = 0; ai < 2; ++ai)
#pragma unroll
            for (int m = 0; m < 4; ++m) { const int t = row0 + ai * HALF + m * 16, b = t >> 12, s = t & 4095, r = s & ((1 << dsh) - 1), i = s >> dsh;
                const int rowidx = r * (SEQ >> dsh) + i;
#pragma unroll
                for (int bj = 0; bj < 2; ++bj) { const f32x4 v0 = acc[ai][bj][m][0], v1 = acc[ai][bj][m][1];
                    const int col = col0 + bj * HALF, hh = (col >> 6) & 15, d0 = col & 63;
                    u32x4 w; w.x = cvt_pk_bf16(v0[0], v0[1]); w.y = cvt_pk_bf16(v0[2], v0[3]); w.z = cvt_pk_bf16(v1[0], v1[1]); w.w = cvt_pk_bf16(v1[2], v1[3]);
                    *(u32x4*)(Kr + ((size_t)(((g * 16 + hh) * 4 + b) * SEQ + rowidx)) * 64 + d0) = w; } }
    }
};
template <int DSH> struct EpiVt {
    static constexpr bool PERM = true, AFTER_DRAIN = false;
    bf16_t* Vt;
    __device__ __forceinline__ void operator()(const f32x4 (&acc)[2][2][4][2], const Unit& u, int wr, int wc, int fr, int fq) const {
        const int row0 = u.pm * BM + wr * 64 + fr;
        const int t_tile = u.pn * BM, b = t_tile >> 12, s_tile = t_tile & 4095;
#pragma unroll
        for (int ai = 0; ai < 2; ++ai)
#pragma unroll
            for (int m = 0; m < 4; ++m) { bf16_t* rowp = Vt + (size_t)(row0 + ai * HALF + m * 16) * MT + b * SEQ + (s_tile >> DSH);
#pragma unroll
                for (int bj = 0; bj < 2; ++bj) { const f32x4 v0 = acc[ai][bj][m][0], v1 = acc[ai][bj][m][1];
                    const int c = bj * HALF + wc * 32 + 8 * fq, r = c >> (8 - DSH), il = c & ((256 >> DSH) - 1);
                    u32x4 w; w.x = cvt_pk_bf16(v0[0], v0[1]); w.y = cvt_pk_bf16(v0[2], v0[3]); w.z = cvt_pk_bf16(v1[0], v1[1]); w.w = cvt_pk_bf16(v1[2], v1[3]);
                    *(u32x4*)(rowp + r * (SEQ >> DSH) + il) = w; } }
    }
};

template <bool RES_F32, bool OUT_F, bool OUT_B, bool F16 = false> struct EpiLnFused {
    static constexpr bool PERM = false, AFTER_DRAIN = true;
    const float* hin_f; const bf16_t* hin_b;
    float* out_f; bf16_t* out_b;
    const float* gam; const float* bet;
    unsigned long long* xbuf; unsigned* cnt; unsigned want;
    __device__ __forceinline__ void fused(f32x4 (&acc)[2][2][4][2], const Unit& u, int wr, int wc, int fr, int fq, LAS unsigned char* lds, int wid, int lane) const {
        LAS f32x2* P = (LAS f32x2*)lds;
        LAS f32x2* S = (LAS f32x2*)(lds + 8192);
        const int col0 = u.pn * BM + wc * 32 + 4 * fq;
#pragma unroll
        for (int ai = 0; ai < 2; ++ai)
#pragma unroll
            for (int mp = 0; mp < 2; ++mp) {
                f32x4 hb_[2][2][2];
#pragma unroll
                for (int mi = 0; mi < 2; ++mi) { const int m = mp * 2 + mi; const unsigned off = (unsigned)(u.pm * BM + ai * HALF + wr * 64 + m * 16 + fr) * DM + col0;
#pragma unroll
                    for (int bj = 0; bj < 2; ++bj)
#pragma unroll
                        for (int n = 0; n < 2; ++n) {
                            if constexpr (RES_F32) hb_[mi][bj][n] = *(const f32x4*)(hin_f + off + bj * HALF + n * 16);
                            else { const u32x2 w = *(const u32x2*)(hin_b + off + bj * HALF + n * 16); hb_[mi][bj][n] = (f32x4){__uint_as_float(w.x), __uint_as_float(w.y), 0.f, 0.f}; } } }
                asm volatile("" : "+v"(hb_[0][0][0]), "+v"(hb_[0][0][1]), "+v"(hb_[0][1][0]), "+v"(hb_[0][1][1]), "+v"(hb_[1][0][0]), "+v"(hb_[1][0][1]), "+v"(hb_[1][1][0]), "+v"(hb_[1][1][1]));
#pragma unroll
                for (int mi = 0; mi < 2; ++mi) { const int m = mp * 2 + mi;
#pragma unroll
                    for (int bj = 0; bj < 2; ++bj)
#pragma unroll
                        for (int n = 0; n < 2; ++n) { f32x4 h = hb_[mi][bj][n];
                            if constexpr (!RES_F32) { const unsigned wx = __float_as_uint(h[0]), wy = __float_as_uint(h[1]); if constexpr (F16) h = (f32x4){h_lo(wx), h_hi(wx), h_lo(wy), h_hi(wy)}; else h = (f32x4){bf_lo(wx), bf_hi(wx), bf_lo(wy), bf_hi(wy)}; }
                            acc[ai][bj][m][n] = h * DN_ALPHA + acc[ai][bj][m][n]; }
                    asm volatile("" : "+v"(acc[ai][0][m][0]), "+v"(acc[ai][0][m][1]), "+v"(acc[ai][1][m][0]), "+v"(acc[ai][1][m][1])); }
                asm volatile("" ::: "memory"); }
#pragma unroll
        for (int ai = 0; ai < 2; ++ai)
#pragma unroll
            for (int m = 0; m < 4; ++m) {
                float s = 0.f;
#pragma unroll
                for (int bj = 0; bj < 2; ++bj)
#pragma unroll
                    for (int n = 0; n < 2; ++n) { const f32x4 x = acc[ai][bj][m][n]; s += (x[0] + x[1]) + (x[2] + x[3]); }
                s += __shfl_xor(s, 16); s += __shfl_xor(s, 32);
                const float mw = s * (1.0f / 64.0f); float qq = 0.f;
#pragma unroll
                for (int bj = 0; bj < 2; ++bj)
#pragma unroll
                    for (int n = 0; n < 2; ++n) { const f32x4 d = acc[ai][bj][m][n] - mw; qq += (d[0] * d[0] + d[1] * d[1]) + (d[2] * d[2] + d[3] * d[3]); }
                qq += __shfl_xor(qq, 16); qq += __shfl_xor(qq, 32);
                if (fq == 0) P[(ai * HALF + wr * 64 + m * 16 + fr) * 4 + wc] = (f32x2){mw, qq};
            }
        asm volatile("s_waitcnt lgkmcnt(0)" ::: "memory"); __builtin_amdgcn_s_barrier(); asm volatile("" ::: "memory");
        const int row = wid * 32 + (lane & 31);
        if (lane < 32) {
            const f32x2 a = P[row * 4 + 0], b = P[row * 4 + 1], c = P[row * 4 + 2], d = P[row * 4 + 3];
            const float mt = (a.x + b.x + c.x + d.x) * 0.25f;
            const float da = a.x - mt, db = b.x - mt, dc = c.x - mt, dd = d.x - mt;
            const float m2 = (a.y + b.y) + (c.y + d.y) + 64.0f * ((da * da + db * db) + (dc * dc + dd * dd));
            unsigned long long* slot = xbuf + ((size_t)(u.pm * BM + row) * 4 + u.pn);
            __hip_atomic_store(slot, ((unsigned long long)__float_as_uint(m2) << 32) | __float_as_uint(mt), __ATOMIC_RELAXED, __HIP_MEMORY_SCOPE_AGENT);
        }
        asm volatile("s_waitcnt vmcnt(0)" ::: "memory");
        if (lane == 0) __hip_atomic_fetch_add(cnt + 64 * u.pm, 1u, __ATOMIC_RELAXED, __HIP_MEMORY_SCOPE_AGENT);
        if (wid == 0) {
            unsigned sp = 0;
            while ((unsigned)__builtin_amdgcn_readfirstlane(__hip_atomic_load(cnt + 64 * u.pm, __ATOMIC_RELAXED, __HIP_MEMORY_SCOPE_AGENT)) < want) { __builtin_amdgcn_s_sleep(2); if (++sp > (1u << 22)) break; }
            __builtin_amdgcn_fence(__ATOMIC_ACQUIRE, "agent");
        }
        asm volatile("s_waitcnt vmcnt(0) lgkmcnt(0)" ::: "memory"); __builtin_amdgcn_s_barrier(); asm volatile("" ::: "memory");
        if (lane < 32) {
            const unsigned long long* slot = xbuf + (size_t)(u.pm * BM + row) * 4; float mt[4], m2[4]; float ms = 0.f;
#pragma unroll
            for (int t = 0; t < 4; ++t) { const unsigned long long w = __hip_atomic_load(slot + t, __ATOMIC_RELAXED, __HIP_MEMORY_SCOPE_AGENT); mt[t] = __uint_as_float((unsigned)w); m2[t] = __uint_as_float((unsigned)(w >> 32)); ms += mt[t]; }
            const float mean = ms * 0.25f; float qq = 0.f;
#pragma unroll
            for (int t = 0; t < 4; ++t) { const float dm = mt[t] - mean; qq += m2[t] + 256.0f * dm * dm; }
            S[row] = (f32x2){mean, 1.0f / sqrtf(qq * (1.0f / 1024.0f) + LN_EPS)};
        }
        asm volatile("s_waitcnt lgkmcnt(0)" ::: "memory"); __builtin_amdgcn_s_barrier(); asm volatile("" ::: "memory");
        f32x2 sr[2][4];
#pragma unroll
        for (int ai = 0; ai < 2; ++ai)
#pragma unroll
            for (int m = 0; m < 4; ++m) sr[ai][m] = S[ai * HALF + wr * 64 + m * 16 + fr];
#pragma unroll
        for (int bj = 0; bj < 2; ++bj)
#pragma unroll
            for (int n = 0; n < 2; ++n) { const f32x4 gv = *(const f32x4*)(gam + col0 + bj * HALF + n * 16), bv = *(const f32x4*)(bet + col0 + bj * HALF + n * 16);
#pragma unroll
                for (int ai = 0; ai < 2; ++ai)
#pragma unroll
                    for (int m = 0; m < 4; ++m) { const int r = ai * HALF + wr * 64 + m * 16 + fr; const unsigned off = (unsigned)(u.pm * BM + r) * DM + col0 + bj * HALF + n * 16;
                        const f32x4 o = (acc[ai][bj][m][n] - sr[ai][m].x) * sr[ai][m].y * gv + bv;
                        if constexpr (OUT_F) *(f32x4*)(out_f + off) = o;
                        if constexpr (OUT_B) { u32x2 w; w.x = cvt_pk16<F16>(o[0], o[1]); w.y = cvt_pk16<F16>(o[2], o[3]); *(u32x2*)(out_b + off) = w; } } }
    }
};

template <class Epi, class Sched, int DSH = 0, bool F16 = false, bool SP2 = true, bool ALIGN_EPI = true>
__device__ __forceinline__ void gemm_phase(LAS unsigned char* lds, const Gemm g, const Sched& S, const Epi& E) {
    const int tid = opaque(threadIdx.x), wid = __builtin_amdgcn_readfirstlane(tid >> 6), lane = tid & 63, wr = wid >> 2, wc = wid & 3, fr = lane & 15, fq = lane >> 4;
    const int K = g.K, nt = K / BK;
    unsigned voffA[2], voffB[2], voffB1[2];
#pragma unroll
    for (int i = 0; i < 2; ++i) { int R, C; stage_rc(tid * 16 + i * 8192, R, C); const int Rb = Epi::PERM ? ((R & ~31) + perm32(R & 31)) : R;
        voffA[i] = (unsigned)(R * K + C) * 2u;
        if constexpr (DSH == 0) { voffB[i] = (unsigned)(Rb * K + C) * 2u; voffB1[i] = (unsigned)((Rb + HALF) * K + C) * 2u; }
        else { const int c0_ = Rb, c1_ = Rb + HALF; const int t0_ = ((c0_ & ((256 >> DSH) - 1)) << DSH) + (c0_ >> (8 - DSH)), t1_ = ((c1_ & ((256 >> DSH) - 1)) << DSH) + (c1_ >> (8 - DSH));
            voffB[i] = (unsigned)(t0_ * K + C) * 2u; voffB1[i] = (unsigned)(t1_ * K + C) * 2u; } }
    const size_t kstep = (size_t)(BK * 2);
    const size_t hstep = (size_t)HALF * K * 2;
    const size_t tstep = 2 * hstep;
    const unsigned ldsw = (unsigned)wid * 1024u;
    const int aoff = lds_byte(wr * 64 + fr, fq * 8), boff = lds_byte(wc * 32 + fr, fq * 8);
#define PG8_SA(b, h) (((b) * 2 + (h)) * HTB)
#define PG8_SB(b, h) ((4 + (b) * 2 + (h)) * HTB)
#define PG8_STAGE(bufoff, gbase, voff) do { _Pragma("unroll") for (int _i = 0; _i < 2; ++_i) \
        __builtin_amdgcn_global_load_lds((const unsigned*)((const char*)(gbase) + (voff)[_i]), (LAS unsigned*)(lds + (bufoff) + ldsw + _i * 8192), 16, 0, 0); } while (0)
#define PG8_LDA(dst, b, h) do { _Pragma("unroll") for (int m = 0; m < 4; ++m) _Pragma("unroll") for (int k = 0; k < 2; ++k) dst[m][k] = *(const LAS bf16x8*)(lds + PG8_SA(b, h) + aoff + m * 2048 + k * 1024); } while (0)
#define PG8_LDB(dst, b, h) do { _Pragma("unroll") for (int n = 0; n < 2; ++n) _Pragma("unroll") for (int k = 0; k < 2; ++k) dst[n][k] = *(const LAS bf16x8*)(lds + PG8_SB(b, h) + boff + n * 2048 + k * 1024); } while (0)
#define PG8_MMA(ai, bj, At, Bt) do { __builtin_amdgcn_s_setprio(1); _Pragma("unroll") for (int m = 0; m < 4; ++m) _Pragma("unroll") for (int n = 0; n < 2; ++n) _Pragma("unroll") for (int k = 0; k < 2; ++k) \
        acc[ai][bj][m][n] = F16 ? __builtin_amdgcn_mfma_f32_16x16x32_f16(__builtin_bit_cast(half8, Bt[n][k]), __builtin_bit_cast(half8, At[m][k]), acc[ai][bj][m][n], 0, 0, 0) : __builtin_amdgcn_mfma_f32_16x16x32_bf16(Bt[n][k], At[m][k], acc[ai][bj][m][n], 0, 0, 0); __builtin_amdgcn_s_setprio(0); } while (0)
#define PG8_WAIT_V(n) asm volatile("s_waitcnt vmcnt(" #n ")" ::: "memory")
#define PG8_WAIT_L(n) asm volatile("s_waitcnt lgkmcnt(" #n ")" ::: "memory")
#define PG8_BAR __builtin_amdgcn_s_barrier()
#define PG8_SCHED __builtin_amdgcn_sched_barrier(0)
    Unit cur, nxt; int ui = 0;
    if (!S.next(0, cur)) return;
    f32x4 acc[2][2][4][2];
#pragma unroll
    for (int a = 0; a < 2; ++a)
#pragma unroll
        for (int b = 0; b < 2; ++b)
#pragma unroll
            for (int m = 0; m < 4; ++m)
#pragma unroll
                for (int n = 0; n < 2; ++n) acc[a][b][m][n] = (f32x4){0.f, 0.f, 0.f, 0.f};
    bf16x8 At[4][2], B0[2][2], B1[2][2];
    const char* cA = (const char*)g.A + (size_t)cur.pm * tstep; const char* cB = (const char*)g.Bt + (size_t)cur.pn * tstep;
    if constexpr (SP2) {
        PG8_STAGE(PG8_SB(0, 0), cB, voffB); PG8_STAGE(PG8_SB(0, 1), cB, voffB1); PG8_STAGE(PG8_SA(0, 0), cA, voffA); PG8_STAGE(PG8_SA(0, 1), cA + hstep, voffA);
        if (wr == 1) PG8_BAR;
        PG8_WAIT_V(2); PG8_BAR;
        PG8_STAGE(PG8_SB(1, 0), cB + kstep, voffB); PG8_STAGE(PG8_SA(1, 0), cA + kstep, voffA); PG8_STAGE(PG8_SB(1, 1), cB + kstep, voffB1);
        PG8_WAIT_V(6); PG8_BAR;
    } else {
    PG8_STAGE(PG8_SB(0, 0), cB, voffB); PG8_STAGE(PG8_SA(0, 0), cA, voffA); PG8_STAGE(PG8_SB(0, 1), cB, voffB1); PG8_STAGE(PG8_SA(0, 1), cA + hstep, voffA);
    if (wr == 1) PG8_BAR;
    PG8_WAIT_V(4); PG8_BAR;
    PG8_STAGE(PG8_SB(1, 0), cB + kstep, voffB); PG8_STAGE(PG8_SA(1, 0), cA + kstep, voffA); PG8_STAGE(PG8_SB(1, 1), cB + kstep, voffB1);
    PG8_WAIT_V(6); PG8_BAR;
    }
    for (;;) {
        const bool has_next = S.next(ui + 1, nxt);
        const char* nA = has_next ? (const char*)g.A + (size_t)nxt.pm * tstep : cA; const char* nB = has_next ? (const char*)g.Bt + (size_t)nxt.pn * tstep : cB;
        for (int t = 0; t < nt; t += 2) {
            const bool last = (t == nt - 2);
            const char* a1 = cA + (size_t)(t + 1) * kstep;
            const char* a2 = last ? nA : cA + (size_t)(t + 2) * kstep; const char* b2 = last ? nB : cB + (size_t)(t + 2) * kstep;
            const char* a3 = a2 + kstep; const char* b3 = b2 + kstep;
            if constexpr (SP2) {
            PG8_LDB(B0, 0, 0); PG8_LDB(B1, 0, 1); PG8_SCHED; PG8_LDA(At, 0, 0); PG8_STAGE(PG8_SA(1, 1), a1 + hstep, voffA);
            PG8_WAIT_V(8); PG8_WAIT_L(0); PG8_BAR; PG8_MMA(0, 0, At, B0); PG8_MMA(0, 1, At, B1); PG8_BAR; PG8_SCHED;
            PG8_LDA(At, 0, 1); PG8_STAGE(PG8_SB(0, 0), b2, voffB); PG8_STAGE(PG8_SB(0, 1), b2, voffB1); PG8_STAGE(PG8_SA(0, 0), a2, voffA);
            PG8_WAIT_V(8); PG8_WAIT_L(0); PG8_BAR; PG8_MMA(1, 0, At, B0); PG8_MMA(1, 1, At, B1); PG8_BAR; PG8_SCHED;
            PG8_LDB(B0, 1, 0); PG8_LDB(B1, 1, 1); PG8_SCHED; PG8_LDA(At, 1, 0); PG8_STAGE(PG8_SA(0, 1), a2 + hstep, voffA);
            PG8_WAIT_V(8); PG8_WAIT_L(0); PG8_BAR; PG8_MMA(0, 0, At, B0); PG8_MMA(0, 1, At, B1); PG8_BAR; PG8_SCHED;
            PG8_LDA(At, 1, 1); PG8_STAGE(PG8_SB(1, 0), b3, voffB); PG8_STAGE(PG8_SB(1, 1), b3, voffB1); PG8_STAGE(PG8_SA(1, 0), a3, voffA);
            PG8_WAIT_V(8); PG8_WAIT_L(0); PG8_BAR; PG8_MMA(1, 0, At, B0); PG8_MMA(1, 1, At, B1); PG8_BAR; PG8_SCHED;
            } else {
            PG8_LDB(B0, 0, 0); PG8_SCHED; PG8_LDA(At, 0, 0); PG8_STAGE(PG8_SA(1, 1), a1 + hstep, voffA);
            PG8_WAIT_L(8); PG8_BAR; PG8_WAIT_L(0); PG8_MMA(0, 0, At, B0); PG8_BAR; PG8_SCHED;
            PG8_LDB(B1, 0, 1); PG8_STAGE(PG8_SB(0, 0), b2, voffB);
            PG8_BAR; PG8_WAIT_L(0); PG8_MMA(0, 1, At, B1); PG8_BAR;
            PG8_LDA(At, 0, 1); PG8_STAGE(PG8_SA(0, 0), a2, voffA);
            PG8_BAR; PG8_WAIT_L(0); PG8_MMA(1, 0, At, B0); PG8_BAR; PG8_SCHED;
            PG8_STAGE(PG8_SB(0, 1), b2, voffB1);
            PG8_WAIT_V(6); PG8_BAR; PG8_MMA(1, 1, At, B1); PG8_BAR;
            PG8_LDB(B0, 1, 0); PG8_SCHED; PG8_LDA(At, 1, 0); PG8_STAGE(PG8_SA(0, 1), a2 + hstep, voffA);
            PG8_WAIT_L(8); PG8_BAR; PG8_WAIT_L(0); PG8_MMA(0, 0, At, B0); PG8_BAR; PG8_SCHED;
            PG8_LDB(B1, 1, 1); PG8_STAGE(PG8_SB(1, 0), b3, voffB);
            PG8_BAR; PG8_WAIT_L(0); PG8_MMA(0, 1, At, B1); PG8_BAR;
            PG8_LDA(At, 1, 1); PG8_STAGE(PG8_SA(1, 0), a3, voffA);
            PG8_BAR; PG8_WAIT_L(0); PG8_MMA(1, 0, At, B0); PG8_BAR; PG8_SCHED;
            PG8_STAGE(PG8_SB(1, 1), b3, voffB1);
            PG8_WAIT_V(6); PG8_BAR; PG8_MMA(1, 1, At, B1); PG8_BAR;
            }
        }
        if constexpr (ALIGN_EPI) { if (wr == 0) PG8_BAR; }
        if constexpr (!Epi::AFTER_DRAIN) E(acc, cur, wr, wc, fr, fq);
        if (!has_next) break;
#pragma unroll
        for (int a = 0; a < 2; ++a)
#pragma unroll
            for (int b = 0; b < 2; ++b)
#pragma unroll
                for (int m = 0; m < 4; ++m)
#pragma unroll
                    for (int n = 0; n < 2; ++n) acc[a][b][m][n] = (f32x4){0.f, 0.f, 0.f, 0.f};
        cur = nxt; cA = nA; cB = nB; ++ui;
        if constexpr (ALIGN_EPI) { if (wr == 1) PG8_BAR; }
    }
    PG8_WAIT_V(0);
    if constexpr (!ALIGN_EPI) { if (wr == 0) PG8_BAR; }
    PG8_BAR;
    if constexpr (Epi::AFTER_DRAIN) E.fused(acc, cur, wr, wc, fr, fq, lds, wid, lane);
#undef PG8_SA
#undef PG8_SB
#undef PG8_STAGE
#undef PG8_LDA
#undef PG8_LDB
#undef PG8_MMA
#undef PG8_WAIT_V
#undef PG8_WAIT_L
#undef PG8_BAR
#undef PG8_SCHED
}


#define XB_TMO      128
#define XB_XCNT(j)  (256  + 64 * (j))
#define XB_XSUB(j)  (1280 + 64 * (j))
#define XB_XGEN(j)  (2304 + 64 * (j))
#define XB_TOP      3328
#define XB_TOPGEN   3392
#define XCD_BAR_WORDS 3456
#define XB_SPIN_CAP (1u << 18)
__device__ __forceinline__ unsigned xb_ld(unsigned* p)              { return __hip_atomic_load(p, __ATOMIC_RELAXED, __HIP_MEMORY_SCOPE_AGENT); }
__device__ __forceinline__ unsigned xb_add(unsigned* p, unsigned v) { return __hip_atomic_fetch_add(p, v, __ATOMIC_RELAXED, __HIP_MEMORY_SCOPE_AGENT); }
__device__ __forceinline__ unsigned xb_xcc_id() { return (unsigned)__builtin_amdgcn_s_getreg((3 << 11) | 20) & 0xFu; }
#define XB_SPIN(cond, bar) do { unsigned _sp = 0; while (cond) { __builtin_amdgcn_s_sleep(1); \
    if ((++_sp & 255u) == 0u) { if (xb_ld(&(bar)[XB_TMO])) break; if (_sp > XB_SPIN_CAP) { atomicAdd(&(bar)[XB_TMO], 1u); break; } } } } while (0)
struct XcdBarrier { unsigned* bar; unsigned x; volatile LAS unsigned* st; };
__device__ __forceinline__ XcdBarrier xcd_barrier_post(unsigned* bar, volatile LAS unsigned* st) {
    XcdBarrier b; b.bar = bar; b.x = xb_xcc_id(); b.st = st;
    if (threadIdx.x == 0) (void)xb_add(&bar[XB_XCNT(b.x)], 1u);
    return b;
}
__device__ __forceinline__ void xcd_barrier_complete(unsigned* bar, unsigned x, unsigned& nloc, unsigned& nx) {
    const unsigned G = gridDim.x * gridDim.y * gridDim.z;
    unsigned sum, cnt, mine, sp = 0u;
    for (;;) {
        sum = 0u; cnt = 0u; mine = 0u;
#pragma unroll
        for (unsigned j = 0; j < 16; ++j) { const unsigned c = xb_ld(&bar[XB_XCNT(j)]); sum += c; cnt += (c > 0u) ? 1u : 0u; mine = (j == x) ? c : mine; }
        if (sum == G) break;
        __builtin_amdgcn_s_sleep(1);
        if ((++sp & 255u) == 0u) { if (xb_ld(&bar[XB_TMO])) break; if (sp > XB_SPIN_CAP) { atomicAdd(&bar[XB_TMO], 1u); break; } }
    }
    nloc = mine > 0u ? mine : 1u; nx = cnt > 0u ? cnt : 1u;
}
__device__ __forceinline__ void xcd_barrier(const XcdBarrier& b) {
    asm volatile("s_waitcnt vmcnt(0)" ::: "memory");
    __syncthreads();
    if (threadIdx.x == 0) {
        unsigned* bar = b.bar;
        const unsigned bx = xb_xcc_id();
        __builtin_amdgcn_s_waitcnt(0);
        unsigned nloc = b.st[0], nx = b.st[1];
        if (nloc == 0u) { xcd_barrier_complete(bar, bx, nloc, nx); b.st[0] = nloc; b.st[1] = nx; }
        const unsigned old = xb_add(&bar[XB_XSUB(bx)], 1u);
        const unsigned gen = old / nloc;
        if (old + 1u == (gen + 1u) * nloc) {
            __builtin_amdgcn_fence(__ATOMIC_RELEASE, "agent");
            asm volatile("s_waitcnt vmcnt(0)" ::: "memory");
            const unsigned og = xb_add(&bar[XB_TOP], 1u);
            const unsigned tg = og / nx;
            if (og + 1u == (tg + 1u) * nx) xb_add(&bar[XB_TOPGEN], 1u);
            else XB_SPIN(xb_ld(&bar[XB_TOPGEN]) == tg, bar);
            __builtin_amdgcn_fence(__ATOMIC_ACQUIRE, "agent");
            xb_add(&bar[XB_XGEN(bx)], 1u);
            asm volatile("s_waitcnt vmcnt(0)" ::: "memory");
        } else {
            XB_SPIN(xb_ld(&bar[XB_XGEN(bx)]) == gen, bar);
            __builtin_amdgcn_fence(__ATOMIC_ACQUIRE, "agent");
            asm volatile("s_waitcnt vmcnt(0)" ::: "memory");
        }
    }
    __syncthreads();
}

template <bool F16 = false>
__device__ __forceinline__ void tp_job(const float* src, size_t smat, int lsrc, int coff, bf16_t* dst, size_t dmat, int ldd, int R, int C, int nmat, LAS float* scr) {
    const int tid = opaque(threadIdx.x);
    const int ntc = C / 64, per = (R / 64) * ntc, total = per * nmat;
    const int G = gridDim.x;
    f32x4 v[2];
    int t = blockIdx.x;
#define TP_LOAD(tt_) do { const int i_ = (tt_) / per, t2_ = (tt_) % per, tr_ = t2_ / ntc, tc_ = t2_ % ntc; const float* s_ = src + (size_t)i_ * smat + coff; \
        _Pragma("unroll") for (int k_ = 0; k_ < 2; ++k_) { const int idx_ = tid + 512 * k_, row_ = idx_ >> 4, c4_ = idx_ & 15; v[k_] = *(const f32x4*)(s_ + (size_t)(tr_ * 64 + row_) * lsrc + tc_ * 64 + c4_ * 4); } } while (0)
    if (t < total) TP_LOAD(t);
#pragma unroll 1
    for (; t < total; t += G) {
#pragma unroll
        for (int k = 0; k < 2; ++k) { const int idx = tid + 512 * k, row = idx >> 4, c4 = idx & 15; LAS float* pp = scr + row * 65 + c4 * 4; pp[0] = v[k][0]; pp[1] = v[k][1]; pp[2] = v[k][2]; pp[3] = v[k][3]; }
        if (t + G < total) TP_LOAD(t + G);
        __syncthreads();
        { const int i = t / per, t2 = t % per, tr = t2 / ntc, tc = t2 % ntc; bf16_t* d = dst + (size_t)i * dmat;
          const int c = tid >> 3, ch = tid & 7; const LAS float* sp = scr + (ch * 8) * 65 + c;
          u32x4 o; o.x = cvt_pk16<F16>(sp[0], sp[65]); o.y = cvt_pk16<F16>(sp[2 * 65], sp[3 * 65]); o.z = cvt_pk16<F16>(sp[4 * 65], sp[5 * 65]); o.w = cvt_pk16<F16>(sp[6 * 65], sp[7 * 65]);
          *(u32x4*)(d + (size_t)(tc * 64 + c) * ldd + tr * 64 + ch * 8) = o; }
        __syncthreads();
    }
#undef TP_LOAD
}

struct Params {
    const float *x, *w_in_a, *w_grp_a, *scale_a, *w_out_a, *w_kv, *w_in_b, *w_out_b, *ln_g, *ln_b;
    float* out; unsigned char* ws;
};

__device__ __forceinline__ void phase_prep(const Params& p, LAS unsigned char* lds) {
    LAS float* scr = (LAS float*)lds;
    unsigned char* ws = p.ws;
    tp_job<true>(p.w_in_a, (size_t)1024 * 4096, 4096, 2048, (bf16_t*)(ws + OFF_BTA) + (size_t)2048 * 1024, (size_t)4096 * 1024, 1024, 1024, 2048, 2, scr);
    tp_job(p.w_out_a, (size_t)2048 * 1024, 1024, 0, (bf16_t*)(ws + OFF_WOA), (size_t)1024 * 2048, 2048, 2048, 1024, 2, scr);
    tp_job<true>(p.w_kv, 0, 6144, 0, (bf16_t*)(ws + OFF_KVT), 0, 1024, 1024, 6144, 1, scr);
    tp_job<true>(p.w_in_b, (size_t)1024 * 4096, 4096, 0, (bf16_t*)(ws + OFF_INB), (size_t)4096 * 1024, 1024, 1024, 4096, 2, scr);
    tp_job<true>(p.w_grp_a, (size_t)512 * 512, 512, 0, (bf16_t*)(ws + OFF_WGT), (size_t)512 * 512, 512, 512, 512, 8, scr);
    { bf16_t* winu = (bf16_t*)(ws + OFF_WINU);
      const int total = 2 * 4 * 1024 * 64;
      const int tid = opaque(threadIdx.x);
#pragma unroll 1
      for (int i0 = blockIdx.x * 512 + tid; i0 < total; i0 += gridDim.x * 512 * 4) {
          f32x4 a[4], b[4];
#pragma unroll
          for (int u = 0; u < 4; ++u) { const int i = i0 + u * gridDim.x * 512; if (i < total) { const int c8 = i & 63, k = (i >> 6) & 1023, lg = i >> 16, l = lg >> 2, g = lg & 3;
              const float* s = p.w_in_a + ((size_t)l * 1024 + k) * 4096 + g * 512 + c8 * 8; a[u] = *(const f32x4*)s; b[u] = *(const f32x4*)(s + 4); } }
#pragma unroll
          for (int u = 0; u < 4; ++u) { const int i = i0 + u * gridDim.x * 512; if (i < total) {
              u32x4 o; o.x = cvt_pk_f16(a[u][0], a[u][1]); o.y = cvt_pk_f16(a[u][2], a[u][3]); o.z = cvt_pk_f16(b[u][0], b[u][1]); o.w = cvt_pk_f16(b[u][2], b[u][3]);
              *(u32x4*)(winu + (size_t)i * 8) = o; } } } }
    { bf16_t* hb = (bf16_t*)(ws + OFF_HB);
      const int total = MT * DM / 8;
      const int tid = opaque(threadIdx.x);
#pragma unroll 1
      for (int i0 = blockIdx.x * 512 + tid; i0 < total; i0 += gridDim.x * 512 * 4) {
          f32x4 a[4], b[4];
#pragma unroll
          for (int u = 0; u < 4; ++u) { const int i = i0 + u * gridDim.x * 512; if (i < total) { const float* s = p.x + (size_t)i * 8; a[u] = *(const f32x4*)s; b[u] = *(const f32x4*)(s + 4); } }
#pragma unroll
          for (int u = 0; u < 4; ++u) { const int i = i0 + u * gridDim.x * 512; if (i < total) {
              u32x4 o; o.x = cvt_pk_f16(a[u][0], a[u][1]); o.y = cvt_pk_f16(a[u][2], a[u][3]); o.z = cvt_pk_f16(b[u][0], b[u][1]); o.w = cvt_pk_f16(b[u][2], b[u][3]);
              *(u32x4*)(hb + (size_t)i * 8) = o; } } } }
}

__device__ __forceinline__ void unpack8(const u32x4 w, float (&f)[8]) { f[0] = bf_lo(w.x); f[1] = bf_hi(w.x); f[2] = bf_lo(w.y); f[3] = bf_hi(w.y); f[4] = bf_lo(w.z); f[5] = bf_hi(w.z); f[6] = bf_lo(w.w); f[7] = bf_hi(w.w); }
template <int W>
__device__ __forceinline__ void pool_item(const bf16_t* V, bf16_t* SG, const float (&sc)[8], int t0, int c0) {
    const int s0 = t0 & (SEQ - 1);
    u32x4 rows[W + 3], gts[4];
#pragma unroll
    for (int j = 0; j < W + 3; ++j) { const int dt = j - (W - 1); rows[j] = (u32x4){0u, 0u, 0u, 0u}; if (s0 + dt >= 0) rows[j] = *(const u32x4*)(V + (size_t)(t0 + dt) * 2048 + c0); }
#pragma unroll
    for (int i = 0; i < 4; ++i) gts[i] = *(const u32x4*)(SG + (size_t)(t0 + i) * 2048 + c0);
    float sum[8];
#pragma unroll
    for (int j = 0; j < 8; ++j) sum[j] = 0.f;
#pragma unroll
    for (int j = 0; j < W - 1; ++j) { float f[8]; unpack8(rows[j], f);
#pragma unroll
        for (int k = 0; k < 8; ++k) sum[k] += f[k]; }
#pragma unroll
    for (int i = 0; i < 4; ++i) {
        float f[8], gt[8]; unpack8(rows[W - 1 + i], f); unpack8(gts[i], gt);
#pragma unroll
        for (int k = 0; k < 8; ++k) sum[k] += f[k];
        const int s = s0 + i; const float inv = 1.0f / (float)(s + 1 < W ? s + 1 : W);
        float o[8];
#pragma unroll
        for (int k = 0; k < 8; ++k) o[k] = (sum[k] * inv - f[k]) * sc[k] * gt[k];
        u32x4 wv; wv.x = cvt_pk_bf16(o[0], o[1]); wv.y = cvt_pk_bf16(o[2], o[3]); wv.z = cvt_pk_bf16(o[4], o[5]); wv.w = cvt_pk_bf16(o[6], o[7]);
        *(u32x4*)(SG + (size_t)(t0 + i) * 2048 + c0) = wv;
        float fo[8]; unpack8(rows[i], fo);
#pragma unroll
        for (int k = 0; k < 8; ++k) sum[k] -= fo[k];
    }
}
__device__ __forceinline__ void phase_pool(const bf16_t* V, bf16_t* SG, const float* scale) {
    const int tid = opaque(threadIdx.x), cth = tid & 255, sub = tid >> 8;
    const int c0 = cth * 8, grp = c0 >> 9;
    float sc[8];
    { const f32x4 a = *(const f32x4*)(scale + c0), b = *(const f32x4*)(scale + c0 + 4); sc[0] = a[0]; sc[1] = a[1]; sc[2] = a[2]; sc[3] = a[3]; sc[4] = b[0]; sc[5] = b[1]; sc[6] = b[2]; sc[7] = b[3]; }
    const int qper = (MT / 4) / (int)gridDim.x;
#pragma unroll 1
    for (int qi = sub; qi < qper; qi += 2) {
        const int q = blockIdx.x * qper + qi;
        const int t0 = q * 4;
        if (grp == 0) pool_item<2>(V, SG, sc, t0, c0);
        else if (grp == 1) pool_item<4>(V, SG, sc, t0, c0);
        else if (grp == 2) pool_item<8>(V, SG, sc, t0, c0);
        else pool_item<16>(V, SG, sc, t0, c0);
    }
}

template <int V_> struct AttIC { static constexpr int value = V_; };
struct AttGeo { int dsh, dil, L, nblk, g; };
__device__ __forceinline__ void att_decode(const AttGeo& G_, int it, int& hh, int& b, int& r, int& n) { n = it & (G_.nblk - 1); const int y = it >> (5 - G_.dsh); r = y & (G_.dil - 1); const int z = y >> G_.dsh; b = z & 3; hh = z >> 2; }
__device__ __forceinline__ void att_dma_half(const AttGeo& G_, const bf16_t* Kr, const bf16_t* Vt, int it, int which, int slot, LAS unsigned char* lds, int wid, int lane0) {
    int hh, b, r, n; att_decode(G_, it, hh, b, r, n);
    const int lane = opaque(lane0);
    int blk = n - 1 + which; blk = blk < 0 ? 0 : blk;
    const bf16_t* kb = Kr + ((size_t)(((G_.g * 16 + hh) * 4 + b) * SEQ + r * G_.L + blk * 128)) * 64;
    const bf16_t* vb = Vt + (size_t)(G_.g * 1024 + hh * 64) * MT + b * SEQ + r * G_.L + blk * 128;
    LAS unsigned char* kl = lds + slot * 32768; LAS unsigned char* vl = kl + 16384;
#pragma unroll
    for (int rd = 0; rd < 2; ++rd) { const int ch = rd * 8 + wid; const int rho = ch * 8 + (lane >> 3); const int cs = (lane & 7) ^ ((rho >> 1) & 7);
        __builtin_amdgcn_global_load_lds((const unsigned*)(kb + (size_t)rho * 64 + cs * 8), (LAS unsigned*)(kl + ch * 1024), 16, 0, 0); }
#pragma unroll
    for (int rd = 0; rd < 2; ++rd) { const int ch = rd * 8 + wid; const int d = ch * 4 + (lane >> 4); const int cs = (lane & 15) ^ (d & 15);
        __builtin_amdgcn_global_load_lds((const unsigned*)(vb + (size_t)d * MT + cs * 8), (LAS unsigned*)(vl + ch * 1024), 16, 0, 0); }
}
__device__ __forceinline__ int att_first_item() { return ((blockIdx.x & 7) * 32 + (blockIdx.x >> 3)) * 8; }
__device__ __forceinline__ void attn_issue_first(const bf16_t* Kr, const bf16_t* Vt, int g, LAS unsigned char* lds) {
    const int tid = opaque(threadIdx.x), wid = __builtin_amdgcn_readfirstlane(tid >> 6), lane0 = tid & 63;
    AttGeo G_; G_.g = g; G_.dsh = 2 * g; G_.dil = 1 << G_.dsh; G_.L = SEQ >> G_.dsh; G_.nblk = G_.L >> 7;
    const int it = att_first_item();
    att_dma_half(G_, Kr, Vt, it, 0, 3, lds, wid, lane0);
    att_dma_half(G_, Kr, Vt, it, 1, 0, lds, wid, lane0);
}
template <bool PRE>
__device__ __forceinline__ void phase_attn(const bf16_t* Q, const bf16_t* Kr, const bf16_t* Vt, bf16_t* ACC, float* LSE, int g, LAS unsigned char* lds) {
    const int tid = opaque(threadIdx.x), wid = __builtin_amdgcn_readfirstlane(tid >> 6), lane0 = tid & 63, q0 = lane0 & 15, q40 = lane0 >> 4;
    AttGeo G_; G_.g = g; G_.dsh = 2 * g; G_.dil = 1 << G_.dsh; G_.L = SEQ >> G_.dsh; G_.nblk = G_.L >> 7;
    const int dsh = G_.dsh, dil = G_.dil;
    const int it0 = att_first_item();
    bf16x8 qf[2]; u32x2 oldacc[4]; float oldlse = 0.f; int tq = 0, hh = 0, n = 0;
    {
        if constexpr (!PRE) { att_dma_half(G_, Kr, Vt, it0, 0, 3, lds, wid, lane0); att_dma_half(G_, Kr, Vt, it0, 1, 0, lds, wid, lane0); }
        int b, r; att_decode(G_, it0, hh, b, r, n);
        tq = b * SEQ + ((n * 128 + wid * 16 + q0) << dsh) + r;
#pragma unroll
        for (int ks = 0; ks < 2; ++ks) qf[ks] = *(const bf16x8*)(Q + (size_t)tq * 1024 + hh * 64 + ks * 32 + q40 * 8);
        if (g > 0) { oldlse = LSE[(size_t)hh * MT + tq];
#pragma unroll
            for (int dt = 0; dt < 4; ++dt) oldacc[dt] = *(const u32x2*)(ACC + (size_t)tq * 1024 + hh * 64 + q40 * 4 + dt * 16); }
    }
    u32x2 pend[4]; float pend_lse = 0.f; int pend_tq = 0, pend_hh = 0; bool have_pend = false;
    auto item_body = [&](auto kkc, int k) __attribute__((always_inline)) {
        constexpr int KK = decltype(kkc)::value;
        constexpr int SC = KK, SP = (KK + 3) & 3, SN = (KK + 1) & 3;
        asm volatile("s_waitcnt vmcnt(0)" ::: "memory");
        __builtin_amdgcn_s_barrier();
        asm volatile("" ::: "memory");
        asm volatile("" : "+v"(qf[0]), "+v"(qf[1]), "+v"(oldacc[0]), "+v"(oldacc[1]), "+v"(oldacc[2]), "+v"(oldacc[3]), "+v"(oldlse));
        if (have_pend) {
            bf16_t* pp = ACC + (size_t)pend_tq * 1024 + pend_hh * 64 + q40 * 4;
#pragma unroll
            for (int dt = 0; dt < 4; ++dt) *(u32x2*)(pp + dt * 16) = pend[dt];
            if (q40 == 0) LSE[(size_t)pend_hh * MT + pend_tq] = pend_lse;
        }
        const int q = opaque(q0), q4 = opaque(q40);
        bf16x8 qn[2]; u32x2 oldn[4]; float oldlsen = 0.f; int tqn = 0, hhn = 0, nn = 0;
        if (k + 1 < 8) {
            const int itn = it0 + k + 1;
            att_dma_half(G_, Kr, Vt, itn, 1, SN, lds, wid, lane0);
            int b, r; att_decode(G_, itn, hhn, b, r, nn);
            tqn = b * SEQ + ((nn * 128 + wid * 16 + q) << dsh) + r;
#pragma unroll
            for (int ks = 0; ks < 2; ++ks) qn[ks] = *(const bf16x8*)(Q + (size_t)tqn * 1024 + hhn * 64 + ks * 32 + q4 * 8);
            if (g > 0) { oldlsen = LSE[(size_t)hhn * MT + tqn];
#pragma unroll
                for (int dt = 0; dt < 4; ++dt) oldn[dt] = *(const u32x2*)(ACC + (size_t)tqn * 1024 + hhn * 64 + q4 * 4 + dt * 16); }
        }
        const float slope = __builtin_amdgcn_exp2f(-8.0f * (float)(g * 16 + hh + 1) / 48.0f);
        const float bias2 = slope * (float)dil * LOG2E;
        f32x4 sacc[9];
        {
            bf16x8 kf[9][2];
#pragma unroll
            for (int kt = 0; kt < 9; ++kt) { const int t16 = wid + kt; const int rl = (t16 & 7) * 16 + q, sw = (rl >> 1) & 7;
                const LAS unsigned char* kb_ = (t16 >= 8) ? (lds + SC * 32768) : (lds + SP * 32768);
                kf[kt][0] = *(const LAS bf16x8*)(kb_ + rl * 128 + ((q4 ^ sw) * 16));
                kf[kt][1] = *(const LAS bf16x8*)(kb_ + rl * 128 + (((4 + q4) ^ sw) * 16)); }
            asm volatile("" : "+v"(kf[0][0]), "+v"(kf[0][1]), "+v"(kf[1][0]), "+v"(kf[1][1]), "+v"(kf[2][0]), "+v"(kf[2][1]), "+v"(kf[3][0]), "+v"(kf[3][1]), "+v"(kf[4][0]), "+v"(kf[4][1]));
            asm volatile("" : "+v"(kf[5][0]), "+v"(kf[5][1]), "+v"(kf[6][0]), "+v"(kf[6][1]), "+v"(kf[7][0]), "+v"(kf[7][1]), "+v"(kf[8][0]), "+v"(kf[8][1]));
#pragma unroll
            for (int kt = 0; kt < 9; ++kt) { f32x4 a = (f32x4){0.f, 0.f, 0.f, 0.f};
                a = __builtin_amdgcn_mfma_f32_16x16x32_bf16(kf[kt][0], qf[0], a, 0, 0, 0);
                sacc[kt] = a; }
#pragma unroll
            for (int kt = 0; kt < 9; ++kt) sacc[kt] = __builtin_amdgcn_mfma_f32_16x16x32_bf16(kf[kt][1], qf[1], sacc[kt], 0, 0, 0);
        }
        const float relb = (float)(128 + q - q4 * 4);
        const float a0 = -bias2 * relb;
        float mx = -1e30f;
#pragma unroll
        for (int kt = 0; kt < 9; ++kt)
#pragma unroll
            for (int jj = 0; jj < 4; ++jj) {
                float s = __builtin_fmaf(sacc[kt][jj], 0.125f * LOG2E, __builtin_fmaf(bias2, (float)(kt * 16 + jj), a0));
                if (kt == 0) { if (q4 * 4 + jj < q) s = -1e30f; }
                if (kt == 8) { if (q4 * 4 + jj > q) s = -1e30f; }
                sacc[kt][jj] = s; }
        if (n == 0) {
#pragma unroll
            for (int kt = 0; kt < 8; ++kt)
#pragma unroll
                for (int jj = 0; jj < 4; ++jj) if (wid * 16 + kt * 16 + q4 * 4 + jj < 128) sacc[kt][jj] = -1e30f;
        }
#pragma unroll
        for (int kt = 0; kt < 9; ++kt)
#pragma unroll
            for (int jj = 0; jj < 4; ++jj) mx = fmaxf(mx, sacc[kt][jj]);
        mx = fmaxf(mx, __shfl_xor(mx, 16)); mx = fmaxf(mx, __shfl_xor(mx, 32));
        float lsum = 0.f;
#pragma unroll
        for (int kt = 0; kt < 9; ++kt)
#pragma unroll
            for (int jj = 0; jj < 4; ++jj) { const float pv = __builtin_amdgcn_exp2f(sacc[kt][jj] - mx); sacc[kt][jj] = pv; lsum += pv; }
        lsum += __shfl_xor(lsum, 16); lsum += __shfl_xor(lsum, 32);
        f32x4 oacc[4];
#pragma unroll
        for (int dt = 0; dt < 4; ++dt) oacc[dt] = (f32x4){0.f, 0.f, 0.f, 0.f};
#pragma unroll
        for (int kp2 = 0; kp2 < 5; ++kp2) {
            u32x4 pw; pw.x = cvt_pk_bf16(sacc[2 * kp2][0], sacc[2 * kp2][1]); pw.y = cvt_pk_bf16(sacc[2 * kp2][2], sacc[2 * kp2][3]);
            if (kp2 < 4) { pw.z = cvt_pk_bf16(sacc[kp2 < 4 ? 2 * kp2 + 1 : 8][0], sacc[kp2 < 4 ? 2 * kp2 + 1 : 8][1]); pw.w = cvt_pk_bf16(sacc[kp2 < 4 ? 2 * kp2 + 1 : 8][2], sacc[kp2 < 4 ? 2 * kp2 + 1 : 8][3]); }
            else { pw.z = 0u; pw.w = 0u; }
            bf16x8 pf; __builtin_memcpy(&pf, &pw, 16);
            const int chb = 2 * wid + 4 * kp2;
            const LAS unsigned char* v0b = ((chb >> 4) ? (lds + SC * 32768) : (lds + SP * 32768)) + 16384;
            const LAS unsigned char* v1b = (((chb + 2) >> 4) ? (lds + SC * 32768) : (lds + SP * 32768)) + 16384;
            const int c0 = (chb & 15) + (q4 >> 1), c1 = ((chb + 2) & 15) + (q4 >> 1);
#pragma unroll
            for (int dt = 0; dt < 4; ++dt) {
                const int d = dt * 16 + q;
                const int roff = d * 256 + (q4 & 1) * 8;
                u32x4 vw; const u32x2 lo = *(const LAS u32x2*)(v0b + roff + ((c0 ^ q) * 16)); vw.x = lo.x; vw.y = lo.y;
                if (kp2 < 4) { const u32x2 hi = *(const LAS u32x2*)(v1b + roff + ((c1 ^ q) * 16)); vw.z = hi.x; vw.w = hi.y; } else { vw.z = 0u; vw.w = 0u; }
                bf16x8 vf; __builtin_memcpy(&vf, &vw, 16);
                oacc[dt] = __builtin_amdgcn_mfma_f32_16x16x32_bf16(vf, pf, oacc[dt], 0, 0, 0);
            }
            __builtin_amdgcn_sched_barrier(0);
        }
        const float inv = 1.0f / lsum;
        float lse = (mx + __log2f(lsum)) * LN2;
        float w_new = inv, w_old = 0.f;
        if (g > 0) {
            const float mm = fmaxf(oldlse, lse), e0 = __expf(oldlse - mm), e1 = __expf(lse - mm), tot = e0 + e1;
            w_old = e0 / tot; w_new = inv * (e1 / tot); lse = mm + __logf(tot);
        }
#pragma unroll
        for (int dt = 0; dt < 4; ++dt) {
            f32x4 o = oacc[dt] * w_new;
            if (g > 0) { const u32x2 pr = oldacc[dt]; o[0] += w_old * bf_lo(pr.x); o[1] += w_old * bf_hi(pr.x); o[2] += w_old * bf_lo(pr.y); o[3] += w_old * bf_hi(pr.y); }
            u32x2 w; w.x = cvt_pk_bf16(o[0], o[1]); w.y = cvt_pk_bf16(o[2], o[3]);
            pend[dt] = w;
        }
        pend_lse = lse; pend_tq = tq; pend_hh = hh; have_pend = true;
        qf[0] = qn[0]; qf[1] = qn[1]; oldlse = oldlsen; tq = tqn; hh = hhn; n = nn;
#pragma unroll
        for (int dt = 0; dt < 4; ++dt) oldacc[dt] = oldn[dt];
    };
#pragma unroll 1
    for (int kq = 0; kq < 2; ++kq) { item_body(AttIC<0>{}, 4 * kq); item_body(AttIC<1>{}, 4 * kq + 1); item_body(AttIC<2>{}, 4 * kq + 2); item_body(AttIC<3>{}, 4 * kq + 3); }
    if (have_pend) {
        bf16_t* pp = ACC + (size_t)pend_tq * 1024 + pend_hh * 64 + q40 * 4;
#pragma unroll
        for (int dt = 0; dt < 4; ++dt) *(u32x2*)(pp + dt * 16) = pend[dt];
        if (q40 == 0) LSE[(size_t)pend_hh * MT + pend_tq] = pend_lse;
    }
    asm volatile("s_waitcnt vmcnt(0)" ::: "memory");
    __builtin_amdgcn_s_barrier();
}

__global__ void __launch_bounds__(512, 2) yoco_fwd(Params p) {
    extern __shared__ __attribute__((aligned(16))) unsigned char smem[];
    LAS unsigned char* lds = (LAS unsigned char*)smem;
    cg::grid_group grid = cg::this_grid();
    volatile LAS unsigned* xst = (volatile LAS unsigned*)(lds + 131072);
    if (threadIdx.x < 4) xst[threadIdx.x] = 0u;
    __syncthreads();
    const XcdBarrier xb = xcd_barrier_post((unsigned*)(p.ws + OFF_BAR), xst);
    if (p.ws == nullptr) grid.sync();
    unsigned char* ws = p.ws;
    const int G = gridDim.x, c = blockIdx.x;
    bf16_t* HB = (bf16_t*)(ws + OFF_HB);

    phase_prep(p, lds);
    xcd_barrier(xb);
    { SingleUnit S; S.has = c < 64; const int lg = c >> 3, un = c & 7; S.u0.pm = un >> 2; S.u0.pn = un & 3;
      Gemm gm; gm.A = (const bf16_t*)(ws + OFF_WGT) + (size_t)lg * 512 * 512; gm.Bt = (const bf16_t*)(ws + OFF_WINU) + (size_t)lg * 1024 * 512; gm.M = 512; gm.N = 1024; gm.K = 512;
      EpiStore16<true> E; E.O = (bf16_t*)(ws + OFF_BTA) + (size_t)(lg >> 2) * 4096 * 1024 + (size_t)(lg & 3) * 512 * 1024; E.ldc = 1024;
      gemm_phase<EpiStore16<true>, SingleUnit, 0, true>(lds, gm, S, E); }
    xcd_barrier(xb);
    for (int l = 0; l < 2; ++l) {
        { StaticOrder S; S.init(MT, 4096, G, c); Gemm gm; gm.A = HB; gm.Bt = (const bf16_t*)(ws + OFF_BTA) + (size_t)l * 4096 * 1024; gm.M = MT; gm.N = 4096; gm.K = 1024;
          EpiAG1 E; E.V = (bf16_t*)(ws + OFF_V); E.SG = (bf16_t*)(ws + OFF_SG); gemm_phase<EpiAG1, StaticOrder, 0, true>(lds, gm, S, E); }
        xcd_barrier(xb);
        phase_pool((const bf16_t*)(ws + OFF_V), (bf16_t*)(ws + OFF_SG), p.scale_a + l * 2048);
        xcd_barrier(xb);
        { StaticOrder S; S.init(MT, 1024, G, c); Gemm gm; gm.A = (const bf16_t*)(ws + OFF_SG); gm.Bt = (const bf16_t*)(ws + OFF_WOA) + (size_t)l * 1024 * 2048; gm.M = MT; gm.N = 1024; gm.K = 2048;
          if (l == 0) { EpiLnFused<true, false, true, true> E; E.hin_f = p.x; E.hin_b = nullptr; E.out_f = nullptr; E.out_b = HB; E.gam = p.ln_g; E.bet = p.ln_b;
              E.xbuf = (unsigned long long*)(ws + OFF_XBUF); E.cnt = (unsigned*)(ws + OFF_CNT); E.want = 32u; gemm_phase(lds, gm, S, E); }
          else { EpiLnFused<false, false, true, true> E; E.hin_f = nullptr; E.hin_b = HB; E.out_f = nullptr; E.out_b = HB; E.gam = p.ln_g + DM; E.bet = p.ln_b + DM;
              E.xbuf = (unsigned long long*)(ws + OFF_XBUF); E.cnt = (unsigned*)(ws + OFF_CNT); E.want = 64u; gemm_phase(lds, gm, S, E); } }
        xcd_barrier(xb);
    }
    { StaticOrder S; S.init(MT, 3072, G, c); Gemm gm; gm.A = HB; gm.Bt = (const bf16_t*)(ws + OFF_KVT); gm.M = MT; gm.N = 3072; gm.K = 1024;
      EpiKr E; E.Kr = (bf16_t*)(ws + OFF_K); gemm_phase<EpiKr, StaticOrder, 0, true>(lds, gm, S, E); }
    { StaticOrder S; S.init(1024, MT, G, c); Gemm gm; gm.Bt = HB; gm.M = 1024; gm.N = MT; gm.K = 1024;
      gm.A = (const bf16_t*)(ws + OFF_KVT) + (size_t)(3072 + 0) * 1024;    { EpiVt<0> E; E.Vt = (bf16_t*)(ws + OFF_VT) + (size_t)0 * MT;    gemm_phase<EpiVt<0>, StaticOrder, 0, true>(lds, gm, S, E); }
      gm.A = (const bf16_t*)(ws + OFF_KVT) + (size_t)(3072 + 1024) * 1024; { EpiVt<2> E; E.Vt = (bf16_t*)(ws + OFF_VT) + (size_t)1024 * MT; gemm_phase<EpiVt<2>, StaticOrder, 2, true>(lds, gm, S, E); }
      gm.A = (const bf16_t*)(ws + OFF_KVT) + (size_t)(3072 + 2048) * 1024; { EpiVt<4> E; E.Vt = (bf16_t*)(ws + OFF_VT) + (size_t)2048 * MT; gemm_phase<EpiVt<4>, StaticOrder, 4, true>(lds, gm, S, E); } }
    bf16_t* QG = (bf16_t*)p.out; bf16_t* QY = (bf16_t*)p.out + (size_t)MT * DM; bf16_t* ACC = QG; float* LSE = (float*)(ws + OFF_LSE);
    for (int j = 0; j < 2; ++j) {
        const bf16_t* inb = (const bf16_t*)(ws + OFF_INB) + (size_t)j * 4096 * 1024;
        { StaticOrder S; S.init(MT, 2048, G, c); Gemm gm; gm.A = HB; gm.Bt = inb; gm.M = MT; gm.N = 2048; gm.K = 1024;
          EpiStoreSplit E; E.O0 = QG; E.O1 = QY; gemm_phase<EpiStoreSplit, StaticOrder, 0, true>(lds, gm, S, E); }
        if (j != 0) attn_issue_first((const bf16_t*)(ws + OFF_K), (const bf16_t*)(ws + OFF_VT), 0, lds);
        xcd_barrier(xb);
        if (j == 0) { tp_job(p.w_out_b, (size_t)1024 * 1024, 1024, 0, (bf16_t*)(ws + OFF_OUTB), (size_t)1024 * 1024, 1024, 1024, 1024, 2, (LAS float*)lds);
                      phase_attn<false>(QG, (const bf16_t*)(ws + OFF_K), (const bf16_t*)(ws + OFF_VT), QG, LSE, 0, lds); }
        else phase_attn<true>(QG, (const bf16_t*)(ws + OFF_K), (const bf16_t*)(ws + OFF_VT), QG, LSE, 0, lds);
        attn_issue_first((const bf16_t*)(ws + OFF_K), (const bf16_t*)(ws + OFF_VT), 1, lds);
        xcd_barrier(xb);
        phase_attn<true>(QY, (const bf16_t*)(ws + OFF_K), (const bf16_t*)(ws + OFF_VT), QG, LSE, 1, lds);
        xcd_barrier(xb);
        { StaticOrder S; S.init(MT, 1024, G, c); Gemm gm; gm.A = HB; gm.Bt = inb + (size_t)2 * 1024 * 1024; gm.M = MT; gm.N = 1024; gm.K = 1024;
          EpiStore16<false> E; E.O = QY; E.ldc = 1024; gemm_phase<EpiStore16<false>, StaticOrder, 0, true>(lds, gm, S, E); }
        attn_issue_first((const bf16_t*)(ws + OFF_K), (const bf16_t*)(ws + OFF_VT), 2, lds);
        xcd_barrier(xb);
        phase_attn<true>(QY, (const bf16_t*)(ws + OFF_K), (const bf16_t*)(ws + OFF_VT), QG, LSE, 2, lds);
        xcd_barrier(xb);
        bf16_t* ZB = j == 0 ? ACC : (bf16_t*)(ws + OFF_K);
        { StaticOrder S; S.init(MT, 1024, G, c); Gemm gm; gm.A = HB; gm.Bt = inb + (size_t)3 * 1024 * 1024; gm.M = MT; gm.N = 1024; gm.K = 1024;
          EpiGateMul E; E.Zin = ACC; E.Zout = ZB; gemm_phase<EpiGateMul, StaticOrder, 0, true>(lds, gm, S, E); }
        xcd_barrier(xb);
        { StaticOrder S; S.init(MT, 1024, G, c); Gemm gm; gm.A = ZB; gm.Bt = (const bf16_t*)(ws + OFF_OUTB) + (size_t)j * 1024 * 1024; gm.M = MT; gm.N = 1024; gm.K = 1024;
          if (j == 0) { EpiLnFused<false, false, true, true> E; E.hin_f = nullptr; E.hin_b = HB; E.out_f = nullptr; E.out_b = HB; E.gam = p.ln_g + 2 * DM; E.bet = p.ln_b + 2 * DM;
              E.xbuf = (unsigned long long*)(ws + OFF_XBUF); E.cnt = (unsigned*)(ws + OFF_CNT); E.want = 96u; gemm_phase(lds, gm, S, E); }
          else { EpiLnFused<false, true, false, true> E; E.hin_f = nullptr; E.hin_b = HB; E.out_f = p.out; E.out_b = nullptr; E.gam = p.ln_g + 3 * DM; E.bet = p.ln_b + 3 * DM;
              E.xbuf = (unsigned long long*)(ws + OFF_XBUF); E.cnt = (unsigned*)(ws + OFF_CNT); E.want = 128u; gemm_phase(lds, gm, S, E); } }
        xcd_barrier(xb);
    }
}

extern "C" void kernel_launch(void* const* d_in, const int* in_sizes, int n_in, void* d_out, int out_size, void* d_ws, size_t ws_size, hipStream_t stream) {
    static int grid = 0;
    if (grid == 0) {
        if (n_in != 10 || out_size != MT * DM || ws_size < WS_NEED) { fprintf(stderr, "kernel_launch: unexpected shapes / workspace (n_in %d out %d ws %zu)\n", n_in, out_size, ws_size); grid = -1; return; }
        int dev = 0, cus = 0, per_cu = 0;
        hipGetDevice(&dev);
        hipDeviceGetAttribute(&cus, hipDeviceAttributeMultiprocessorCount, dev);
        hipFuncSetAttribute((const void*)yoco_fwd, hipFuncAttributeMaxDynamicSharedMemorySize, LDS_BYTES);
        hipOccupancyMaxActiveBlocksPerMultiprocessor(&per_cu, (const void*)yoco_fwd, 512, LDS_BYTES);
        if (per_cu < 1) per_cu = 1;
        (void)hipGetLastError();
        grid = cus;
    }
    if (grid < 0) return;
    Params p{};
    p.x = (const float*)d_in[0]; p.w_in_a = (const float*)d_in[1]; p.w_grp_a = (const float*)d_in[2]; p.scale_a = (const float*)d_in[3]; p.w_out_a = (const float*)d_in[4];
    p.w_kv = (const float*)d_in[5]; p.w_in_b = (const float*)d_in[6]; p.w_out_b = (const float*)d_in[7]; p.ln_g = (const float*)d_in[8]; p.ln_b = (const float*)d_in[9];
    p.out = (float*)d_out; p.ws = (unsigned char*)d_ws;
    if (hipMemsetAsync((unsigned char*)d_ws + OFF_BAR, 0, 32768, stream) != hipSuccess) { fprintf(stderr, "memset failed\n"); return; }
    void* args[] = {&p};
    hipError_t e = hipLaunchCooperativeKernel((const void*)yoco_fwd, dim3(grid), dim3(512), args, LDS_BYTES, stream);
    if (e != hipSuccess) fprintf(stderr, "cooperative launch failed: %s (grid %d)\n", hipGetErrorString(e), grid);
}
```

```cpp
#include <hip/hip_runtime.h>
#include <hip/hip_cooperative_groups.h>
#include <cstdio>
namespace cg = cooperative_groups;

#define LAS __attribute__((address_space(3)))
typedef unsigned short bf16_t;
typedef short bf16x8 __attribute__((ext_vector_type(8)));
typedef short bf16x4 __attribute__((ext_vector_type(4)));
typedef float f32x4 __attribute__((ext_vector_type(4)));
typedef float f32x2 __attribute__((ext_vector_type(2)));
typedef unsigned u32x4 __attribute__((ext_vector_type(4)));
typedef unsigned u32x2 __attribute__((ext_vector_type(2)));

constexpr int MT = 16384, DM = 1024, SEQ = 4096;
constexpr int BM = 256, BK = 64, HALF = 128, HTB = HALF * BK * 2, STAGE_BYTES = 8 * HTB, NXCD = 8, WGM = 8;
constexpr int LDS_BYTES = 131072 + 1024;
constexpr float DN_ALPHA = 1.681792830507429f;
constexpr float LN_EPS = 1e-5f;
constexpr float LOG2E = 1.4426950408889634f, LN2 = 0.6931471805599453f;
constexpr size_t MiB = 1024 * 1024;
constexpr size_t OFF_V = 0, OFF_SG = 64 * MiB, OFF_BTA = 128 * MiB, OFF_WOA = 144 * MiB, OFF_WGT = 152 * MiB, OFF_WINU = 156 * MiB;
constexpr size_t OFF_KVT = 192 * MiB, OFF_INB = 204 * MiB, OFF_BAR = 220 * MiB, OFF_HB = 224 * MiB;
constexpr size_t OFF_CNT = OFF_BAR + 16384, OFF_XBUF = OFF_BAR + 32768;
constexpr size_t OFF_OUTB = 193 * MiB;
constexpr size_t OFF_K = 0, OFF_VT = 96 * MiB, OFF_LSE = 192 * MiB;
constexpr size_t WS_NEED = 256 * MiB;

typedef __bf16 bf16x2_t __attribute__((ext_vector_type(2)));
__device__ __forceinline__ unsigned cvt_pk_bf16(float lo, float hi) { const f32x2 v = {lo, hi}; const bf16x2_t b = __builtin_convertvector(v, bf16x2_t); return __builtin_bit_cast(unsigned, b); }
__device__ __forceinline__ float bf_lo(unsigned w) { return __uint_as_float(w << 16); }
__device__ __forceinline__ float bf_hi(unsigned w) { return __uint_as_float(w & 0xffff0000u); }
typedef _Float16 half8 __attribute__((ext_vector_type(8)));
__device__ __forceinline__ unsigned cvt_pk_f16(float lo, float hi) { const _Float16 a = (_Float16)lo, b = (_Float16)hi; return (unsigned)__builtin_bit_cast(unsigned short, a) | ((unsigned)__builtin_bit_cast(unsigned short, b) << 16); }
__device__ __forceinline__ float h_lo(unsigned w) { return (float)__builtin_bit_cast(_Float16, (unsigned short)(w & 0xffffu)); }
__device__ __forceinline__ float h_hi(unsigned w) { return (float)__builtin_bit_cast(_Float16, (unsigned short)(w >> 16)); }
template <bool F16> __device__ __forceinline__ unsigned cvt_pk16(float lo, float hi) { if constexpr (F16) return cvt_pk_f16(lo, hi); else return cvt_pk_bf16(lo, hi); }
__device__ __forceinline__ int opaque(int x) { asm volatile("" : "+v"(x)); return x; }
__device__ __forceinline__ float silu_f(float x) { return x * __builtin_amdgcn_rcpf(1.0f + __builtin_amdgcn_exp2f(-x * LOG2E)); }

__host__ __device__ __forceinline__ int lds_byte(int r, int c) { const int st = (r >> 4) * 2 + (c >> 5), rr = r & 15, cc = c & 31, ob = rr * 64 + cc * 2; return st * 1024 + (ob ^ (((ob >> 9) & 1) << 5)); }
__host__ __device__ __forceinline__ void stage_rc(int b, int& R, int& C) { const int st = b / 1024, sb = b % 1024, swz = sb ^ (((sb >> 9) & 1) << 5); R = (st >> 1) * 16 + swz / 64; C = (st & 1) * 32 + (swz % 64) / 2; }
__host__ __device__ __forceinline__ int perm32(int rho) { const int n = rho >> 4, i = rho & 15; return 8 * (i >> 2) + 4 * n + (i & 3); }

struct Unit { int pm, pn; };
struct Gemm { const bf16_t* A; const bf16_t* Bt; int M, N, K; };

struct StaticOrder {
    int nM, nN, nwg, G, c;
    __device__ void init(int M, int N, int G_, int c_) { nM = M / BM; nN = N / BM; nwg = nM * nN; G = G_; c = c_; }
    __device__ bool next(int i, Unit& u) const {
        const long L = (long)i * G + c; if (L >= nwg) return false;
        int wgid = (int)L; { const int q = nwg / NXCD, r = nwg % NXCD, xcd = wgid % NXCD, off = wgid / NXCD; wgid = (xcd < r ? xcd * (q + 1) : r * (q + 1) + (xcd - r) * q) + off; }
        const int nig = WGM * nN, gid = wgid / nig, fm = gid * WGM, gsz = (nM - fm) < WGM ? (nM - fm) : WGM;
        u.pm = fm + ((wgid % nig) % gsz); u.pn = (wgid % nig) / gsz; return true;
    }
};
struct SingleUnit {
    bool has; Unit u0;
    __device__ bool next(int i, Unit& u) const { if (i == 0 && has) { u = u0; return true; } return false; }
};

template <bool F16 = false> struct EpiStore16 {
    static constexpr bool PERM = true, AFTER_DRAIN = false;
    bf16_t* O; int ldc;
    __device__ __forceinline__ void operator()(const f32x4 (&acc)[2][2][4][2], const Unit& u, int wr, int wc, int fr, int fq) const {
        const int row0 = u.pm * BM + wr * 64 + fr, col0 = u.pn * BM + wc * 32 + 8 * fq;
#pragma unroll
        for (int ai = 0; ai < 2; ++ai)
#pragma unroll
            for (int m = 0; m < 4; ++m) { bf16_t* rowp = O + (size_t)(row0 + ai * HALF + m * 16) * ldc + col0;
#pragma unroll
                for (int bj = 0; bj < 2; ++bj) { const f32x4 v0 = acc[ai][bj][m][0], v1 = acc[ai][bj][m][1];
                    u32x4 w; w.x = cvt_pk16<F16>(v0[0], v0[1]); w.y = cvt_pk16<F16>(v0[2], v0[3]); w.z = cvt_pk16<F16>(v1[0], v1[1]); w.w = cvt_pk16<F16>(v1[2], v1[3]);
                    *(u32x4*)(rowp + bj * HALF) = w; } }
    }
};
struct EpiStoreSplit {
    static constexpr bool PERM = true, AFTER_DRAIN = false;
    bf16_t* O0; bf16_t* O1;
    __device__ __forceinline__ void operator()(const f32x4 (&acc)[2][2][4][2], const Unit& u, int wr, int wc, int fr, int fq) const {
        const int row0 = u.pm * BM + wr * 64 + fr, col0 = (u.pn & 3) * BM + wc * 32 + 8 * fq;
        bf16_t* base = u.pn >= 4 ? O1 : O0;
#pragma unroll
        for (int ai = 0; ai < 2; ++ai)
#pragma unroll
            for (int m = 0; m < 4; ++m) { bf16_t* rowp = base + (size_t)(row0 + ai * HALF + m * 16) * 1024 + col0;
#pragma unroll
                for (int bj = 0; bj < 2; ++bj) { const f32x4 v0 = acc[ai][bj][m][0], v1 = acc[ai][bj][m][1];
                    u32x4 w; w.x = cvt_pk_bf16(v0[0], v0[1]); w.y = cvt_pk_bf16(v0[2], v0[3]); w.z = cvt_pk_bf16(v1[0], v1[1]); w.w = cvt_pk_bf16(v1[2], v1[3]);
                    *(u32x4*)(rowp + bj * HALF) = w; } }
    }
};
struct EpiAG1 {
    static constexpr bool PERM = true, AFTER_DRAIN = false;
    bf16_t* V; bf16_t* SG;
    __device__ __forceinline__ void operator()(const f32x4 (&acc)[2][2][4][2], const Unit& u, int wr, int wc, int fr, int fq) const {
        const bool isg = u.pn >= 8;
        const int row0 = u.pm * BM + wr * 64 + fr, col0 = (isg ? u.pn - 8 : u.pn) * BM + wc * 32 + 8 * fq;
        bf16_t* base = isg ? SG : V;
#pragma unroll
        for (int ai = 0; ai < 2; ++ai)
#pragma unroll
            for (int m = 0; m < 4; ++m) { bf16_t* rowp = base + (size_t)(row0 + ai * HALF + m * 16) * 2048 + col0;
#pragma unroll
                for (int bj = 0; bj < 2; ++bj) { f32x4 v0 = acc[ai][bj][m][0], v1 = acc[ai][bj][m][1];
                    if (isg) {
#pragma unroll
                        for (int j = 0; j < 4; ++j) { v0[j] = silu_f(v0[j]); v1[j] = silu_f(v1[j]); } }
                    u32x4 w; w.x = cvt_pk_bf16(v0[0], v0[1]); w.y = cvt_pk_bf16(v0[2], v0[3]); w.z = cvt_pk_bf16(v1[0], v1[1]); w.w = cvt_pk_bf16(v1[2], v1[3]);
                    *(u32x4*)(rowp + bj * HALF) = w; } }
    }
};
struct EpiGateMul {
    static constexpr bool PERM = true, AFTER_DRAIN = false;
    const bf16_t* Zin; bf16_t* Zout;
    __device__ __forceinline__ void operator()(const f32x4 (&acc)[2][2][4][2], const Unit& u, int wr, int wc, int fr, int fq) const {
        const int row0 = u.pm * BM + wr * 64 + fr, col0 = u.pn * BM + wc * 32 + 8 * fq;
#pragma unroll
        for (int ai = 0; ai < 2; ++ai)
#pragma unroll
            for (int m = 0; m < 4; ++m) { const size_t roff = (size_t)(row0 + ai * HALF + m * 16) * DM + col0; const bf16_t* rowp = Zin + roff; bf16_t* rowo = Zout + roff;
#pragma unroll
                for (int bj = 0; bj < 2; ++bj) { const f32x4 v0 = acc[ai][bj][m][0], v1 = acc[ai][bj][m][1];
                    const u32x4 h = *(const u32x4*)(rowp + bj * HALF);
                    u32x4 w;
                    w.x = cvt_pk_bf16(bf_lo(h.x) * silu_f(v0[0]), bf_hi(h.x) * silu_f(v0[1]));
                    w.y = cvt_pk_bf16(bf_lo(h.y) * silu_f(v0[2]), bf_hi(h.y) * silu_f(v0[3]));
                    w.z = cvt_pk_bf16(bf_lo(h.z) * silu_f(v1[0]), bf_hi(h.z) * silu_f(v1[1]));
                    w.w = cvt_pk_bf16(bf_lo(h.w) * silu_f(v1[2]), bf_hi(h.w) * silu_f(v1[3]));
                    *(u32x4*)(rowo + bj * HALF) = w; } }
    }
};
struct EpiKr {
    static constexpr bool PERM = true, AFTER_DRAIN = false;
    bf16_t* Kr;
    __device__ __forceinline__ void operator()(const f32x4 (&acc)[2][2][4][2], const Unit& u, int wr, int wc, int fr, int fq) const {
        const int row0 = u.pm * BM + wr * 64 + fr, col0 = u.pn * BM + wc * 32 + 8 * fq;
        const int g = u.pn >> 2, dsh = 2 * g;
#pragma unroll
        for (int ai = 0; ai < 2; ++ai)
#pragma unroll
            for (int m = 0; m < 4; ++m) { const int t = row0 + ai * HALF + m * 16, b = t >> 12, s = t & 4095, r = s & ((1 << dsh) - 1), i = s >> dsh;
                const int rowidx = r * (SEQ >> dsh) + i;
#pragma unroll
                for (int bj = 0; bj < 2; ++bj) { const f32x4 v0 = acc[ai][bj][m][0], v1 = acc[ai][bj][m][1];
                    const int col = col0 + bj * HALF, hh = (col >> 6) & 15, d0 = col & 63;
                    u32x4 w; w.x = cvt_pk_bf16(v0[0], v0[1]); w.y = cvt_pk_bf16(v0[2], v0[3]); w.z = cvt_pk_bf16(v1[0], v1[1]); w.w = cvt_pk_bf16(v1[2], v1[3]);
                    *(u32x4*)(Kr + ((size_t)(((g * 16 + hh) * 4 + b) * SEQ + rowidx)) * 64 + d0) = w; } }
    }
};
template <int DSH> struct EpiVt {
    static constexpr bool PERM = true, AFTER_DRAIN = false;
    bf16_t* Vt;
    __device__ __forceinline__ void operator()(const f32x4 (&acc)[2][2][4][2], const Unit& u, int wr, int wc, int fr, int fq) const {
        const int row0 = u.pm * BM + wr * 64 + fr;
        const int t_tile = u.pn * BM, b = t_tile >> 12, s_tile = t_tile & 4095;
#pragma unroll
        for (int ai = 0; ai < 2; ++ai)
#pragma unroll
            for (int m = 0; m < 4; ++m) { bf16_t* rowp = Vt + (size_t)(row0 + ai * HALF + m * 16) * MT + b * SEQ + (s_tile >> DSH);
#pragma unroll
                for (int bj = 0; bj < 2; ++bj) { const f32x4 v0 = acc[ai][bj][m][0], v1 = acc[ai][bj][m][1];
                    const int c = bj * HALF + wc * 32 + 8 * fq, r = c >> (8 - DSH), il = c & ((256 >> DSH) - 1);
                    u32x4 w; w.x = cvt_pk_bf16(v0[0], v0[1]); w.y = cvt_pk_bf16(v0[2], v0[3]); w.z = cvt_pk_bf16(v1[0], v1[1]); w.w = cvt_pk_bf16(v1[2], v1[3]);
                    *(u32x4*)(rowp + r * (SEQ >> DSH) + il) = w; } }
    }
};

template <bool RES_F32, bool OUT_F, bool OUT_B, bool F16 = false> struct EpiLnFused {
    static constexpr bool PERM = false, AFTER_DRAIN = true;
    const float* hin_f; const bf16_t* hin_b;
    float* out_f; bf16_t* out_b;
    const float* gam; const float* bet;
    unsigned long long* xbuf; unsigned* cnt; unsigned want;
    __device__ __forceinline__ void fused(f32x4 (&acc)[2][2][4][2], const Unit& u, int wr, int wc, int fr, int fq, LAS unsigned char* lds, int wid, int lane) const {
        LAS f32x2* P = (LAS f32x2*)lds;
        LAS f32x2* S = (LAS f32x2*)(lds + 8192);
        const int col0 = u.pn * BM + wc * 32 + 4 * fq;
#pragma unroll
        for (int ai = 0; ai < 2; ++ai)
#pragma unroll
            for (int mp = 0; mp < 2; ++mp) {
                f32x4 hb_[2][2][2];
#pragma unroll
                for (int mi = 0; mi < 2; ++mi) { const int m = mp * 2 + mi; const unsigned off = (unsigned)(u.pm * BM + ai * HALF + wr * 64 + m * 16 + fr) * DM + col0;
#pragma unroll
                    for (int bj = 0; bj < 2; ++bj)
#pragma unroll
                        for (int n = 0; n < 2; ++n) {
                            if constexpr (RES_F32) hb_[mi][bj][n] = *(const f32x4*)(hin_f + off + bj * HALF + n * 16);
                            else { const u32x2 w = *(const u32x2*)(hin_b + off + bj * HALF + n * 16); hb_[mi][bj][n] = (f32x4){__uint_as_float(w.x), __uint_as_float(w.y), 0.f, 0.f}; } } }
                asm volatile("" : "+v"(hb_[0][0][0]), "+v"(hb_[0][0][1]), "+v"(hb_[0][1][0]), "+v"(hb_[0][1][1]), "+v"(hb_[1][0][0]), "+v"(hb_[1][0][1]), "+v"(hb_[1][1][0]), "+v"(hb_[1][1][1]));
#pragma unroll
                for (int mi = 0; mi < 2; ++mi) { const int m = mp * 2 + mi;
#pragma unroll
                    for (int bj = 0; bj < 2; ++bj)
#pragma unroll
                        for (int n = 0; n < 2; ++n) { f32x4 h = hb_[mi][bj][n];
                            if constexpr (!RES_F32) { const unsigned wx = __float_as_uint(h[0]), wy = __float_as_uint(h[1]); if constexpr (F16) h = (f32x4){h_lo(wx), h_hi(wx), h_lo(wy), h_hi(wy)}; else h = (f32x4){bf_lo(wx), bf_hi(wx), bf_lo(wy), bf_hi(wy)}; }
                            acc[ai][bj][m][n] = h * DN_ALPHA + acc[ai][bj][m][n]; }
                    asm volatile("" : "+v"(acc[ai][0][m][0]), "+v"(acc[ai][0][m][1]), "+v"(acc[ai][1][m][0]), "+v"(acc[ai][1][m][1])); }
                asm volatile("" ::: "memory"); }
#pragma unroll
        for (int ai = 0; ai < 2; ++ai)
#pragma unroll
            for (int m = 0; m < 4; ++m) {
                float s = 0.f;
#pragma unroll
                for (int bj = 0; bj < 2; ++bj)
#pragma unroll
                    for (int n = 0; n < 2; ++n) { const f32x4 x = acc[ai][bj][m][n]; s += (x[0] + x[1]) + (x[2] + x[3]); }
                s += __shfl_xor(s, 16); s += __shfl_xor(s, 32);
                const float mw = s * (1.0f / 64.0f); float qq = 0.f;
#pragma unroll
                for (int bj = 0; bj < 2; ++bj)
#pragma unroll
                    for (int n = 0; n < 2; ++n) { const f32x4 d = acc[ai][bj][m][n] - mw; qq += (d[0] * d[0] + d[1] * d[1]) + (d[2] * d[2] + d[3] * d[3]); }
                qq += __shfl_xor(qq, 16); qq += __shfl_xor(qq, 32);
                if (fq == 0) P[(ai * HALF + wr * 64 + m * 16 + fr) * 4 + wc] = (f32x2){mw, qq};
            }
        asm volatile("s_waitcnt lgkmcnt(0)" ::: "memory"); __builtin_amdgcn_s_barrier(); asm volatile("" ::: "memory");
        const int row = wid * 32 + (lane & 31);
        if (lane < 32) {
            const f32x2 a = P[row * 4 + 0], b = P[row * 4 + 1], c = P[row * 4 + 2], d = P[row * 4 + 3];
            const float mt = (a.x + b.x + c.x + d.x) * 0.25f;
            const float da = a.x - mt, db = b.x - mt, dc = c.x - mt, dd = d.x - mt;
            const float m2 = (a.y + b.y) + (c.y + d.y) + 64.0f * ((da * da + db * db) + (dc * dc + dd * dd));
            unsigned long long* slot = xbuf + ((size_t)(u.pm * BM + row) * 4 + u.pn);
            __hip_atomic_store(slot, ((unsigned long long)__float_as_uint(m2) << 32) | __float_as_uint(mt), __ATOMIC_RELAXED, __HIP_MEMORY_SCOPE_AGENT);
        }
        asm volatile("s_waitcnt vmcnt(0)" ::: "memory");
        if (lane == 0) __hip_atomic_fetch_add(cnt + 64 * u.pm, 1u, __ATOMIC_RELAXED, __HIP_MEMORY_SCOPE_AGENT);
        if (wid == 0) {
            unsigned sp = 0;
            while ((unsigned)__builtin_amdgcn_readfirstlane(__hip_atomic_load(cnt + 64 * u.pm, __ATOMIC_RELAXED, __HIP_MEMORY_SCOPE_AGENT)) < want) { __builtin_amdgcn_s_sleep(2); if (++sp > (1u << 22)) break; }
            __builtin_amdgcn_fence(__ATOMIC_ACQUIRE, "agent");
        }
        asm volatile("s_waitcnt vmcnt(0) lgkmcnt(0)" ::: "memory"); __builtin_amdgcn_s_barrier(); asm volatile("" ::: "memory");
        if (lane < 32) {
            const unsigned long long* slot = xbuf + (size_t)(u.pm * BM + row) * 4; float mt[4], m2[4]; float ms = 0.f;
#pragma unroll
            for (int t = 0; t < 4; ++t) { const unsigned long long w = __hip_atomic_load(slot + t, __ATOMIC_RELAXED, __HIP_MEMORY_SCOPE_AGENT); mt[t] = __uint_as_float((unsigned)w); m2[t] = __uint_as_float((unsigned)(w >> 32)); ms += mt[t]; }
            const float mean = ms * 0.25f; float qq = 0.f;
#pragma unroll
            for (int t = 0; t < 4; ++t) { const float dm = mt[t] - mean; qq += m2[t] + 256.0f * dm * dm; }
            S[row] = (f32x2){mean, 1.0f / sqrtf(qq * (1.0f / 1024.0f) + LN_EPS)};
        }
        asm volatile("s_waitcnt lgkmcnt(0)" ::: "memory"); __builtin_amdgcn_s_barrier(); asm volatile("" ::: "memory");
        f32x2 sr[2][4];
#pragma unroll
        for (int ai = 0; ai < 2; ++ai)
#pragma unroll
            for (int m = 0; m < 4; ++m) sr[ai][m] = S[ai * HALF + wr * 64 + m * 16 + fr];
#pragma unroll
        for (int bj = 0; bj < 2; ++bj)
#pragma unroll
            for (int n = 0; n < 2; ++n) { const f32x4 gv = *(const f32x4*)(gam + col0 + bj * HALF + n * 16), bv = *(const f32x4*)(bet + col0 + bj * HALF + n * 16);
#pragma unroll
                for (int ai = 0; ai < 2; ++ai)
#pragma unroll
                    for (int m = 0; m < 4; ++m) { const int r = ai * HALF + wr * 64 + m * 16 + fr; const unsigned off = (unsigned)(u.pm * BM + r) * DM + col0 + bj * HALF + n * 16;
                        const f32x4 o = (acc[ai][bj][m][n] - sr[ai][m].x) * sr[ai][m].y * gv + bv;
                        if constexpr (OUT_F) *(f32x4*)(out_f + off) = o;
                        if constexpr (OUT_B) { u32x2 w; w.x = cvt_pk16<F16>(o[0], o[1]); w.y = cvt_pk16<F16>(o[2], o[3]); *(u32x2*)(out_b + off) = w; } } }
    }
};

template <class Epi, class Sched, int DSH = 0, bool F16 = false, bool SP2 = true, bool ALIGN_EPI = true>
__device__ __forceinline__ void gemm_phase(LAS unsigned char* lds, const Gemm g, const Sched& S, const Epi& E) {
    const int tid = opaque(threadIdx.x), wid = __builtin_amdgcn_readfirstlane(tid >> 6), lane = tid & 63, wr = wid >> 2, wc = wid & 3, fr = lane & 15, fq = lane >> 4;
    const int K = g.K, nt = K / BK;
    unsigned voffA[2], voffB[2], voffB1[2];
#pragma unroll
    for (int i = 0; i < 2; ++i) { int R, C; stage_rc(tid * 16 + i * 8192, R, C); const int Rb = Epi::PERM ? ((R & ~31) + perm32(R & 31)) : R;
        voffA[i] = (unsigned)(R * K + C) * 2u;
        if constexpr (DSH == 0) { voffB[i] = (unsigned)(Rb * K + C) * 2u; voffB1[i] = (unsigned)((Rb + HALF) * K + C) * 2u; }
        else { const int c0_ = Rb, c1_ = Rb + HALF; const int t0_ = ((c0_ & ((256 >> DSH) - 1)) << DSH) + (c0_ >> (8 - DSH)), t1_ = ((c1_ & ((256 >> DSH) - 1)) << DSH) + (c1_ >> (8 - DSH));
            voffB[i] = (unsigned)(t0_ * K + C) * 2u; voffB1[i] = (unsigned)(t1_ * K + C) * 2u; } }
    const size_t kstep = (size_t)(BK * 2);
    const size_t hstep = (size_t)HALF * K * 2;
    const size_t tstep = 2 * hstep;
    const unsigned ldsw = (unsigned)wid * 1024u;
    const int aoff = lds_byte(wr * 64 + fr, fq * 8), boff = lds_byte(wc * 32 + fr, fq * 8);
#define PG8_SA(b, h) (((b) * 2 + (h)) * HTB)
#define PG8_SB(b, h) ((4 + (b) * 2 + (h)) * HTB)
#define PG8_STAGE(bufoff, gbase, voff) do { _Pragma("unroll") for (int _i = 0; _i < 2; ++_i) \
        __builtin_amdgcn_global_load_lds((const unsigned*)((const char*)(gbase) + (voff)[_i]), (LAS unsigned*)(lds + (bufoff) + ldsw + _i * 8192), 16, 0, 0); } while (0)
#define PG8_LDA(dst, b, h) do { _Pragma("unroll") for (int m = 0; m < 4; ++m) _Pragma("unroll") for (int k = 0; k < 2; ++k) dst[m][k] = *(const LAS bf16x8*)(lds + PG8_SA(b, h) + aoff + m * 2048 + k * 1024); } while (0)
#define PG8_LDB(dst, b, h) do { _Pragma("unroll") for (int n = 0; n < 2; ++n) _Pragma("unroll") for (int k = 0; k < 2; ++k) dst[n][k] = *(const LAS bf16x8*)(lds + PG8_SB(b, h) + boff + n * 2048 + k * 1024); } while (0)
#define PG8_MMA(ai, bj, At, Bt) do { __builtin_amdgcn_s_setprio(1); _Pragma("unroll") for (int m = 0; m < 4; ++m) _Pragma("unroll") for (int n = 0; n < 2; ++n) _Pragma("unroll") for (int k = 0; k < 2; ++k) \
        acc[ai][bj][m][n] = F16 ? __builtin_amdgcn_mfma_f32_16x16x32_f16(__builtin_bit_cast(half8, Bt[n][k]), __builtin_bit_cast(half8, At[m][k]), acc[ai][bj][m][n], 0, 0, 0) : __builtin_amdgcn_mfma_f32_16x16x32_bf16(Bt[n][k], At[m][k], acc[ai][bj][m][n], 0, 0, 0); __builtin_amdgcn_s_setprio(0); } while (0)
#define PG8_WAIT_V(n) asm volatile("s_waitcnt vmcnt(" #n ")" ::: "memory")
#define PG8_WAIT_L(n) asm volatile("s_waitcnt lgkmcnt(" #n ")" ::: "memory")
#define PG8_BAR __builtin_amdgcn_s_barrier()
#define PG8_SCHED __builtin_amdgcn_sched_barrier(0)
    Unit cur, nxt; int ui = 0;
    if (!S.next(0, cur)) return;
    f32x4 acc[2][2][4][2];
#pragma unroll
    for (int a = 0; a < 2; ++a)
#pragma unroll
        for (int b = 0; b < 2; ++b)
#pragma unroll
            for (int m = 0; m < 4; ++m)
#pragma unroll
                for (int n = 0; n < 2; ++n) acc[a][b][m][n] = (f32x4){0.f, 0.f, 0.f, 0.f};
    bf16x8 At[4][2], B0[2][2], B1[2][2];
    const char* cA = (const char*)g.A + (size_t)cur.pm * tstep; const char* cB = (const char*)g.Bt + (size_t)cur.pn * tstep;
    if constexpr (SP2) {
        PG8_STAGE(PG8_SB(0, 0), cB, voffB); PG8_STAGE(PG8_SB(0, 1), cB, voffB1); PG8_STAGE(PG8_SA(0, 0), cA, voffA); PG8_STAGE(PG8_SA(0, 1), cA + hstep, voffA);
        if (wr == 1) PG8_BAR;
        PG8_WAIT_V(2); PG8_BAR;
        PG8_STAGE(PG8_SB(1, 0), cB + kstep, voffB); PG8_STAGE(PG8_SA(1, 0), cA + kstep, voffA); PG8_STAGE(PG8_SB(1, 1), cB + kstep, voffB1);
        PG8_WAIT_V(6); PG8_BAR;
    } else {
    PG8_STAGE(PG8_SB(0, 0), cB, voffB); PG8_STAGE(PG8_SA(0, 0), cA, voffA); PG8_STAGE(PG8_SB(0, 1), cB, voffB1); PG8_STAGE(PG8_SA(0, 1), cA + hstep, voffA);
    if (wr == 1) PG8_BAR;
    PG8_WAIT_V(4); PG8_BAR;
    PG8_STAGE(PG8_SB(1, 0), cB + kstep, voffB); PG8_STAGE(PG8_SA(1, 0), cA + kstep, voffA); PG8_STAGE(PG8_SB(1, 1), cB + kstep, voffB1);
    PG8_WAIT_V(6); PG8_BAR;
    }
    for (;;) {
        const bool has_next = S.next(ui + 1, nxt);
        const char* nA = has_next ? (const char*)g.A + (size_t)nxt.pm * tstep : cA; const char* nB = has_next ? (const char*)g.Bt + (size_t)nxt.pn * tstep : cB;
        for (int t = 0; t < nt; t += 2) {
            const bool last = (t == nt - 2);
            const char* a1 = cA + (size_t)(t + 1) * kstep;
            const char* a2 = last ? nA : cA + (size_t)(t + 2) * kstep; const char* b2 = last ? nB : cB + (size_t)(t + 2) * kstep;
            const char* a3 = a2 + kstep; const char* b3 = b2 + kstep;
            if constexpr (SP2) {
            PG8_LDB(B0, 0, 0); PG8_LDB(B1, 0, 1); PG8_SCHED; PG8_LDA(At, 0, 0); PG8_STAGE(PG8_SA(1, 1), a1 + hstep, voffA);
            PG8_WAIT_V(8); PG8_WAIT_L(0); PG8_BAR; PG8_MMA(0, 0, At, B0); PG8_MMA(0, 1, At, B1); PG8_BAR; PG8_SCHED;
            PG8_LDA(At, 0, 1); PG8_STAGE(PG8_SB(0, 0), b2, voffB); PG8_STAGE(PG8_SB(0, 1), b2, voffB1); PG8_STAGE(PG8_SA(0, 0), a2, voffA);
            PG8_WAIT_V(8); PG8_WAIT_L(0); PG8_BAR; PG8_MMA(1, 0, At, B0); PG8_MMA(1, 1, At, B1); PG8_BAR; PG8_SCHED;
            PG8_LDB(B0, 1, 0); PG8_LDB(B1, 1, 1); PG8_SCHED; PG8_LDA(At, 1, 0); PG8_STAGE(PG8_SA(0, 1), a2 + hstep, voffA);
            PG8_WAIT_V(8); PG8_WAIT_L(0); PG8_BAR; PG8_MMA(0, 0, At, B0); PG8_MMA(0, 1, At, B1); PG8_BAR; PG8_SCHED;
            PG8_LDA(At, 1, 1); PG8_STAGE(PG8_SB(1, 0), b3, voffB); PG8_STAGE(PG8_SB(1, 1), b3, voffB1); PG8_STAGE(PG8_SA(1, 0), a3, voffA);
            PG8_WAIT_V(8); PG8_WAIT_L(0); PG8_BAR; PG8_MMA(1, 0, At, B0); PG8_MMA(1, 1, At, B1); PG8_BAR; PG8_SCHED;
            } else {
            PG8_LDB(B0, 0, 0); PG8_SCHED; PG8_LDA(At, 0, 0); PG8_STAGE(PG8_SA(1, 1), a1 + hstep, voffA);
            PG8_WAIT_L(8); PG8_BAR; PG8_WAIT_L(0); PG8_MMA(0, 0, At, B0); PG8_BAR; PG8_SCHED;
            PG8_LDB(B1, 0, 1); PG8_STAGE(PG8_SB(0, 0), b2, voffB);
            PG8_BAR; PG8_WAIT_L(0); PG8_MMA(0, 1, At, B1); PG8_BAR;
            PG8_LDA(At, 0, 1); PG8_STAGE(PG8_SA(0, 0), a2, voffA);
            PG8_BAR; PG8_WAIT_L(0); PG8_MMA(1, 0, At, B0); PG8_BAR; PG8_SCHED;
            PG8_STAGE(PG8_SB(0, 1), b2, voffB1);
            PG8_WAIT_V(6); PG8_BAR; PG8_MMA(1, 1, At, B1); PG8_BAR;
            PG8_LDB(B0, 1, 0); PG8_SCHED; PG8_LDA(At, 1, 0); PG8_STAGE(PG8_SA(0, 1), a2 + hstep, voffA);
            PG8_WAIT_L(8); PG8_BAR; PG8_WAIT_L(0); PG8_MMA(0, 0, At, B0); PG8_BAR; PG8_SCHED;
            PG8_LDB(B1, 1, 1); PG8_STAGE(PG8_SB(1, 0), b3, voffB);
            PG8_BAR; PG8_WAIT_L(0); PG8_MMA(0, 1, At, B1); PG8_BAR;
            PG8_LDA(At, 1, 1); PG8_STAGE(PG8_SA(1, 0), a3, voffA);
            PG8_BAR; PG8_WAIT_L(0); PG8_MMA(1, 0, At, B0); PG8_BAR; PG8_SCHED;
            PG8_STAGE(PG8_SB(1, 1), b3, voffB1);
            PG8_WAIT_V(6); PG8_BAR; PG8_MMA(1, 1, At, B1); PG8_BAR;
            }
        }
        if constexpr (ALIGN_EPI) { if (wr == 0) PG8_BAR; }
        if constexpr (!Epi::AFTER_DRAIN) E(acc, cur, wr, wc, fr, fq);
        if (!has_next) break;
#pragma unroll
        for (int a = 0; a < 2; ++a)
#pragma unroll
            for (int b = 0; b < 2; ++b)
#pragma unroll
                for (int m = 0; m < 4; ++m)
#pragma unroll
                    for (int n = 0; n < 2; ++n) acc[a][b][m][n] = (f32x4){0.f, 0.f, 0.f, 0.f};
        cur = nxt; cA = nA; cB = nB; ++ui;
        if constexpr (ALIGN_EPI) { if (wr == 1) PG8_BAR; }
    }
    PG8_WAIT_V(0);
    if constexpr (!ALIGN_EPI) { if (wr == 0) PG8_BAR; }
    PG8_BAR;
    if constexpr (Epi::AFTER_DRAIN) E.fused(acc, cur, wr, wc, fr, fq, lds, wid, lane);
#undef PG8_SA
#undef PG8_SB
#undef PG8_STAGE
#undef PG8_LDA
#undef PG8_LDB
#undef PG8_MMA
#undef PG8_WAIT_V
#undef PG8_WAIT_L
#undef PG8_BAR
#undef PG8_SCHED
}


#define XB_TMO      128
#define XB_XCNT(j)  (256  + 64 * (j))
#define XB_XSUB(j)  (1280 + 64 * (j))
#define XB_XGEN(j)  (2304 + 64 * (j))
#define XB_TOP      3328
#define XB_TOPGEN   3392
#define XCD_BAR_WORDS 3456
#define XB_SPIN_CAP (1u << 18)
__device__ __forceinline__ unsigned xb_ld(unsigned* p)              { return __hip_atomic_load(p, __ATOMIC_RELAXED, __HIP_MEMORY_SCOPE_AGENT); }
__device__ __forceinline__ unsigned xb_add(unsigned* p, unsigned v) { return __hip_atomic_fetch_add(p, v, __ATOMIC_RELAXED, __HIP_MEMORY_SCOPE_AGENT); }
__device__ __forceinline__ unsigned xb_xcc_id() { return (unsigned)__builtin_amdgcn_s_getreg((3 << 11) | 20) & 0xFu; }
#define XB_SPIN(cond, bar) do { unsigned _sp = 0; while (cond) { __builtin_amdgcn_s_sleep(1); \
    if ((++_sp & 255u) == 0u) { if (xb_ld(&(bar)[XB_TMO])) break; if (_sp > XB_SPIN_CAP) { atomicAdd(&(bar)[XB_TMO], 1u); break; } } } } while (0)
struct XcdBarrier { unsigned* bar; unsigned x; volatile LAS unsigned* st; };
__device__ __forceinline__ XcdBarrier xcd_barrier_post(unsigned* bar, volatile LAS unsigned* st) {
    XcdBarrier b; b.bar = bar; b.x = xb_xcc_id(); b.st = st;
    if (threadIdx.x == 0) (void)xb_add(&bar[XB_XCNT(b.x)], 1u);
    return b;
}
__device__ __forceinline__ void xcd_barrier_complete(unsigned* bar, unsigned x, unsigned& nloc, unsigned& nx) {
    const unsigned G = gridDim.x * gridDim.y * gridDim.z;
    unsigned sum, cnt, mine, sp = 0u;
    for (;;) {
        sum = 0u; cnt = 0u; mine = 0u;
#pragma unroll
        for (unsigned j = 0; j < 16; ++j) { const unsigned c = xb_ld(&bar[XB_XCNT(j)]); sum += c; cnt += (c > 0u) ? 1u : 0u; mine = (j == x) ? c : mine; }
        if (sum == G) break;
        __builtin_amdgcn_s_sleep(1);
        if ((++sp & 255u) == 0u) { if (xb_ld(&bar[XB_TMO])) break; if (sp > XB_SPIN_CAP) { atomicAdd(&bar[XB_TMO], 1u); break; } }
    }
    nloc = mine > 0u ? mine : 1u; nx = cnt > 0u ? cnt : 1u;
}
__device__ __forceinline__ void xcd_barrier(const XcdBarrier& b) {
    asm volatile("s_waitcnt vmcnt(0)" ::: "memory");
    __syncthreads();
    if (threadIdx.x == 0) {
        unsigned* bar = b.bar;
        const unsigned bx = xb_xcc_id();
        __builtin_amdgcn_s_waitcnt(0);
        unsigned nloc = b.st[0], nx = b.st[1];
        if (nloc == 0u) { xcd_barrier_complete(bar, bx, nloc, nx); b.st[0] = nloc; b.st[1] = nx; }
        const unsigned old = xb_add(&bar[XB_XSUB(bx)], 1u);
        const unsigned gen = old / nloc;
        if (old + 1u == (gen + 1u) * nloc) {
            __builtin_amdgcn_fence(__ATOMIC_RELEASE, "agent");
            asm volatile("s_waitcnt vmcnt(0)" ::: "memory");
            const unsigned og = xb_add(&bar[XB_TOP], 1u);
            const unsigned tg = og / nx;
            if (og + 1u == (tg + 1u) * nx) xb_add(&bar[XB_TOPGEN], 1u);
            else XB_SPIN(xb_ld(&bar[XB_TOPGEN]) == tg, bar);
            __builtin_amdgcn_fence(__ATOMIC_ACQUIRE, "agent");
            xb_add(&bar[XB_XGEN(bx)], 1u);
            asm volatile("s_waitcnt vmcnt(0)" ::: "memory");
        } else {
            XB_SPIN(xb_ld(&bar[XB_XGEN(bx)]) == gen, bar);
            __builtin_amdgcn_fence(__ATOMIC_ACQUIRE, "agent");
            asm volatile("s_waitcnt vmcnt(0)" ::: "memory");
        }
    }
    __syncthreads();
}

template <bool F16 = false>
__device__ __forceinline__ void tp_job(const float* src, size_t smat, int lsrc, int coff, bf16_t* dst, size_t dmat, int ldd, int R, int C, int nmat, LAS float* scr) {
    const int tid = opaque(threadIdx.x);
    const int ntc = C / 64, per = (R / 64) * ntc, total = per * nmat;
    const int G = gridDim.x;
    f32x4 v[2];
    int t = blockIdx.x;
#define TP_LOAD(tt_) do { const int i_ = (tt_) / per, t2_ = (tt_) % per, tr_ = t2_ / ntc, tc_ = t2_ % ntc; const float* s_ = src + (size_t)i_ * smat + coff; \
        _Pragma("unroll") for (int k_ = 0; k_ < 2; ++k_) { const int idx_ = tid + 512 * k_, row_ = idx_ >> 4, c4_ = idx_ & 15; v[k_] = *(const f32x4*)(s_ + (size_t)(tr_ * 64 + row_) * lsrc + tc_ * 64 + c4_ * 4); } } while (0)
    if (t < total) TP_LOAD(t);
#pragma unroll 1
    for (; t < total; t += G) {
#pragma unroll
        for (int k = 0; k < 2; ++k) { const int idx = tid + 512 * k, row = idx >> 4, c4 = idx & 15; LAS float* pp = scr + row * 65 + c4 * 4; pp[0] = v[k][0]; pp[1] = v[k][1]; pp[2] = v[k][2]; pp[3] = v[k][3]; }
        if (t + G < total) TP_LOAD(t + G);
        __syncthreads();
        { const int i = t / per, t2 = t % per, tr = t2 / ntc, tc = t2 % ntc; bf16_t* d = dst + (size_t)i * dmat;
          const int c = tid >> 3, ch = tid & 7; const LAS float* sp = scr + (ch * 8) * 65 + c;
          u32x4 o; o.x = cvt_pk16<F16>(sp[0], sp[65]); o.y = cvt_pk16<F16>(sp[2 * 65], sp[3 * 65]); o.z = cvt_pk16<F16>(sp[4 * 65], sp[5 * 65]); o.w = cvt_pk16<F16>(sp[6 * 65], sp[7 * 65]);
          *(u32x4*)(d + (size_t)(tc * 64 + c) * ldd + tr * 64 + ch * 8) = o; }
        __syncthreads();
    }
#undef TP_LOAD
}

struct Params {
    const float *x, *w_in_a, *w_grp_a, *scale_a, *w_out_a, *w_kv, *w_in_b, *w_out_b, *ln_g, *ln_b;
    float* out; unsigned char* ws;
};

__device__ __forceinline__ void phase_prep(const Params& p, LAS unsigned char* lds) {
    LAS float* scr = (LAS float*)lds;
    unsigned char* ws = p.ws;
    tp_job<true>(p.w_in_a, (size_t)1024 * 4096, 4096, 2048, (bf16_t*)(ws + OFF_BTA) + (size_t)2048 * 1024, (size_t)4096 * 1024, 1024, 1024, 2048, 2, scr);
    tp_job(p.w_out_a, (size_t)2048 * 1024, 1024, 0, (bf16_t*)(ws + OFF_WOA), (size_t)1024 * 2048, 2048, 2048, 1024, 2, scr);
    tp_job<true>(p.w_kv, 0, 6144, 0, (bf16_t*)(ws + OFF_KVT), 0, 1024, 1024, 6144, 1, scr);
    tp_job<true>(p.w_in_b, (size_t)1024 * 4096, 4096, 0, (bf16_t*)(ws + OFF_INB), (size_t)4096 * 1024, 1024, 1024, 4096, 2, scr);
    tp_job<true>(p.w_grp_a, (size_t)512 * 512, 512, 0, (bf16_t*)(ws + OFF_WGT), (size_t)512 * 512, 512, 512, 512, 8, scr);
    { bf16_t* winu = (bf16_t*)(ws + OFF_WINU);
      const int total = 2 * 4 * 1024 * 64;
      const int tid = opaque(threadIdx.x);
#pragma unroll 1
      for (int i0 = blockIdx.x * 512 + tid; i0 < total; i0 += gridDim.x * 512 * 4) {
          f32x4 a[4], b[4];
#pragma unroll
          for (int u = 0; u < 4; ++u) { const int i = i0 + u * gridDim.x * 512; if (i < total) { const int c8 = i & 63, k = (i >> 6) & 1023, lg = i >> 16, l = lg >> 2, g = lg & 3;
              const float* s = p.w_in_a + ((size_t)l * 1024 + k) * 4096 + g * 512 + c8 * 8; a[u] = *(const f32x4*)s; b[u] = *(const f32x4*)(s + 4); } }
#pragma unroll
          for (int u = 0; u < 4; ++u) { const int i = i0 + u * gridDim.x * 512; if (i < total) {
              u32x4 o; o.x = cvt_pk_f16(a[u][0], a[u][1]); o.y = cvt_pk_f16(a[u][2], a[u][3]); o.z = cvt_pk_f16(b[u][0], b[u][1]); o.w = cvt_pk_f16(b[u][2], b[u][3]);
              *(u32x4*)(winu + (size_t)i * 8) = o; } } } }
    { bf16_t* hb = (bf16_t*)(ws + OFF_HB);
      const int total = MT * DM / 8;
      const int tid = opaque(threadIdx.x);
#pragma unroll 1
      for (int i0 = blockIdx.x * 512 + tid; i0 < total; i0 += gridDim.x * 512 * 4) {
          f32x4 a[4], b[4];
#pragma unroll
          for (int u = 0; u < 4; ++u) { const int i = i0 + u * gridDim.x * 512; if (i < total) { const float* s = p.x + (size_t)i * 8; a[u] = *(const f32x4*)s; b[u] = *(const f32x4*)(s + 4); } }
#pragma unroll
          for (int u = 0; u < 4; ++u) { const int i = i0 + u * gridDim.x * 512; if (i < total) {
              u32x4 o; o.x = cvt_pk_f16(a[u][0], a[u][1]); o.y = cvt_pk_f16(a[u][2], a[u][3]); o.z = cvt_pk_f16(b[u][0], b[u][1]); o.w = cvt_pk_f16(b[u][2], b[u][3]);
              *(u32x4*)(hb + (size_t)i * 8) = o; } } } }
}

__device__ __forceinline__ void unpack8(const u32x4 w, float (&f)[8]) { f[0] = bf_lo(w.x); f[1] = bf_hi(w.x); f[2] = bf_lo(w.y); f[3] = bf_hi(w.y); f[4] = bf_lo(w.z); f[5] = bf_hi(w.z); f[6] = bf_lo(w.w); f[7] = bf_hi(w.w); }
template <int W>
__device__ __forceinline__ void pool_item(const bf16_t* V, bf16_t* SG, const float (&sc)[8], int t0, int c0) {
    const int s0 = t0 & (SEQ - 1);
    u32x4 rows[W + 3], gts[4];
#pragma unroll
    for (int j = 0; j < W + 3; ++j) { const int dt = j - (W - 1); rows[j] = (u32x4){0u, 0u, 0u, 0u}; if (s0 + dt >= 0) rows[j] = *(const u32x4*)(V + (size_t)(t0 + dt) * 2048 + c0); }
#pragma unroll
    for (int i = 0; i < 4; ++i) gts[i] = *(const u32x4*)(SG + (size_t)(t0 + i) * 2048 + c0);
    float sum[8];
#pragma unroll
    for (int j = 0; j < 8; ++j) sum[j] = 0.f;
#pragma unroll
    for (int j = 0; j < W - 1; ++j) { float f[8]; unpack8(rows[j], f);
#pragma unroll
        for (int k = 0; k < 8; ++k) sum[k] += f[k]; }
#pragma unroll
    for (int i = 0; i < 4; ++i) {
        float f[8], gt[8]; unpack8(rows[W - 1 + i], f); unpack8(gts[i], gt);
#pragma unroll
        for (int k = 0; k < 8; ++k) sum[k] += f[k];
        const int s = s0 + i; const float inv = 1.0f / (float)(s + 1 < W ? s + 1 : W);
        float o[8];
#pragma unroll
        for (int k = 0; k < 8; ++k) o[k] = (sum[k] * inv - f[k]) * sc[k] * gt[k];
        u32x4 wv; wv.x = cvt_pk_bf16(o[0], o[1]); wv.y = cvt_pk_bf16(o[2], o[3]); wv.z = cvt_pk_bf16(o[4], o[5]); wv.w = cvt_pk_bf16(o[6], o[7]);
        *(u32x4*)(SG + (size_t)(t0 + i) * 2048 + c0) = wv;
        float fo[8]; unpack8(rows[i], fo);
#pragma unroll
        for (int k = 0; k < 8; ++k) sum[k] -= fo[k];
    }
}
__device__ __forceinline__ void phase_pool(const bf16_t* V, bf16_t* SG, const float* scale) {
    const int tid = opaque(threadIdx.x), cth = tid & 255, sub = tid >> 8;
    const int c0 = cth * 8, grp = c0 >> 9;
    float sc[8];
    { const f32x4 a = *(const f32x4*)(scale + c0), b = *(const f32x4*)(scale + c0 + 4); sc[0] = a[0]; sc[1] = a[1]; sc[2] = a[2]; sc[3] = a[3]; sc[4] = b[0]; sc[5] = b[1]; sc[6] = b[2]; sc[7] = b[3]; }
    const int qper = (MT / 4) / (int)gridDim.x;
#pragma unroll 1
    for (int qi = sub; qi < qper; qi += 2) {
        const int q = blockIdx.x * qper + qi;
        const int t0 = q * 4;
        if (grp == 0) pool_item<2>(V, SG, sc, t0, c0);
        else if (grp == 1) pool_item<4>(V, SG, sc, t0, c0);
        else if (grp == 2) pool_item<8>(V, SG, sc, t0, c0);
        else pool_item<16>(V, SG, sc, t0, c0);
    }
}

template <int V_> struct AttIC { static constexpr int value = V_; };
struct AttGeo { int dsh, dil, L, nblk, g; };
__device__ __forceinline__ void att_decode(const AttGeo& G_, int it, int& hh, int& b, int& r, int& n) { n = it & (G_.nblk - 1); const int y = it >> (5 - G_.dsh); r = y & (G_.dil - 1); const int z = y >> G_.dsh; b = z & 3; hh = z >> 2; }
__device__ __forceinline__ void att_dma_half(const AttGeo& G_, const bf16_t* Kr, const bf16_t* Vt, int it, int which, int slot, LAS unsigned char* lds, int wid, int lane0) {
    int hh, b, r, n; att_decode(G_, it, hh, b, r, n);
    const int lane = opaque(lane0);
    int blk = n - 1 + which; blk = blk < 0 ? 0 : blk;
    const bf16_t* kb = Kr + ((size_t)(((G_.g * 16 + hh) * 4 + b) * SEQ + r * G_.L + blk * 128)) * 64;
    const bf16_t* vb = Vt + (size_t)(G_.g * 1024 + hh * 64) * MT + b * SEQ + r * G_.L + blk * 128;
    LAS unsigned char* kl = lds + slot * 32768; LAS unsigned char* vl = kl + 16384;
#pragma unroll
    for (int rd = 0; rd < 2; ++rd) { const int ch = rd * 8 + wid; const int rho = ch * 8 + (lane >> 3); const int cs = (lane & 7) ^ ((rho >> 1) & 7);
        __builtin_amdgcn_global_load_lds((const unsigned*)(kb + (size_t)rho * 64 + cs * 8), (LAS unsigned*)(kl + ch * 1024), 16, 0, 0); }
#pragma unroll
    for (int rd = 0; rd < 2; ++rd) { const int ch = rd * 8 + wid; const int d = ch * 4 + (lane >> 4); const int cs = (lane & 15) ^ (d & 15);
        __builtin_amdgcn_global_load_lds((const unsigned*)(vb + (size_t)d * MT + cs * 8), (LAS unsigned*)(vl + ch * 1024), 16, 0, 0); }
}
__device__ __forceinline__ int att_first_item() { return ((blockIdx.x & 7) * 32 + (blockIdx.x >> 3)) * 8; }
__device__ __forceinline__ void attn_issue_first(const bf16_t* Kr, const bf16_t* Vt, int g, LAS unsigned char* lds) {
    const int tid = opaque(threadIdx.x), wid = __builtin_amdgcn_readfirstlane(tid >> 6), lane0 = tid & 63;
    AttGeo G_; G_.g = g; G_.dsh = 2 * g; G_.dil = 1 << G_.dsh; G_.L = SEQ >> G_.dsh; G_.nblk = G_.L >> 7;
    const int it = att_first_item();
    att_dma_half(G_, Kr, Vt, it, 0, 3, lds, wid, lane0);
    att_dma_half(G_, Kr, Vt, it, 1, 0, lds, wid, lane0);
}
template <bool PRE>
__device__ __forceinline__ void phase_attn(const bf16_t* Q, const bf16_t* Kr, const bf16_t* Vt, bf16_t* ACC, float* LSE, int g, LAS unsigned char* lds) {
    const int tid = opaque(threadIdx.x), wid = __builtin_amdgcn_readfirstlane(tid >> 6), lane0 = tid & 63, q0 = lane0 & 15, q40 = lane0 >> 4;
    AttGeo G_; G_.g = g; G_.dsh = 2 * g; G_.dil = 1 << G_.dsh; G_.L = SEQ >> G_.dsh; G_.nblk = G_.L >> 7;
    const int dsh = G_.dsh, dil = G_.dil;
    const int it0 = att_first_item();
    bf16x8 qf[2]; u32x2 oldacc[4]; float oldlse = 0.f; int tq = 0, hh = 0, n = 0;
    {
        if constexpr (!PRE) { att_dma_half(G_, Kr, Vt, it0, 0, 3, lds, wid, lane0); att_dma_half(G_, Kr, Vt, it0, 1, 0, lds, wid, lane0); }
        int b, r; att_decode(G_, it0, hh, b, r, n);
        tq = b * SEQ + ((n * 128 + wid * 16 + q0) << dsh) + r;
#pragma unroll
        for (int ks = 0; ks < 2; ++ks) qf[ks] = *(const bf16x8*)(Q + (size_t)tq * 1024 + hh * 64 + ks * 32 + q40 * 8);
        if (g > 0) { oldlse = LSE[(size_t)hh * MT + tq];
#pragma unroll
            for (int dt = 0; dt < 4; ++dt) oldacc[dt] = *(const u32x2*)(ACC + (size_t)tq * 1024 + hh * 64 + q40 * 4 + dt * 16); }
    }
    u32x2 pend[4]; float pend_lse = 0.f; int pend_tq = 0, pend_hh = 0; bool have_pend = false;
    auto item_body = [&](auto kkc, int k) __attribute__((always_inline)) {
        constexpr int KK = decltype(kkc)::value;
        constexpr int SC = KK, SP = (KK + 3) & 3, SN = (KK + 1) & 3;
        asm volatile("s_waitcnt vmcnt(0)" ::: "memory");
        __builtin_amdgcn_s_barrier();
        asm volatile("" ::: "memory");
        asm volatile("" : "+v"(qf[0]), "+v"(qf[1]), "+v"(oldacc[0]), "+v"(oldacc[1]), "+v"(oldacc[2]), "+v"(oldacc[3]), "+v"(oldlse));
        if (have_pend) {
            bf16_t* pp = ACC + (size_t)pend_tq * 1024 + pend_hh * 64 + q40 * 4;
#pragma unroll
            for (int dt = 0; dt < 4; ++dt) *(u32x2*)(pp + dt * 16) = pend[dt];
            if (q40 == 0) LSE[(size_t)pend_hh * MT + pend_tq] = pend_lse;
        }
        const int q = opaque(q0), q4 = opaque(q40);
        bf16x8 qn[2]; u32x2 oldn[4]; float oldlsen = 0.f; int tqn = 0, hhn = 0, nn = 0;
        if (k + 1 < 8) {
            const int itn = it0 + k + 1;
            att_dma_half(G_, Kr, Vt, itn, 1, SN, lds, wid, lane0);
            int b, r; att_decode(G_, itn, hhn, b, r, nn);
            tqn = b * SEQ + ((nn * 128 + wid * 16 + q) << dsh) + r;
#pragma unroll
            for (int ks = 0; ks < 2; ++ks) qn[ks] = *(const bf16x8*)(Q + (size_t)tqn * 1024 + hhn * 64 + ks * 32 + q4 * 8);
            if (g > 0) { oldlsen = LSE[(size_t)hhn * MT + tqn];
#pragma unroll
                for (int dt = 0; dt < 4; ++dt) oldn[dt] = *(const u32x2*)(ACC + (size_t)tqn * 1024 + hhn * 64 + q4 * 4 + dt * 16); }
        }
        const float slope = __builtin_amdgcn_exp2f(-8.0f * (float)(g * 16 + hh + 1) / 48.0f);
        const float bias2 = slope * (float)dil * LOG2E;
        f32x4 sacc[9];
        {
            bf16x8 kf[9][2];
#pragma unroll
            for (int kt = 0; kt < 9; ++kt) { const int t16 = wid + kt; const int rl = (t16 & 7) * 16 + q, sw = (rl >> 1) & 7;
                const LAS unsigned char* kb_ = (t16 >= 8) ? (lds + SC * 32768) : (lds + SP * 32768);
                kf[kt][0] = *(const LAS bf16x8*)(kb_ + rl * 128 + ((q4 ^ sw) * 16));
                kf[kt][1] = *(const LAS bf16x8*)(kb_ + rl * 128 + (((4 + q4) ^ sw) * 16)); }
            asm volatile("" : "+v"(kf[0][0]), "+v"(kf[0][1]), "+v"(kf[1][0]), "+v"(kf[1][1]), "+v"(kf[2][0]), "+v"(kf[2][1]), "+v"(kf[3][0]), "+v"(kf[3][1]), "+v"(kf[4][0]), "+v"(kf[4][1]));
            asm volatile("" : "+v"(kf[5][0]), "+v"(kf[5][1]), "+v"(kf[6][0]), "+v"(kf[6][1]), "+v"(kf[7][0]), "+v"(kf[7][1]), "+v"(kf[8][0]), "+v"(kf[8][1]));
#pragma unroll
            for (int kt = 0; kt < 9; ++kt) { f32x4 a = (f32x4){0.f, 0.f, 0.f, 0.f};
                a = __builtin_amdgcn_mfma_f32_16x16x32_bf16(kf[kt][0], qf[0], a, 0, 0, 0);
                sacc[kt] = a; }
#pragma unroll
            for (int kt = 0; kt < 9; ++kt) sacc[kt] = __builtin_amdgcn_mfma_f32_16x16x32_bf16(kf[kt][1], qf[1], sacc[kt], 0, 0, 0);
        }
        const float relb = (float)(128 + q - q4 * 4);
        const float a0 = -bias2 * relb;
        float mx = -1e30f;
#pragma unroll
        for (int kt = 0; kt < 9; ++kt)
#pragma unroll
            for (int jj = 0; jj < 4; ++jj) {
                float s = __builtin_fmaf(sacc[kt][jj], 0.125f * LOG2E, __builtin_fmaf(bias2, (float)(kt * 16 + jj), a0));
                if (kt == 0) { if (q4 * 4 + jj < q) s = -1e30f; }
                if (kt == 8) { if (q4 * 4 + jj > q) s = -1e30f; }
                sacc[kt][jj] = s; }
        if (n == 0) {
#pragma unroll
            for (int kt = 0; kt < 8; ++kt)
#pragma unroll
                for (int jj = 0; jj < 4; ++jj) if (wid * 16 + kt * 16 + q4 * 4 + jj < 128) sacc[kt][jj] = -1e30f;
        }
#pragma unroll
        for (int kt = 0; kt < 9; ++kt)
#pragma unroll
            for (int jj = 0; jj < 4; ++jj) mx = fmaxf(mx, sacc[kt][jj]);
        mx = fmaxf(mx, __shfl_xor(mx, 16)); mx = fmaxf(mx, __shfl_xor(mx, 32));
        float lsum = 0.f;
#pragma unroll
        for (int kt = 0; kt < 9; ++kt)
#pragma unroll
            for (int jj = 0; jj < 4; ++jj) { const float pv = __builtin_amdgcn_exp2f(sacc[kt][jj] - mx); sacc[kt][jj] = pv; lsum += pv; }
        lsum += __shfl_xor(lsum, 16); lsum += __shfl_xor(lsum, 32);
        f32x4 oacc[4];
#pragma unroll
        for (int dt = 0; dt < 4; ++dt) oacc[dt] = (f32x4){0.f, 0.f, 0.f, 0.f};
#pragma unroll
        for (int kp2 = 0; kp2 < 5; ++kp2) {
            u32x4 pw; pw.x = cvt_pk_bf16(sacc[2 * kp2][0], sacc[2 * kp2][1]); pw.y = cvt_pk_bf16(sacc[2 * kp2][2], sacc[2 * kp2][3]);
            if (kp2 < 4) { pw.z = cvt_pk_bf16(sacc[kp2 < 4 ? 2 * kp2 + 1 : 8][0], sacc[kp2 < 4 ? 2 * kp2 + 1 : 8][1]); pw.w = cvt_pk_bf16(sacc[kp2 < 4 ? 2 * kp2 + 1 : 8][2], sacc[kp2 < 4 ? 2 * kp2 + 1 : 8][3]); }
            else { pw.z = 0u; pw.w = 0u; }
            bf16x8 pf; __builtin_memcpy(&pf, &pw, 16);
            const int chb = 2 * wid + 4 * kp2;
            const LAS unsigned char* v0b = ((chb >> 4) ? (lds + SC * 32768) : (lds + SP * 32768)) + 16384;
            const LAS unsigned char* v1b = (((chb + 2) >> 4) ? (lds + SC * 32768) : (lds + SP * 32768)) + 16384;
            const int c0 = (chb & 15) + (q4 >> 1), c1 = ((chb + 2) & 15) + (q4 >> 1);
#pragma unroll
            for (int dt = 0; dt < 4; ++dt) {
                const int d = dt * 16 + q;
                const int roff = d * 256 + (q4 & 1) * 8;
                u32x4 vw; const u32x2 lo = *(const LAS u32x2*)(v0b + roff + ((c0 ^ q) * 16)); vw.x = lo.x; vw.y = lo.y;
                if (kp2 < 4) { const u32x2 hi = *(const LAS u32x2*)(v1b + roff + ((c1 ^ q) * 16)); vw.z = hi.x; vw.w = hi.y; } else { vw.z = 0u; vw.w = 0u; }
                bf16x8 vf; __builtin_memcpy(&vf, &vw, 16);
                oacc[dt] = __builtin_amdgcn_mfma_f32_16x16x32_bf16(vf, pf, oacc[dt], 0, 0, 0);
            }
            __builtin_amdgcn_sched_barrier(0);
        }
        const float inv = 1.0f / lsum;
        float lse = (mx + __log2f(lsum)) * LN2;
        float w_new = inv, w_old = 0.f;
        if (g > 0) {
            const float mm = fmaxf(oldlse, lse), e0 = __expf(oldlse - mm), e1 = __expf(lse - mm), tot = e0 + e1;
            w_old = e0 / tot; w_new = inv * (e1 / tot); lse = mm + __logf(tot);
        }
#pragma unroll
        for (int dt = 0; dt < 4; ++dt) {
            f32x4 o = oacc[dt] * w_new;
            if (g > 0) { const u32x2 pr = oldacc[dt]; o[0] += w_old * bf_lo(pr.x); o[1] += w_old * bf_hi(pr.x); o[2] += w_old * bf_lo(pr.y); o[3] += w_old * bf_hi(pr.y); }
            u32x2 w; w.x = cvt_pk_bf16(o[0], o[1]); w.y = cvt_pk_bf16(o[2], o[3]);
            pend[dt] = w;
        }
        pend_lse = lse; pend_tq = tq; pend_hh = hh; have_pend = true;
        qf[0] = qn[0]; qf[1] = qn[1]; oldlse = oldlsen; tq = tqn; hh = hhn; n = nn;
#pragma unroll
        for (int dt = 0; dt < 4; ++dt) oldacc[dt] = oldn[dt];
    };
#pragma unroll 1
    for (int kq = 0; kq < 2; ++kq) { item_body(AttIC<0>{}, 4 * kq); item_body(AttIC<1>{}, 4 * kq + 1); item_body(AttIC<2>{}, 4 * kq + 2); item_body(AttIC<3>{}, 4 * kq + 3); }
    if (have_pend) {
        bf16_t* pp = ACC + (size_t)pend_tq * 1024 + pend_hh * 64 + q40 * 4;
#pragma unroll
        for (int dt = 0; dt < 4; ++dt) *(u32x2*)(pp + dt * 16) = pend[dt];
        if (q40 == 0) LSE[(size_t)pend_hh * MT + pend_tq] = pend_lse;
    }
    asm volatile("s_waitcnt vmcnt(0)" ::: "memory");
    __builtin_amdgcn_s_barrier();
}

__global__ void __launch_bounds__(512, 2) yoco_fwd(Params p) {
    extern __shared__ __attribute__((aligned(16))) unsigned char smem[];
    LAS unsigned char* lds = (LAS unsigned char*)smem;
    cg::grid_group grid = cg::this_grid();
    volatile LAS unsigned* xst = (volatile LAS unsigned*)(lds + 131072);
    if (threadIdx.x < 4) xst[threadIdx.x] = 0u;
    __syncthreads();
    const XcdBarrier xb = xcd_barrier_post((unsigned*)(p.ws + OFF_BAR), xst);
    if (p.ws == nullptr) grid.sync();
    unsigned char* ws = p.ws;
    const int G = gridDim.x, c = blockIdx.x;
    bf16_t* HB = (bf16_t*)(ws + OFF_HB);

    phase_prep(p, lds);
    xcd_barrier(xb);
    { SingleUnit S; S.has = c < 64; const int lg = c >> 3, un = c & 7; S.u0.pm = un >> 2; S.u0.pn = un & 3;
      Gemm gm; gm.A = (const bf16_t*)(ws + OFF_WGT) + (size_t)lg * 512 * 512; gm.Bt = (const bf16_t*)(ws + OFF_WINU) + (size_t)lg * 1024 * 512; gm.M = 512; gm.N = 1024; gm.K = 512;
      EpiStore16<true> E; E.O = (bf16_t*)(ws + OFF_BTA) + (size_t)(lg >> 2) * 4096 * 1024 + (size_t)(lg & 3) * 512 * 1024; E.ldc = 1024;
      gemm_phase<EpiStore16<true>, SingleUnit, 0, true>(lds, gm, S, E); }
    xcd_barrier(xb);
    for (int l = 0; l < 2; ++l) {
        { StaticOrder S; S.init(MT, 4096, G, c); Gemm gm; gm.A = HB; gm.Bt = (const bf16_t*)(ws + OFF_BTA) + (size_t)l * 4096 * 1024; gm.M = MT; gm.N = 4096; gm.K = 1024;
          EpiAG1 E; E.V = (bf16_t*)(ws + OFF_V); E.SG = (bf16_t*)(ws + OFF_SG); gemm_phase<EpiAG1, StaticOrder, 0, true>(lds, gm, S, E); }
        xcd_barrier(xb);
        phase_pool((const bf16_t*)(ws + OFF_V), (bf16_t*)(ws + OFF_SG), p.scale_a + l * 2048);
        xcd_barrier(xb);
        { StaticOrder S; S.init(MT, 1024, G, c); Gemm gm; gm.A = (const bf16_t*)(ws + OFF_SG); gm.Bt = (const bf16_t*)(ws + OFF_WOA) + (size_t)l * 1024 * 2048; gm.M = MT; gm.N = 1024; gm.K = 2048;
          if (l == 0) { EpiLnFused<false, false, true, true> E; E.hin_f = nullptr; E.hin_b = HB; E.out_f = nullptr; E.out_b = HB; E.gam = p.ln_g; E.bet = p.ln_b;
              E.xbuf = (unsigned long long*)(ws + OFF_XBUF); E.cnt = (unsigned*)(ws + OFF_CNT); E.want = 32u; gemm_phase(lds, gm, S, E); }
          else { EpiLnFused<false, false, true, true> E; E.hin_f = nullptr; E.hin_b = HB; E.out_f = nullptr; E.out_b = HB; E.gam = p.ln_g + DM; E.bet = p.ln_b + DM;
              E.xbuf = (unsigned long long*)(ws + OFF_XBUF); E.cnt = (unsigned*)(ws + OFF_CNT); E.want = 64u; gemm_phase(lds, gm, S, E); } }
        xcd_barrier(xb);
    }
    { StaticOrder S; S.init(MT, 3072, G, c); Gemm gm; gm.A = HB; gm.Bt = (const bf16_t*)(ws + OFF_KVT); gm.M = MT; gm.N = 3072; gm.K = 1024;
      EpiKr E; E.Kr = (bf16_t*)(ws + OFF_K); gemm_phase<EpiKr, StaticOrder, 0, true>(lds, gm, S, E); }
    { StaticOrder S; S.init(1024, MT, G, c); Gemm gm; gm.Bt = HB; gm.M = 1024; gm.N = MT; gm.K = 1024;
      gm.A = (const bf16_t*)(ws + OFF_KVT) + (size_t)(3072 + 0) * 1024;    { EpiVt<0> E; E.Vt = (bf16_t*)(ws + OFF_VT) + (size_t)0 * MT;    gemm_phase<EpiVt<0>, StaticOrder, 0, true>(lds, gm, S, E); }
      gm.A = (const bf16_t*)(ws + OFF_KVT) + (size_t)(3072 + 1024) * 1024; { EpiVt<2> E; E.Vt = (bf16_t*)(ws + OFF_VT) + (size_t)1024 * MT; gemm_phase<EpiVt<2>, StaticOrder, 2, true>(lds, gm, S, E); }
      gm.A = (const bf16_t*)(ws + OFF_KVT) + (size_t)(3072 + 2048) * 1024; { EpiVt<4> E; E.Vt = (bf16_t*)(ws + OFF_VT) + (size_t)2048 * MT; gemm_phase<EpiVt<4>, StaticOrder, 4, true>(lds, gm, S, E); } }
    bf16_t* QG = (bf16_t*)p.out; bf16_t* QY = (bf16_t*)p.out + (size_t)MT * DM; bf16_t* ACC = QG; float* LSE = (float*)(ws + OFF_LSE);
    for (int j = 0; j < 2; ++j) {
        const bf16_t* inb = (const bf16_t*)(ws + OFF_INB) + (size_t)j * 4096 * 1024;
        { StaticOrder S; S.init(MT, 2048, G, c); Gemm gm; gm.A = HB; gm.Bt = inb; gm.M = MT; gm.N = 2048; gm.K = 1024;
          EpiStoreSplit E; E.O0 = QG; E.O1 = QY; gemm_phase<EpiStoreSplit, StaticOrder, 0, true>(lds, gm, S, E); }
        if (j != 0) attn_issue_first((const bf16_t*)(ws + OFF_K), (const bf16_t*)(ws + OFF_VT), 0, lds);
        xcd_barrier(xb);
        if (j == 0) { tp_job(p.w_out_b, (size_t)1024 * 1024, 1024, 0, (bf16_t*)(ws + OFF_OUTB), (size_t)1024 * 1024, 1024, 1024, 1024, 2, (LAS float*)lds);
                      phase_attn<false>(QG, (const bf16_t*)(ws + OFF_K), (const bf16_t*)(ws + OFF_VT), QG, LSE, 0, lds); }
        else phase_attn<true>(QG, (const bf16_t*)(ws + OFF_K), (const bf16_t*)(ws + OFF_VT), QG, LSE, 0, lds);
        attn_issue_first((const bf16_t*)(ws + OFF_K), (const bf16_t*)(ws + OFF_VT), 1, lds);
        xcd_barrier(xb);
        phase_attn<true>(QY, (const bf16_t*)(ws + OFF_K), (const bf16_t*)(ws + OFF_VT), QG, LSE, 1, lds);
        xcd_barrier(xb);
        { StaticOrder S; S.init(MT, 1024, G, c); Gemm gm; gm.A = HB; gm.Bt = inb + (size_t)2 * 1024 * 1024; gm.M = MT; gm.N = 1024; gm.K = 1024;
          EpiStore16<false> E; E.O = QY; E.ldc = 1024; gemm_phase<EpiStore16<false>, StaticOrder, 0, true>(lds, gm, S, E); }
        attn_issue_first((const bf16_t*)(ws + OFF_K), (const bf16_t*)(ws + OFF_VT), 2, lds);
        xcd_barrier(xb);
        phase_attn<true>(QY, (const bf16_t*)(ws + OFF_K), (const bf16_t*)(ws + OFF_VT), QG, LSE, 2, lds);
        xcd_barrier(xb);
        bf16_t* ZB = j == 0 ? ACC : (bf16_t*)(ws + OFF_K);
        { StaticOrder S; S.init(MT, 1024, G, c); Gemm gm; gm.A = HB; gm.Bt = inb + (size_t)3 * 1024 * 1024; gm.M = MT; gm.N = 1024; gm.K = 1024;
          EpiGateMul E; E.Zin = ACC; E.Zout = ZB; gemm_phase<EpiGateMul, StaticOrder, 0, true>(lds, gm, S, E); }
        xcd_barrier(xb);
        { StaticOrder S; S.init(MT, 1024, G, c); Gemm gm; gm.A = ZB; gm.Bt = (const bf16_t*)(ws + OFF_OUTB) + (size_t)j * 1024 * 1024; gm.M = MT; gm.N = 1024; gm.K = 1024;
          if (j == 0) { EpiLnFused<false, false, true, true> E; E.hin_f = nullptr; E.hin_b = HB; E.out_f = nullptr; E.out_b = HB; E.gam = p.ln_g + 2 * DM; E.bet = p.ln_b + 2 * DM;
              E.xbuf = (unsigned long long*)(ws + OFF_XBUF); E.cnt = (unsigned*)(ws + OFF_CNT); E.want = 96u; gemm_phase(lds, gm, S, E); }
          else { EpiLnFused<false, true, false, true> E; E.hin_f = nullptr; E.hin_b = HB; E.out_f = p.out; E.out_b = nullptr; E.gam = p.ln_g + 3 * DM; E.bet = p.ln_b + 3 * DM;
              E.xbuf = (unsigned long long*)(ws + OFF_XBUF); E.cnt = (unsigned*)(ws + OFF_CNT); E.want = 128u; gemm_phase(lds, gm, S, E); } }
        xcd_barrier(xb);
    }
}

extern "C" void kernel_launch(void* const* d_in, const int* in_sizes, int n_in, void* d_out, int out_size, void* d_ws, size_t ws_size, hipStream_t stream) {
    static int grid = 0;
    if (grid == 0) {
        if (n_in != 10 || out_size != MT * DM || ws_size < WS_NEED) { fprintf(stderr, "kernel_launch: unexpected shapes / workspace (n_in %d out %d ws %zu)\n", n_in, out_size, ws_size); grid = -1; return; }
        int dev = 0, cus = 0, per_cu = 0;
        hipGetDevice(&dev);
        hipDeviceGetAttribute(&cus, hipDeviceAttributeMultiprocessorCount, dev);
        hipFuncSetAttribute((const void*)yoco_fwd, hipFuncAttributeMaxDynamicSharedMemorySize, LDS_BYTES);
        hipOccupancyMaxActiveBlocksPerMultiprocessor(&per_cu, (const void*)yoco_fwd, 512, LDS_BYTES);
        if (per_cu < 1) per_cu = 1;
        (void)hipGetLastError();
        grid = cus;
    }
    if (grid < 0) return;
    Params p{};
    p.x = (const float*)d_in[0]; p.w_in_a = (const float*)d_in[1]; p.w_grp_a = (const float*)d_in[2]; p.scale_a = (const float*)d_in[3]; p.w_out_a = (const float*)d_in[4];
    p.w_kv = (const float*)d_in[5]; p.w_in_b = (const float*)d_in[6]; p.w_out_b = (const float*)d_in[7]; p.ln_g = (const float*)d_in[8]; p.ln_b = (const float*)d_in[9];
    p.out = (float*)d_out; p.ws = (unsigned char*)d_ws;
    if (hipMemsetAsync((unsigned char*)d_ws + OFF_BAR, 0, 32768, stream) != hipSuccess) { fprintf(stderr, "memset failed\n"); return; }
    void* args[] = {&p};
    hipError_t e = hipLaunchCooperativeKernel((const void*)yoco_fwd, dim3(grid), dim3(512), args, LDS_BYTES, stream);
    if (e != hipSuccess) fprintf(stderr, "cooperative launch failed: %s (grid %d)\n", hipGetErrorString(e), grid);
}
```

```cpp
#include <hip/hip_runtime.h>
#include <hip/hip_cooperative_groups.h>
#include <cstdio>
namespace cg = cooperative_groups;

#define LAS __attribute__((address_space(3)))
typedef unsigned short bf16_t;
typedef short bf16x8 __attribute__((ext_vector_type(8)));
typedef short bf16x4 __attribute__((ext_vector_type(4)));
typedef float f32x4 __attribute__((ext_vector_type(4)));
typedef float f32x2 __attribute__((ext_vector_type(2)));
typedef unsigned u32x4 __attribute__((ext_vector_type(4)));
typedef unsigned u32x2 __attribute__((ext_vector_type(2)));

constexpr int MT = 16384, DM = 1024, SEQ = 4096;
constexpr int BM = 256, BK = 64, HALF = 128, HTB = HALF * BK * 2, STAGE_BYTES = 8 * HTB, NXCD = 8, WGM = 8;
constexpr int LDS_BYTES = 131072 + 1024;
constexpr float DN_ALPHA = 1.681792830507429f;
constexpr float LN_EPS = 1e-5f;
constexpr float LOG2E = 1.4426950408889634f, LN2 = 0.6931471805599453f;
constexpr size_t MiB = 1024 * 1024;
constexpr size_t OFF_V = 0, OFF_SG = 64 * MiB, OFF_BTA = 128 * MiB, OFF_WOA = 144 * MiB, OFF_WGT = 152 * MiB, OFF_WINU = 156 * MiB;
constexpr size_t OFF_KVT = 192 * MiB, OFF_INB = 204 * MiB, OFF_BAR = 220 * MiB, OFF_HB = 224 * MiB;
constexpr size_t OFF_CNT = OFF_BAR + 16384, OFF_XBUF = OFF_BAR + 32768;
constexpr size_t OFF_OUTB = 193 * MiB;
constexpr size_t OFF_K = 0, OFF_VT = 96 * MiB, OFF_LSE = 192 * MiB;
constexpr size_t WS_NEED = 256 * MiB;

typedef __bf16 bf16x2_t __attribute__((ext_vector_type(2)));
__device__ __forceinline__ unsigned cvt_pk_bf16(float lo, float hi) { const f32x2 v = {lo, hi}; const bf16x2_t b = __builtin_convertvector(v, bf16x2_t); return __builtin_bit_cast(unsigned, b); }
__device__ __forceinline__ float bf_lo(unsigned w) { return __uint_as_float(w << 16); }
__device__ __forceinline__ float bf_hi(unsigned w) { return __uint_as_float(w & 0xffff0000u); }
typedef _Float16 half8 __attribute__((ext_vector_type(8)));
__device__ __forceinline__ unsigned cvt_pk_f16(float lo, float hi) { const _Float16 a = (_Float16)lo, b = (_Float16)hi; return (unsigned)__builtin_bit_cast(unsigned short, a) | ((unsigned)__builtin_bit_cast(unsigned short, b) << 16); }
__device__ __forceinline__ float h_lo(unsigned w) { return (float)__builtin_bit_cast(_Float16, (unsigned short)(w & 0xffffu)); }
__device__ __forceinline__ float h_hi(unsigned w) { return (float)__builtin_bit_cast(_Float16, (unsigned short)(w >> 16)); }
template <bool F16> __device__ __forceinline__ unsigned cvt_pk16(float lo, float hi) { if constexpr (F16) return cvt_pk_f16(lo, hi); else return cvt_pk_bf16(lo, hi); }
__device__ __forceinline__ int opaque(int x) { asm volatile("" : "+v"(x)); return x; }
__device__ __forceinline__ float silu_f(float x) { return x * __builtin_amdgcn_rcpf(1.0f + __builtin_amdgcn_exp2f(-x * LOG2E)); }

__host__ __device__ __forceinline__ int lds_byte(int r, int c) { const int st = (r >> 4) * 2 + (c >> 5), rr = r & 15, cc = c & 31, ob = rr * 64 + cc * 2; return st * 1024 + (ob ^ (((ob >> 9) & 1) << 5)); }
__host__ __device__ __forceinline__ void stage_rc(int b, int& R, int& C) { const int st = b / 1024, sb = b % 1024, swz = sb ^ (((sb >> 9) & 1) << 5); R = (st >> 1) * 16 + swz / 64; C = (st & 1) * 32 + (swz % 64) / 2; }
__host__ __device__ __forceinline__ int perm32(int rho) { const int n = rho >> 4, i = rho & 15; return 8 * (i >> 2) + 4 * n + (i & 3); }

struct Unit { int pm, pn; };
struct Gemm { const bf16_t* A; const bf16_t* Bt; int M, N, K; };

struct StaticOrder {
    int nM, nN, nwg, G, c;
    __device__ void init(int M, int N, int G_, int c_) { nM = M / BM; nN = N / BM; nwg = nM * nN; G = G_; c = c_; }
    __device__ bool next(int i, Unit& u) const {
        const long L = (long)i * G + c; if (L >= nwg) return false;
        int wgid = (int)L; { const int q = nwg / NXCD, r = nwg % NXCD, xcd = wgid % NXCD, off = wgid / NXCD; wgid = (xcd < r ? xcd * (q + 1) : r * (q + 1) + (xcd - r) * q) + off; }
        const int nig = WGM * nN, gid = wgid / nig, fm = gid * WGM, gsz = (nM - fm) < WGM ? (nM - fm) : WGM;
        u.pm = fm + ((wgid % nig) % gsz); u.pn = (wgid % nig) / gsz; return true;
    }
};
struct SingleUnit {
    bool has; Unit u0;
    __device__ bool next(int i, Unit& u) const { if (i == 0 && has) { u = u0; return true; } return false; }
};

template <bool F16 = false> struct EpiStore16 {
    static constexpr bool PERM = true, AFTER_DRAIN = false;
    bf16_t* O; int ldc;
    __device__ __forceinline__ void operator()(const f32x4 (&acc)[2][2][4][2], const Unit& u, int wr, int wc, int fr, int fq) const {
        const int row0 = u.pm * BM + wr * 64 + fr, col0 = u.pn * BM + wc * 32 + 8 * fq;
#pragma unroll
        for (int ai = 0; ai < 2; ++ai)
#pragma unroll
            for (int m = 0; m < 4; ++m) { bf16_t* rowp = O + (size_t)(row0 + ai * HALF + m * 16) * ldc + col0;
#pragma unroll
                for (int bj = 0; bj < 2; ++bj) { const f32x4 v0 = acc[ai][bj][m][0], v1 = acc[ai][bj][m][1];
                    u32x4 w; w.x = cvt_pk16<F16>(v0[0], v0[1]); w.y = cvt_pk16<F16>(v0[2], v0[3]); w.z = cvt_pk16<F16>(v1[0], v1[1]); w.w = cvt_pk16<F16>(v1[2], v1[3]);
                    *(u32x4*)(rowp + bj * HALF) = w; } }
    }
};
struct EpiStoreSplit {
    static constexpr bool PERM = true, AFTER_DRAIN = false;
    bf16_t* O0; bf16_t* O1;
    __device__ __forceinline__ void operator()(const f32x4 (&acc)[2][2][4][2], const Unit& u, int wr, int wc, int fr, int fq) const {
        const int row0 = u.pm * BM + wr * 64 + fr, col0 = (u.pn & 3) * BM + wc * 32 + 8 * fq;
        bf16_t* base = u.pn >= 4 ? O1 : O0;
#pragma unroll
        for (int ai = 0; ai < 2; ++ai)
#pragma unroll
            for (int m = 0; m < 4; ++m) { bf16_t* rowp = base + (size_t)(row0 + ai * HALF + m * 16) * 1024 + col0;
#pragma unroll
                for (int bj = 0; bj < 2; ++bj) { const f32x4 v0 = acc[ai][bj][m][0], v1 = acc[ai][bj][m][1];
                    u32x4 w; w.x = cvt_pk_bf16(v0[0], v0[1]); w.y = cvt_pk_bf16(v0[2], v0[3]); w.z = cvt_pk_bf16(v1[0], v1[1]); w.w = cvt_pk_bf16(v1[2], v1[3]);
                    *(u32x4*)(rowp + bj * HALF) = w; } }
    }
};
struct EpiAG1 {
    static constexpr bool PERM = true, AFTER_DRAIN = false;
    bf16_t* V; bf16_t* SG;
    __device__ __forceinline__ void operator()(const f32x4 (&acc)[2][2][4][2], const Unit& u, int wr, int wc, int fr, int fq) const {
        const bool isg = u.pn >= 8;
        const int row0 = u.pm * BM + wr * 64 + fr, col0 = (isg ? u.pn - 8 : u.pn) * BM + wc * 32 + 8 * fq;
        bf16_t* base = isg ? SG : V;
#pragma unroll
        for (int ai = 0; ai < 2; ++ai)
#pragma unroll
            for (int m = 0; m < 4; ++m) { bf16_t* rowp = base + (size_t)(row0 + ai * HALF + m * 16) * 2048 + col0;
#pragma unroll
                for (int bj = 0; bj < 2; ++bj) { f32x4 v0 = acc[ai][bj][m][0], v1 = acc[ai][bj][m][1];
                    if (isg) {
#pragma unroll
                        for (int j = 0; j < 4; ++j) { v0[j] = silu_f(v0[j]); v1[j] = silu_f(v1[j]); } }
                    u32x4 w; w.x = cvt_pk_bf16(v0[0], v0[1]); w.y = cvt_pk_bf16(v0[2], v0[3]); w.z = cvt_pk_bf16(v1[0], v1[1]); w.w = cvt_pk_bf16(v1[2], v1[3]);
                    *(u32x4*)(rowp + bj * HALF) = w; } }
    }
};
struct EpiGateMul {
    static constexpr bool PERM = true, AFTER_DRAIN = false;
    const bf16_t* Zin; bf16_t* Zout;
    __device__ __forceinline__ void operator()(const f32x4 (&acc)[2][2][4][2], const Unit& u, int wr, int wc, int fr, int fq) const {
        const int row0 = u.pm * BM + wr * 64 + fr, col0 = u.pn * BM + wc * 32 + 8 * fq;
#pragma unroll
        for (int ai = 0; ai < 2; ++ai)
#pragma unroll
            for (int m = 0; m < 4; ++m) { const size_t roff = (size_t)(row0 + ai * HALF + m * 16) * DM + col0; const bf16_t* rowp = Zin + roff; bf16_t* rowo = Zout + roff;
#pragma unroll
                for (int bj = 0; bj < 2; ++bj) { const f32x4 v0 = acc[ai][bj][m][0], v1 = acc[ai][bj][m][1];
                    const u32x4 h = *(const u32x4*)(rowp + bj * HALF);
                    u32x4 w;
                    w.x = cvt_pk_bf16(bf_lo(h.x) * silu_f(v0[0]), bf_hi(h.x) * silu_f(v0[1]));
                    w.y = cvt_pk_bf16(bf_lo(h.y) * silu_f(v0[2]), bf_hi(h.y) * silu_f(v0[3]));
                    w.z = cvt_pk_bf16(bf_lo(h.z) * silu_f(v1[0]), bf_hi(h.z) * silu_f(v1[1]));
                    w.w = cvt_pk_bf16(bf_lo(h.w) * silu_f(v1[2]), bf_hi(h.w) * silu_f(v1[3]));
                    *(u32x4*)(rowo + bj * HALF) = w; } }
    }
};
struct EpiKr {
    static constexpr bool PERM = true, AFTER_DRAIN = false;
    bf16_t* Kr;
    __device__ __forceinline__ void operator()(const f32x4 (&acc)[2][2][4][2], const Unit& u, int wr, int wc, int fr, int fq) const {
        const int row0 = u.pm * BM + wr * 64 + fr, col0 = u.pn * BM + wc * 32 + 8 * fq;
        const int g = u.pn >> 2, dsh = 2 * g;
#pragma unroll
        for (int ai = 0; ai < 2; ++ai)
#pragma unroll
            for (int m = 0; m < 4; ++m) { const int t = row0 + ai * HALF + m * 16, b = t >> 12, s = t & 4095, r = s & ((1 << dsh) - 1), i = s >> dsh;
                const int rowidx = r * (SEQ >> dsh) + i;
#pragma unroll
                for (int bj = 0; bj < 2; ++bj) { const f32x4 v0 = acc[ai][bj][m][0], v1 = acc[ai][bj][m][1];
                    const int col = col0 + bj * HALF, hh = (col >> 6) & 15, d0 = col & 63;
                    u32x4 w; w.x = cvt_pk_bf16(v0[0], v0[1]); w.y = cvt_pk_bf16(v0[2], v0[3]); w.z = cvt_pk_bf16(v1[0], v1[1]); w.w = cvt_pk_bf16(v1[2], v1[3]);
                    *(u32x4*)(Kr + ((size_t)(((g * 16 + hh) * 4 + b) * SEQ + rowidx)) * 64 + d0) = w; } }
    }
};
template <int DSH> struct EpiVt {
    static constexpr bool PERM = true, AFTER_DRAIN = false;
    bf16_t* Vt;
    __device__ __forceinline__ void operator()(const f32x4 (&acc)[2][2][4][2], const Unit& u, int wr, int wc, int fr, int fq) const {
        const int row0 = u.pm * BM + wr * 64 + fr;
        const int t_tile = u.pn * BM, b = t_tile >> 12, s_tile = t_tile & 4095;
#pragma unroll
        for (int ai = 0; ai < 2; ++ai)
#pragma unroll
            for (int m = 0; m < 4; ++m) { bf16_t* rowp = Vt + (size_t)(row0 + ai * HALF + m * 16) * MT + b * SEQ + (s_tile >> DSH);
#pragma unroll
                for (int bj = 0; bj < 2; ++bj) { const f32x4 v0 = acc[ai][bj][m][0], v1 = acc[ai][bj][m][1];
                    const int c = bj * HALF + wc * 32 + 8 * fq, r = c >> (8 - DSH), il = c & ((256 >> DSH) - 1);
                    u32x4 w; w.x = cvt_pk_bf16(v0[0], v0[1]); w.y = cvt_pk_bf16(v0[2], v0[3]); w.z = cvt_pk_bf16(v1[0], v1[1]); w.w = cvt_pk_bf16(v1[2], v1[3]);
                    *(u32x4*)(rowp + r * (SEQ >> DSH) + il) = w; } }
    }
};

template <bool RES_F32, bool OUT_F, bool OUT_B, bool F16 = false> struct EpiLnFused {
    static constexpr bool PERM = false, AFTER_DRAIN = true;
    const float* hin_f; const bf16_t* hin_b;
    float* out_f; bf16_t* out_b;
    const float* gam; const float* bet;
    unsigned long long* xbuf; unsigned* cnt; unsigned want;
    __device__ __forceinline__ void fused(f32x4 (&acc)[2][2][4][2], const Unit& u, int wr, int wc, int fr, int fq, LAS unsigned char* lds, int wid, int lane) const {
        LAS f32x2* P = (LAS f32x2*)lds;
        LAS f32x2* S = (LAS f32x2*)(lds + 8192);
        const int col0 = u.pn * BM + wc * 32 + 4 * fq;
#pragma unroll
        for (int ai = 0; ai < 2; ++ai)
#pragma unroll
            for (int mp = 0; mp < 2; ++mp) {
                f32x4 hb_[2][2][2];
#pragma unroll
                for (int mi = 0; mi < 2; ++mi) { const int m = mp * 2 + mi; const unsigned off = (unsigned)(u.pm * BM + ai * HALF + wr * 64 + m * 16 + fr) * DM + col0;
#pragma unroll
                    for (int bj = 0; bj < 2; ++bj)
#pragma unroll
                        for (int n = 0; n < 2; ++n) {
                            if constexpr (RES_F32) hb_[mi][bj][n] = *(const f32x4*)(hin_f + off + bj * HALF + n * 16);
                            else { const u32x2 w = *(const u32x2*)(hin_b + off + bj * HALF + n * 16); hb_[mi][bj][n] = (f32x4){__uint_as_float(w.x), __uint_as_float(w.y), 0.f, 0.f}; } } }
                asm volatile("" : "+v"(hb_[0][0][0]), "+v"(hb_[0][0][1]), "+v"(hb_[0][1][0]), "+v"(hb_[0][1][1]), "+v"(hb_[1][0][0]), "+v"(hb_[1][0][1]), "+v"(hb_[1][1][0]), "+v"(hb_[1][1][1]));
#pragma unroll
                for (int mi = 0; mi < 2; ++mi) { const int m = mp * 2 + mi;
#pragma unroll
                    for (int bj = 0; bj < 2; ++bj)
#pragma unroll
                        for (int n = 0; n < 2; ++n) { f32x4 h = hb_[mi][bj][n];
                            if constexpr (!RES_F32) { const unsigned wx = __float_as_uint(h[0]), wy = __float_as_uint(h[1]); if constexpr (F16) h = (f32x4){h_lo(wx), h_hi(wx), h_lo(wy), h_hi(wy)}; else h = (f32x4){bf_lo(wx), bf_hi(wx), bf_lo(wy), bf_hi(wy)}; }
                            acc[ai][bj][m][n] = h * DN_ALPHA + acc[ai][bj][m][n]; }
                    asm volatile("" : "+v"(acc[ai][0][m][0]), "+v"(acc[ai][0][m][1]), "+v"(acc[ai][1][m][0]), "+v"(acc[ai][1][m][1])); }
                asm volatile("" ::: "memory"); }
#pragma unroll
        for (int ai = 0; ai < 2; ++ai)
#pragma unroll
            for (int m = 0; m < 4; ++m) {
                float s = 0.f;
#pragma unroll
                for (int bj = 0; bj < 2; ++bj)
#pragma unroll
                    for (int n = 0; n < 2; ++n) { const f32x4 x = acc[ai][bj][m][n]; s += (x[0] + x[1]) + (x[2] + x[3]); }
                s += __shfl_xor(s, 16); s += __shfl_xor(s, 32);
                const float mw = s * (1.0f / 64.0f); float qq = 0.f;
#pragma unroll
                for (int bj = 0; bj < 2; ++bj)
#pragma unroll
                    for (int n = 0; n < 2; ++n) { const f32x4 d = acc[ai][bj][m][n] - mw; qq += (d[0] * d[0] + d[1] * d[1]) + (d[2] * d[2] + d[3] * d[3]); }
                qq += __shfl_xor(qq, 16); qq += __shfl_xor(qq, 32);
                if (fq == 0) P[(ai * HALF + wr * 64 + m * 16 + fr) * 4 + wc] = (f32x2){mw, qq};
            }
        asm volatile("s_waitcnt lgkmcnt(0)" ::: "memory"); __builtin_amdgcn_s_barrier(); asm volatile("" ::: "memory");
        const int row = wid * 32 + (lane & 31);
        if (lane < 32) {
            const f32x2 a = P[row * 4 + 0], b = P[row * 4 + 1], c = P[row * 4 + 2], d = P[row * 4 + 3];
            const float mt = (a.x + b.x + c.x + d.x) * 0.25f;
            const float da = a.x - mt, db = b.x - mt, dc = c.x - mt, dd = d.x - mt;
            const float m2 = (a.y + b.y) + (c.y + d.y) + 64.0f * ((da * da + db * db) + (dc * dc + dd * dd));
            unsigned long long* slot = xbuf + ((size_t)(u.pm * BM + row) * 4 + u.pn);
            __hip_atomic_store(slot, ((unsigned long long)__float_as_uint(m2) << 32) | __float_as_uint(mt), __ATOMIC_RELAXED, __HIP_MEMORY_SCOPE_AGENT);
        }
        asm volatile("s_waitcnt vmcnt(0)" ::: "memory");
        if (lane == 0) __hip_atomic_fetch_add(cnt + 64 * u.pm, 1u, __ATOMIC_RELAXED, __HIP_MEMORY_SCOPE_AGENT);
        if (wid == 0) {
            unsigned sp = 0;
            while ((unsigned)__builtin_amdgcn_readfirstlane(__hip_atomic_load(cnt + 64 * u.pm, __ATOMIC_RELAXED, __HIP_MEMORY_SCOPE_AGENT)) < want) { __builtin_amdgcn_s_sleep(2); if (++sp > (1u << 22)) break; }
            __builtin_amdgcn_fence(__ATOMIC_ACQUIRE, "agent");
        }
        asm volatile("s_waitcnt vmcnt(0) lgkmcnt(0)" ::: "memory"); __builtin_amdgcn_s_barrier(); asm volatile("" ::: "memory");
        if (lane < 32) {
            const unsigned long long* slot = xbuf + (size_t)(u.pm * BM + row) * 4; float mt[4], m2[4]; float ms = 0.f;
#pragma unroll
            for (int t = 0; t < 4; ++t) { const unsigned long long w = __hip_atomic_load(slot + t, __ATOMIC_RELAXED, __HIP_MEMORY_SCOPE_AGENT); mt[t] = __uint_as_float((unsigned)w); m2[t] = __uint_as_float((unsigned)(w >> 32)); ms += mt[t]; }
            const float mean = ms * 0.25f; float qq = 0.f;
#pragma unroll
            for (int t = 0; t < 4; ++t) { const float dm = mt[t] - mean; qq += m2[t] + 256.0f * dm * dm; }
            S[row] = (f32x2){mean, 1.0f / sqrtf(qq * (1.0f / 1024.0f) + LN_EPS)};
        }
        asm volatile("s_waitcnt lgkmcnt(0)" ::: "memory"); __builtin_amdgcn_s_barrier(); asm volatile("" ::: "memory");
        f32x2 sr[2][4];
#pragma unroll
        for (int ai = 0; ai < 2; ++ai)
#pragma unroll
            for (int m = 0; m < 4; ++m) sr[ai][m] = S[ai * HALF + wr * 64 + m * 16 + fr];
#pragma unroll
        for (int bj = 0; bj < 2; ++bj)
#pragma unroll
            for (int n = 0; n < 2; ++n) { const f32x4 gv = *(const f32x4*)(gam + col0 + bj * HALF + n * 16), bv = *(const f32x4*)(bet + col0 + bj * HALF + n * 16);
#pragma unroll
                for (int ai = 0; ai < 2; ++ai)
#pragma unroll
                    for (int m = 0; m < 4; ++m) { const int r = ai * HALF + wr * 64 + m * 16 + fr; const unsigned off = (unsigned)(u.pm * BM + r) * DM + col0 + bj * HALF + n * 16;
                        const f32x4 o = (acc[ai][bj][m][n] - sr[ai][m].x) * sr[ai][m].y * gv + bv;
                        if constexpr (OUT_F) *(f32x4*)(out_f + off) = o;
                        if constexpr (OUT_B) { u32x2 w; w.x = cvt_pk16<F16>(o[0], o[1]); w.y = cvt_pk16<F16>(o[2], o[3]); *(u32x2*)(out_b + off) = w; } } }
    }
};

template <class Epi, class Sched, int DSH = 0, bool F16 = false, bool SP2 = true, bool ALIGN_EPI = true>
__device__ __forceinline__ void gemm_phase(LAS unsigned char* lds, const Gemm g, const Sched& S, const Epi& E) {
    const int tid = opaque(threadIdx.x), wid = __builtin_amdgcn_readfirstlane(tid >> 6), lane = tid & 63, wr = wid >> 2, wc = wid & 3, fr = lane & 15, fq = lane >> 4;
    const int K = g.K, nt = K / BK;
    unsigned voffA[2], voffB[2], voffB1[2];
#pragma unroll
    for (int i = 0; i < 2; ++i) { int R, C; stage_rc(tid * 16 + i * 8192, R, C); const int Rb = Epi::PERM ? ((R & ~31) + perm32(R & 31)) : R;
        voffA[i] = (unsigned)(R * K + C) * 2u;
        if constexpr (DSH == 0) { voffB[i] = (unsigned)(Rb * K + C) * 2u; voffB1[i] = (unsigned)((Rb + HALF) * K + C) * 2u; }
        else { const int c0_ = Rb, c1_ = Rb + HALF; const int t0_ = ((c0_ & ((256 >> DSH) - 1)) << DSH) + (c0_ >> (8 - DSH)), t1_ = ((c1_ & ((256 >> DSH) - 1)) << DSH) + (c1_ >> (8 - DSH));
            voffB[i] = (unsigned)(t0_ * K + C) * 2u; voffB1[i] = (unsigned)(t1_ * K + C) * 2u; } }
    const size_t kstep = (size_t)(BK * 2);
    const size_t hstep = (size_t)HALF * K * 2;
    const size_t tstep = 2 * hstep;
    const unsigned ldsw = (unsigned)wid * 1024u;
    const int aoff = lds_byte(wr * 64 + fr, fq * 8), boff = lds_byte(wc * 32 + fr, fq * 8);
#define PG8_SA(b, h) (((b) * 2 + (h)) * HTB)
#define PG8_SB(b, h) ((4 + (b) * 2 + (h)) * HTB)
#define PG8_STAGE(bufoff, gbase, voff) do { _Pragma("unroll") for (int _i = 0; _i < 2; ++_i) \
        __builtin_amdgcn_global_load_lds((const unsigned*)((const char*)(gbase) + (voff)[_i]), (LAS unsigned*)(lds + (bufoff) + ldsw + _i * 8192), 16, 0, 0); } while (0)
#define PG8_LDA(dst, b, h) do { _Pragma("unroll") for (int m = 0; m < 4; ++m) _Pragma("unroll") for (int k = 0; k < 2; ++k) dst[m][k] = *(const LAS bf16x8*)(lds + PG8_SA(b, h) + aoff + m * 2048 + k * 1024); } while (0)
#define PG8_LDB(dst, b, h) do { _Pragma("unroll") for (int n = 0; n < 2; ++n) _Pragma("unroll") for (int k = 0; k < 2; ++k) dst[n][k] = *(const LAS bf16x8*)(lds + PG8_SB(b, h) + boff + n * 2048 + k * 1024); } while (0)
#define PG8_MMA(ai, bj, At, Bt) do { __builtin_amdgcn_s_setprio(1); _Pragma("unroll") for (int m = 0; m < 4; ++m) _Pragma("unroll") for (int n = 0; n < 2; ++n) _Pragma("unroll") for (int k = 0; k < 2; ++k) \
        acc[ai][bj][m][n] = F16 ? __builtin_amdgcn_mfma_f32_16x16x32_f16(__builtin_bit_cast(half8, Bt[n][k]), __builtin_bit_cast(half8, At[m][k]), acc[ai][bj][m][n], 0, 0, 0) : __builtin_amdgcn_mfma_f32_16x16x32_bf16(Bt[n][k], At[m][k], acc[ai][bj][m][n], 0, 0, 0); __builtin_amdgcn_s_setprio(0); } while (0)
#define PG8_WAIT_V(n) asm volatile("s_waitcnt vmcnt(" #n ")" ::: "memory")
#define PG8_WAIT_L(n) asm volatile("s_waitcnt lgkmcnt(" #n ")" ::: "memory")
#define PG8_BAR __builtin_amdgcn_s_barrier()
#define PG8_SCHED __builtin_amdgcn_sched_barrier(0)
    Unit cur, nxt; int ui = 0;
    if (!S.next(0, cur)) return;
    f32x4 acc[2][2][4][2];
#pragma unroll
    for (int a = 0; a < 2; ++a)
#pragma unroll
        for (int b = 0; b < 2; ++b)
#pragma unroll
            for (int m = 0; m < 4; ++m)
#pragma unroll
                for (int n = 0; n < 2; ++n) acc[a][b][m][n] = (f32x4){0.f, 0.f, 0.f, 0.f};
    bf16x8 At[4][2], B0[2][2], B1[2][2];
    const char* cA = (const char*)g.A + (size_t)cur.pm * tstep; const char* cB = (const char*)g.Bt + (size_t)cur.pn * tstep;
    if constexpr (SP2) {
        PG8_STAGE(PG8_SB(0, 0), cB, voffB); PG8_STAGE(PG8_SB(0, 1), cB, voffB1); PG8_STAGE(PG8_SA(0, 0), cA, voffA); PG8_STAGE(PG8_SA(0, 1), cA + hstep, voffA);
        if (wr == 1) PG8_BAR;
        PG8_WAIT_V(2); PG8_BAR;
        PG8_STAGE(PG8_SB(1, 0), cB + kstep, voffB); PG8_STAGE(PG8_SA(1, 0), cA + kstep, voffA); PG8_STAGE(PG8_SB(1, 1), cB + kstep, voffB1);
        PG8_WAIT_V(6); PG8_BAR;
    } else {
    PG8_STAGE(PG8_SB(0, 0), cB, voffB); PG8_STAGE(PG8_SA(0, 0), cA, voffA); PG8_STAGE(PG8_SB(0, 1), cB, voffB1); PG8_STAGE(PG8_SA(0, 1), cA + hstep, voffA);
    if (wr == 1) PG8_BAR;
    PG8_WAIT_V(4); PG8_BAR;
    PG8_STAGE(PG8_SB(1, 0), cB + kstep, voffB); PG8_STAGE(PG8_SA(1, 0), cA + kstep, voffA); PG8_STAGE(PG8_SB(1, 1), cB + kstep, voffB1);
    PG8_WAIT_V(6); PG8_BAR;
    }
    for (;;) {
        const bool has_next = S.next(ui + 1, nxt);
        const char* nA = has_next ? (const char*)g.A + (size_t)nxt.pm * tstep : cA; const char* nB = has_next ? (const char*)g.Bt + (size_t)nxt.pn * tstep : cB;
        for (int t = 0; t < nt; t += 2) {
            const bool last = (t == nt - 2);
            const char* a1 = cA + (size_t)(t + 1) * kstep;
            const char* a2 = last ? nA : cA + (size_t)(t + 2) * kstep; const char* b2 = last ? nB : cB + (size_t)(t + 2) * kstep;
            const char* a3 = a2 + kstep; const char* b3 = b2 + kstep;
            if constexpr (SP2) {
            PG8_LDB(B0, 0, 0); PG8_LDB(B1, 0, 1); PG8_SCHED; PG8_LDA(At, 0, 0); PG8_STAGE(PG8_SA(1, 1), a1 + hstep, voffA);
            PG8_WAIT_V(8); PG8_WAIT_L(0); PG8_BAR; PG8_MMA(0, 0, At, B0); PG8_MMA(0, 1, At, B1); PG8_BAR; PG8_SCHED;
            PG8_LDA(At, 0, 1); PG8_STAGE(PG8_SB(0, 0), b2, voffB); PG8_STAGE(PG8_SB(0, 1), b2, voffB1); PG8_STAGE(PG8_SA(0, 0), a2, voffA);
            PG8_WAIT_V(8); PG8_WAIT_L(0); PG8_BAR; PG8_MMA(1, 0, At, B0); PG8_MMA(1, 1, At, B1); PG8_BAR; PG8_SCHED;
            PG8_LDB(B0, 1, 0); PG8_LDB(B1, 1, 1); PG8_SCHED; PG8_LDA(At, 1, 0); PG8_STAGE(PG8_SA(0, 1), a2 + hstep, voffA);
            PG8_WAIT_V(8); PG8_WAIT_L(0); PG8_BAR; PG8_MMA(0, 0, At, B0); PG8_MMA(0, 1, At, B1); PG8_BAR; PG8_SCHED;
            PG8_LDA(At, 1, 1); PG8_STAGE(PG8_SB(1, 0), b3, voffB); PG8_STAGE(PG8_SB(1, 1), b3, voffB1); PG8_STAGE(PG8_SA(1, 0), a3, voffA);
            PG8_WAIT_V(8); PG8_WAIT_L(0); PG8_BAR; PG8_MMA(1, 0, At, B0); PG8_MMA(1, 1, At, B1); PG8_BAR; PG8_SCHED;
            } else {
            PG8_LDB(B0, 0, 0); PG8_SCHED; PG8_LDA(At, 0, 0); PG8_STAGE(PG8_SA(1, 1), a1 + hstep, voffA);
            PG8_WAIT_L(8); PG8_BAR; PG8_WAIT_L(0); PG8_MMA(0, 0, At, B0); PG8_BAR; PG8_SCHED;
            PG8_LDB(B1, 0, 1); PG8_STAGE(PG8_SB(0, 0), b2, voffB);
            PG8_BAR; PG8_WAIT_L(0); PG8_MMA(0, 1, At, B1); PG8_BAR;
            PG8_LDA(At, 0, 1); PG8_STAGE(PG8_SA(0, 0), a2, voffA);
            PG8_BAR; PG8_WAIT_L(0); PG8_MMA(1, 0, At, B0); PG8_BAR; PG8_SCHED;
            PG8_STAGE(PG8_SB(0, 1), b2, voffB1);
            PG8_WAIT_V(6); PG8_BAR; PG8_MMA(1, 1, At, B1); PG8_BAR;
            PG8_LDB(B0, 1, 0); PG8_SCHED; PG8_LDA(At, 1, 0); PG8_STAGE(PG8_SA(0, 1), a2 + hstep, voffA);
            PG8_WAIT_L(8); PG8_BAR; PG8_WAIT_L(0); PG8_MMA(0, 0, At, B0); PG8_BAR; PG8_SCHED;
            PG8_LDB(B1, 1, 1); PG8_STAGE(PG8_SB(1, 0), b3, voffB);
            PG8_BAR; PG8_WAIT_L(0); PG8_MMA(0, 1, At, B1); PG8_BAR;
            PG8_LDA(At, 1, 1); PG8_STAGE(PG8_SA(1, 0), a3, voffA);
            PG8_BAR; PG8_WAIT_L(0); PG8_MMA(1, 0, At, B0); PG8_BAR; PG8_SCHED;
            PG8_STAGE(PG8_SB(1, 1), b3, voffB1);
            PG8_WAIT_V(6); PG8_BAR; PG8_MMA(1, 1, At, B1); PG8_BAR;
            }
        }
        if constexpr (ALIGN_EPI) { if (wr == 0) PG8_BAR; }
        if constexpr (!Epi::AFTER_DRAIN) E(acc, cur, wr, wc, fr, fq);
        if (!has_next) break;
#pragma unroll
        for (int a = 0; a < 2; ++a)
#pragma unroll
            for (int b = 0; b < 2; ++b)
#pragma unroll
                for (int m = 0; m < 4; ++m)
#pragma unroll
                    for (int n = 0; n < 2; ++n) acc[a][b][m][n] = (f32x4){0.f, 0.f, 0.f, 0.f};
        cur = nxt; cA = nA; cB = nB; ++ui;
        if constexpr (ALIGN_EPI) { if (wr == 1) PG8_BAR; }
    }
    PG8_WAIT_V(0);
    if constexpr (!ALIGN_EPI) { if (wr == 0) PG8_BAR; }
    PG8_BAR;
    if constexpr (Epi::AFTER_DRAIN) E.fused(acc, cur, wr, wc, fr, fq, lds, wid, lane);
#undef PG8_SA
#undef PG8_SB
#undef PG8_STAGE
#undef PG8_LDA
#undef PG8_LDB
#undef PG8_MMA
#undef PG8_WAIT_V
#undef PG8_WAIT_L
#undef PG8_BAR
#undef PG8_SCHED
}


#define XB_TMO      128
#define XB_XCNT(j)  (256  + 64 * (j))
#define XB_XSUB(j)  (1280 + 64 * (j))
#define XB_XGEN(j)  (2304 + 64 * (j))
#define XB_TOP      3328
#define XB_TOPGEN   3392
#define XCD_BAR_WORDS 3456
#define XB_SPIN_CAP (1u << 18)
__device__ __forceinline__ unsigned xb_ld(unsigned* p)              { return __hip_atomic_load(p, __ATOMIC_RELAXED, __HIP_MEMORY_SCOPE_AGENT); }
__device__ __forceinline__ unsigned xb_add(unsigned* p, unsigned v) { return __hip_atomic_fetch_add(p, v, __ATOMIC_RELAXED, __HIP_MEMORY_SCOPE_AGENT); }
__device__ __forceinline__ unsigned xb_xcc_id() { return (unsigned)__builtin_amdgcn_s_getreg((3 << 11) | 20) & 0xFu; }
#define XB_SPIN(cond, bar) do { unsigned _sp = 0; while (cond) { __builtin_amdgcn_s_sleep(1); \
    if ((++_sp & 255u) == 0u) { if (xb_ld(&(bar)[XB_TMO])) break; if (_sp > XB_SPIN_CAP) { atomicAdd(&(bar)[XB_TMO], 1u); break; } } } } while (0)
struct XcdBarrier { unsigned* bar; unsigned x; volatile LAS unsigned* st; };
__device__ __forceinline__ XcdBarrier xcd_barrier_post(unsigned* bar, volatile LAS unsigned* st) {
    XcdBarrier b; b.bar = bar; b.x = xb_xcc_id(); b.st = st;
    if (threadIdx.x == 0) (void)xb_add(&bar[XB_XCNT(b.x)], 1u);
    return b;
}
__device__ __forceinline__ void xcd_barrier_complete(unsigned* bar, unsigned x, unsigned& nloc, unsigned& nx) {
    const unsigned G = gridDim.x * gridDim.y * gridDim.z;
    unsigned sum, cnt, mine, sp = 0u;
    for (;;) {
        sum = 0u; cnt = 0u; mine = 0u;
#pragma unroll
        for (unsigned j = 0; j < 16; ++j) { const unsigned c = xb_ld(&bar[XB_XCNT(j)]); sum += c; cnt += (c > 0u) ? 1u : 0u; mine = (j == x) ? c : mine; }
        if (sum == G) break;
        __builtin_amdgcn_s_sleep(1);
        if ((++sp & 255u) == 0u) { if (xb_ld(&bar[XB_TMO])) break; if (sp > XB_SPIN_CAP) { atomicAdd(&bar[XB_TMO], 1u); break; } }
    }
    nloc = mine > 0u ? mine : 1u; nx = cnt > 0u ? cnt : 1u;
}
__device__ __forceinline__ void xcd_barrier(const XcdBarrier& b) {
    asm volatile("s_waitcnt vmcnt(0)" ::: "memory");
    __syncthreads();
    if (threadIdx.x == 0) {
        unsigned* bar = b.bar;
        const unsigned bx = xb_xcc_id();
        __builtin_amdgcn_s_waitcnt(0);
        unsigned nloc = b.st[0], nx = b.st[1];
        if (nloc == 0u) { xcd_barrier_complete(bar, bx, nloc, nx); b.st[0] = nloc; b.st[1] = nx; }
        const unsigned old = xb_add(&bar[XB_XSUB(bx)], 1u);
        const unsigned gen = old / nloc;
        if (old + 1u == (gen + 1u) * nloc) {
            __builtin_amdgcn_fence(__ATOMIC_RELEASE, "agent");
            asm volatile("s_waitcnt vmcnt(0)" ::: "memory");
            const unsigned og = xb_add(&bar[XB_TOP], 1u);
            const unsigned tg = og / nx;
            if (og + 1u == (tg + 1u) * nx) xb_add(&bar[XB_TOPGEN], 1u);
            else XB_SPIN(xb_ld(&bar[XB_TOPGEN]) == tg, bar);
            __builtin_amdgcn_fence(__ATOMIC_ACQUIRE, "agent");
            xb_add(&bar[XB_XGEN(bx)], 1u);
            asm volatile("s_waitcnt vmcnt(0)" ::: "memory");
        } else {
            XB_SPIN(xb_ld(&bar[XB_XGEN(bx)]) == gen, bar);
            __builtin_amdgcn_fence(__ATOMIC_ACQUIRE, "agent");
            asm volatile("s_waitcnt vmcnt(0)" ::: "memory");
        }
    }
    __syncthreads();
}

template <bool F16 = false>
__device__ __forceinline__ void tp_job(const float* src, size_t smat, int lsrc, int coff, bf16_t* dst, size_t dmat, int ldd, int R, int C, int nmat, LAS float* scr) {
    const int tid = opaque(threadIdx.x);
    const int ntc = C / 64, per = (R / 64) * ntc, total = per * nmat;
    const int G = gridDim.x;
    f32x4 v[2];
    int t = blockIdx.x;
#define TP_LOAD(tt_) do { const int i_ = (tt_) / per, t2_ = (tt_) % per, tr_ = t2_ / ntc, tc_ = t2_ % ntc; const float* s_ = src + (size_t)i_ * smat + coff; \
        _Pragma("unroll") for (int k_ = 0; k_ < 2; ++k_) { const int idx_ = tid + 512 * k_, row_ = idx_ >> 4, c4_ = idx_ & 15; v[k_] = *(const f32x4*)(s_ + (size_t)(tr_ * 64 + row_) * lsrc + tc_ * 64 + c4_ * 4); } } while (0)
    if (t < total) TP_LOAD(t);
#pragma unroll 1
    for (; t < total; t += G) {
#pragma unroll
        for (int k = 0; k < 2; ++k) { const int idx = tid + 512 * k, row = idx >> 4, c4 = idx & 15; LAS float* pp = scr + row * 65 + c4 * 4; pp[0] = v[k][0]; pp[1] = v[k][1]; pp[2] = v[k][2]; pp[3] = v[k][3]; }
        if (t + G < total) TP_LOAD(t + G);
        __syncthreads();
        { const int i = t / per, t2 = t % per, tr = t2 / ntc, tc = t2 % ntc; bf16_t* d = dst + (size_t)i * dmat;
          const int c = tid >> 3, ch = tid & 7; const LAS float* sp = scr + (ch * 8) * 65 + c;
          u32x4 o; o.x = cvt_pk16<F16>(sp[0], sp[65]); o.y = cvt_pk16<F16>(sp[2 * 65], sp[3 * 65]); o.z = cvt_pk16<F16>(sp[4 * 65], sp[5 * 65]); o.w = cvt_pk16<F16>(sp[6 * 65], sp[7 * 65]);
          *(u32x4*)(d + (size_t)(tc * 64 + c) * ldd + tr * 64 + ch * 8) = o; }
        __syncthreads();
    }
#undef TP_LOAD
}

struct Params {
    const float *x, *w_in_a, *w_grp_a, *scale_a, *w_out_a, *w_kv, *w_in_b, *w_out_b, *ln_g, *ln_b;
    float* out; unsigned char* ws;
};

__device__ __forceinline__ void phase_prep(const Params& p, LAS unsigned char* lds) {
    LAS float* scr = (LAS float*)lds;
    unsigned char* ws = p.ws;
    tp_job<true>(p.w_in_a, (size_t)1024 * 4096, 4096, 2048, (bf16_t*)(ws + OFF_BTA) + (size_t)2048 * 1024, (size_t)4096 * 1024, 1024, 1024, 2048, 2, scr);
    tp_job(p.w_out_a, (size_t)2048 * 1024, 1024, 0, (bf16_t*)(ws + OFF_WOA), (size_t)1024 * 2048, 2048, 2048, 1024, 2, scr);
    tp_job<true>(p.w_kv, 0, 6144, 0, (bf16_t*)(ws + OFF_KVT), 0, 1024, 1024, 6144, 1, scr);
    tp_job<true>(p.w_in_b, (size_t)1024 * 4096, 4096, 0, (bf16_t*)(ws + OFF_INB), (size_t)4096 * 1024, 1024, 1024, 4096, 2, scr);
    tp_job<true>(p.w_grp_a, (size_t)512 * 512, 512, 0, (bf16_t*)(ws + OFF_WGT), (size_t)512 * 512, 512, 512, 512, 8, scr);
    { bf16_t* winu = (bf16_t*)(ws + OFF_WINU);
      const int total = 2 * 4 * 1024 * 64;
      const int tid = opaque(threadIdx.x);
#pragma unroll 1
      for (int i0 = blockIdx.x * 512 + tid; i0 < total; i0 += gridDim.x * 512 * 4) {
          f32x4 a[4], b[4];
#pragma unroll
          for (int u = 0; u < 4; ++u) { const int i = i0 + u * gridDim.x * 512; if (i < total) { const int c8 = i & 63, k = (i >> 6) & 1023, lg = i >> 16, l = lg >> 2, g = lg & 3;
              const float* s = p.w_in_a + ((size_t)l * 1024 + k) * 4096 + g * 512 + c8 * 8; a[u] = *(const f32x4*)s; b[u] = *(const f32x4*)(s + 4); } }
#pragma unroll
          for (int u = 0; u < 4; ++u) { const int i = i0 + u * gridDim.x * 512; if (i < total) {
              u32x4 o; o.x = cvt_pk_f16(a[u][0], a[u][1]); o.y = cvt_pk_f16(a[u][2], a[u][3]); o.z = cvt_pk_f16(b[u][0], b[u][1]); o.w = cvt_pk_f16(b[u][2], b[u][3]);
              *(u32x4*)(winu + (size_t)i * 8) = o; } } } }
    { bf16_t* hb = (bf16_t*)(ws + OFF_HB);
      const int total = MT * DM / 8;
      const int tid = opaque(threadIdx.x);
#pragma unroll 1
      for (int i0 = blockIdx.x * 512 + tid; i0 < total; i0 += gridDim.x * 512 * 4) {
          f32x4 a[4], b[4];
#pragma unroll
          for (int u = 0; u < 4; ++u) { const int i = i0 + u * gridDim.x * 512; if (i < total) { const float* s = p.x + (size_t)i * 8; a[u] = *(const f32x4*)s; b[u] = *(const f32x4*)(s + 4); } }
#pragma unroll
          for (int u = 0; u < 4; ++u) { const int i = i0 + u * gridDim.x * 512; if (i < total) {
              u32x4 o; o.x = cvt_pk_f16(a[u][0], a[u][1]); o.y = cvt_pk_f16(a[u][2], a[u][3]); o.z = cvt_pk_f16(b[u][0], b[u][1]); o.w = cvt_pk_f16(b[u][2], b[u][3]);
              *(u32x4*)(hb + (size_t)i * 8) = o; } } } }
}

__device__ __forceinline__ void unpack8(const u32x4 w, float (&f)[8]) { f[0] = bf_lo(w.x); f[1] = bf_hi(w.x); f[2] = bf_lo(w.y); f[3] = bf_hi(w.y); f[4] = bf_lo(w.z); f[5] = bf_hi(w.z); f[6] = bf_lo(w.w); f[7] = bf_hi(w.w); }
template <int W>
__device__ __forceinline__ void pool_item(const bf16_t* V, bf16_t* SG, const float (&sc)[8], int t0, int c0) {
    const int s0 = t0 & (SEQ - 1);
    u32x4 rows[W + 3], gts[4];
#pragma unroll
    for (int j = 0; j < W + 3; ++j) { const int dt = j - (W - 1); rows[j] = (u32x4){0u, 0u, 0u, 0u}; if (s0 + dt >= 0) rows[j] = *(const u32x4*)(V + (size_t)(t0 + dt) * 2048 + c0); }
#pragma unroll
    for (int i = 0; i < 4; ++i) gts[i] = *(const u32x4*)(SG + (size_t)(t0 + i) * 2048 + c0);
    float sum[8];
#pragma unroll
    for (int j = 0; j < 8; ++j) sum[j] = 0.f;
#pragma unroll
    for (int j = 0; j < W - 1; ++j) { float f[8]; unpack8(rows[j], f);
#pragma unroll
        for (int k = 0; k < 8; ++k) sum[k] += f[k]; }
#pragma unroll
    for (int i = 0; i < 4; ++i) {
        float f[8], gt[8]; unpack8(rows[W - 1 + i], f); unpack8(gts[i], gt);
#pragma unroll
        for (int k = 0; k < 8; ++k) sum[k] += f[k];
        const int s = s0 + i; const float inv = 1.0f / (float)(s + 1 < W ? s + 1 : W);
        float o[8];
#pragma unroll
        for (int k = 0; k < 8; ++k) o[k] = (sum[k] * inv - f[k]) * sc[k] * gt[k];
        u32x4 wv; wv.x = cvt_pk_bf16(o[0], o[1]); wv.y = cvt_pk_bf16(o[2], o[3]); wv.z = cvt_pk_bf16(o[4], o[5]); wv.w = cvt_pk_bf16(o[6], o[7]);
        *(u32x4*)(SG + (size_t)(t0 + i) * 2048 + c0) = wv;
        float fo[8]; unpack8(rows[i], fo);
#pragma unroll
        for (int k = 0; k < 8; ++k) sum[k] -= fo[k];
    }
}
__device__ __forceinline__ void phase_pool(const bf16_t* V, bf16_t* SG, const float* scale) {
    const int tid = opaque(threadIdx.x), cth = tid & 255, sub = tid >> 8;
    const int c0 = cth * 8, grp = c0 >> 9;
    float sc[8];
    { const f32x4 a = *(const f32x4*)(scale + c0), b = *(const f32x4*)(scale + c0 + 4); sc[0] = a[0]; sc[1] = a[1]; sc[2] = a[2]; sc[3] = a[3]; sc[4] = b[0]; sc[5] = b[1]; sc[6] = b[2]; sc[7] = b[3]; }
    const int qper = (MT / 4) / (int)gridDim.x;
#pragma unroll 1
    for (int qi = sub; qi < qper; qi += 2) {
        const int q = blockIdx.x * qper + qi;
        const int t0 = q * 4;
        if (grp == 0) pool_item<2>(V, SG, sc, t0, c0);
        else if (grp == 1) pool_item<4>(V, SG, sc, t0, c0);
        else if (grp == 2) pool_item<8>(V, SG, sc, t0, c0);
        else pool_item<16>(V, SG, sc, t0, c0);
    }
}

template <int V_> struct AttIC { static constexpr int value = V_; };
struct AttGeo { int dsh, dil, L, nblk, g; };
__device__ __forceinline__ void att_decode(const AttGeo& G_, int it, int& hh, int& b, int& r, int& n) { n = it & (G_.nblk - 1); const int y = it >> (5 - G_.dsh); r = y & (G_.dil - 1); const int z = y >> G_.dsh; b = z & 3; hh = z >> 2; }
__device__ __forceinline__ void att_dma_half(const AttGeo& G_, const bf16_t* Kr, const bf16_t* Vt, int it, int which, int slot, LAS unsigned char* lds, int wid, int lane0) {
    int hh, b, r, n; att_decode(G_, it, hh, b, r, n);
    const int lane = opaque(lane0);
    int blk = n - 1 + which; blk = blk < 0 ? 0 : blk;
    const bf16_t* kb = Kr + ((size_t)(((G_.g * 16 + hh) * 4 + b) * SEQ + r * G_.L + blk * 128)) * 64;
    const bf16_t* vb = Vt + (size_t)(G_.g * 1024 + hh * 64) * MT + b * SEQ + r * G_.L + blk * 128;
    LAS unsigned char* kl = lds + slot * 32768; LAS unsigned char* vl = kl + 16384;
#pragma unroll
    for (int rd = 0; rd < 2; ++rd) { const int ch = rd * 8 + wid; const int rho = ch * 8 + (lane >> 3); const int cs = (lane & 7) ^ ((rho >> 1) & 7);
        __builtin_amdgcn_global_load_lds((const unsigned*)(kb + (size_t)rho * 64 + cs * 8), (LAS unsigned*)(kl + ch * 1024), 16, 0, 0); }
#pragma unroll
    for (int rd = 0; rd < 2; ++rd) { const int ch = rd * 8 + wid; const int d = ch * 4 + (lane >> 4); const int cs = (lane & 15) ^ (d & 15);
        __builtin_amdgcn_global_load_lds((const unsigned*)(vb + (size_t)d * MT + cs * 8), (LAS unsigned*)(vl + ch * 1024), 16, 0, 0); }
}
__device__ __forceinline__ int att_first_item() { return ((blockIdx.x & 7) * 32 + (blockIdx.x >> 3)) * 8; }
__device__ __forceinline__ void attn_issue_first(const bf16_t* Kr, const bf16_t* Vt, int g, LAS unsigned char* lds) {
    const int tid = opaque(threadIdx.x), wid = __builtin_amdgcn_readfirstlane(tid >> 6), lane0 = tid & 63;
    AttGeo G_; G_.g = g; G_.dsh = 2 * g; G_.dil = 1 << G_.dsh; G_.L = SEQ >> G_.dsh; G_.nblk = G_.L >> 7;
    const int it = att_first_item();
    att_dma_half(G_, Kr, Vt, it, 0, 3, lds, wid, lane0);
    att_dma_half(G_, Kr, Vt, it, 1, 0, lds, wid, lane0);
}
template <bool PRE>
__device__ __forceinline__ void phase_attn(const bf16_t* Q, const bf16_t* Kr, const bf16_t* Vt, bf16_t* ACC, float* LSE, int g, LAS unsigned char* lds) {
    const int tid = opaque(threadIdx.x), wid = __builtin_amdgcn_readfirstlane(tid >> 6), lane0 = tid & 63, q0 = lane0 & 15, q40 = lane0 >> 4;
    AttGeo G_; G_.g = g; G_.dsh = 2 * g; G_.dil = 1 << G_.dsh; G_.L = SEQ >> G_.dsh; G_.nblk = G_.L >> 7;
    const int dsh = G_.dsh, dil = G_.dil;
    const int it0 = att_first_item();
    bf16x8 qf[2]; u32x2 oldacc[4]; float oldlse = 0.f; int tq = 0, hh = 0, n = 0;
    {
        if constexpr (!PRE) { att_dma_half(G_, Kr, Vt, it0, 0, 3, lds, wid, lane0); att_dma_half(G_, Kr, Vt, it0, 1, 0, lds, wid, lane0); }
        int b, r; att_decode(G_, it0, hh, b, r, n);
        tq = b * SEQ + ((n * 128 + wid * 16 + q0) << dsh) + r;
#pragma unroll
        for (int ks = 0; ks < 2; ++ks) qf[ks] = *(const bf16x8*)(Q + (size_t)tq * 1024 + hh * 64 + ks * 32 + q40 * 8);
        if (g > 0) { oldlse = LSE[(size_t)hh * MT + tq];
#pragma unroll
            for (int dt = 0; dt < 4; ++dt) oldacc[dt] = *(const u32x2*)(ACC + (size_t)tq * 1024 + hh * 64 + q40 * 4 + dt * 16); }
    }
    u32x2 pend[4]; float pend_lse = 0.f; int pend_tq = 0, pend_hh = 0; bool have_pend = false;
    auto item_body = [&](auto kkc, int k) __attribute__((always_inline)) {
        constexpr int KK = decltype(kkc)::value;
        constexpr int SC = KK, SP = (KK + 3) & 3, SN = (KK + 1) & 3;
        asm volatile("s_waitcnt vmcnt(0)" ::: "memory");
        __builtin_amdgcn_s_barrier();
        asm volatile("" ::: "memory");
        asm volatile("" : "+v"(qf[0]), "+v"(qf[1]), "+v"(oldacc[0]), "+v"(oldacc[1]), "+v"(oldacc[2]), "+v"(oldacc[3]), "+v"(oldlse));
        if (have_pend) {
            bf16_t* pp = ACC + (size_t)pend_tq * 1024 + pend_hh * 64 + q40 * 4;
#pragma unroll
            for (int dt = 0; dt < 4; ++dt) *(u32x2*)(pp + dt * 16) = pend[dt];
            if (q40 == 0) LSE[(size_t)pend_hh * MT + pend_tq] = pend_lse;
        }
        const int q = opaque(q0), q4 = opaque(q40);
        bf16x8 qn[2]; u32x2 oldn[4]; float oldlsen = 0.f; int tqn = 0, hhn = 0, nn = 0;
        if (k + 1 < 8) {
            const int itn = it0 + k + 1;
            att_dma_half(G_, Kr, Vt, itn, 1, SN, lds, wid, lane0);
            int b, r; att_decode(G_, itn, hhn, b, r, nn);
            tqn = b * SEQ + ((nn * 128 + wid * 16 + q) << dsh) + r;
#pragma unroll
            for (int ks = 0; ks < 2; ++ks) qn[ks] = *(const bf16x8*)(Q + (size_t)tqn * 1024 + hhn * 64 + ks * 32 + q4 * 8);
            if (g > 0) { oldlsen = LSE[(size_t)hhn * MT + tqn];
#pragma unroll
                for (int dt = 0; dt < 4; ++dt) oldn[dt] = *(const u32x2*)(ACC + (size_t)tqn * 1024 + hhn * 64 + q4 * 4 + dt * 16); }
        }
        const float slope = __builtin_amdgcn_exp2f(-8.0f * (float)(g * 16 + hh + 1) / 48.0f);
        const float bias2 = slope * (float)dil * LOG2E;
        f32x4 sacc[9];
        {
            bf16x8 kf[9][2];
#pragma unroll
            for (int kt = 0; kt < 9; ++kt) { const int t16 = wid + kt; const int rl = (t16 & 7) * 16 + q, sw = (rl >> 1) & 7;
                const LAS unsigned char* kb_ = (t16 >= 8) ? (lds + SC * 32768) : (lds + SP * 32768);
                kf[kt][0] = *(const LAS bf16x8*)(kb_ + rl * 128 + ((q4 ^ sw) * 16));
                kf[kt][1] = *(const LAS bf16x8*)(kb_ + rl * 128 + (((4 + q4) ^ sw) * 16)); }
            asm volatile("" : "+v"(kf[0][0]), "+v"(kf[0][1]), "+v"(kf[1][0]), "+v"(kf[1][1]), "+v"(kf[2][0]), "+v"(kf[2][1]), "+v"(kf[3][0]), "+v"(kf[3][1]), "+v"(kf[4][0]), "+v"(kf[4][1]));
            asm volatile("" : "+v"(kf[5][0]), "+v"(kf[5][1]), "+v"(kf[6][0]), "+v"(kf[6][1]), "+v"(kf[7][0]), "+v"(kf[7][1]), "+v"(kf[8][0]), "+v"(kf[8][1]));
#pragma unroll
            for (int kt = 0; kt < 9; ++kt) { f32x4 a = (f32x4){0.f, 0.f, 0.f, 0.f};
                a = __builtin_amdgcn_mfma_f32_16x16x32_bf16(kf[kt][0], qf[0], a, 0, 0, 0);
                sacc[kt] = a; }
#pragma unroll
            for (int kt = 0; kt < 9; ++kt) sacc[kt] = __builtin_amdgcn_mfma_f32_16x16x32_bf16(kf[kt][1], qf[1], sacc[kt], 0, 0, 0);
        }
        const float relb = (float)(128 + q - q4 * 4);
        const float a0 = -bias2 * relb;
        float mx = -1e30f;
#pragma unroll
        for (int kt = 0; kt < 9; ++kt)
#pragma unroll
            for (int jj = 0; jj < 4; ++jj) {
                float s = __builtin_fmaf(sacc[kt][jj], 0.125f * LOG2E, __builtin_fmaf(bias2, (float)(kt * 16 + jj), a0));
                if (kt == 0) { if (q4 * 4 + jj < q) s = -1e30f; }
                if (kt == 8) { if (q4 * 4 + jj > q) s = -1e30f; }
                sacc[kt][jj] = s; }
        if (n == 0) {
#pragma unroll
            for (int kt = 0; kt < 8; ++kt)
#pragma unroll
                for (int jj = 0; jj < 4; ++jj) if (wid * 16 + kt * 16 + q4 * 4 + jj < 128) sacc[kt][jj] = -1e30f;
        }
#pragma unroll
        for (int kt = 0; kt < 9; ++kt)
#pragma unroll
            for (int jj = 0; jj < 4; ++jj) mx = fmaxf(mx, sacc[kt][jj]);
        mx = fmaxf(mx, __shfl_xor(mx, 16)); mx = fmaxf(mx, __shfl_xor(mx, 32));
        float lsum = 0.f;
#pragma unroll
        for (int kt = 0; kt < 9; ++kt)
#pragma unroll
            for (int jj = 0; jj < 4; ++jj) { const float pv = __builtin_amdgcn_exp2f(sacc[kt][jj] - mx); sacc[kt][jj] = pv; lsum += pv; }
        lsum += __shfl_xor(lsum, 16); lsum += __shfl_xor(lsum, 32);
        f32x4 oacc[4];
#pragma unroll
        for (int dt = 0; dt < 4; ++dt) oacc[dt] = (f32x4){0.f, 0.f, 0.f, 0.f};
#pragma unroll
        for (int kp2 = 0; kp2 < 5; ++kp2) {
            u32x4 pw; pw.x = cvt_pk_bf16(sacc[2 * kp2][0], sacc[2 * kp2][1]); pw.y = cvt_pk_bf16(sacc[2 * kp2][2], sacc[2 * kp2][3]);
            if (kp2 < 4) { pw.z = cvt_pk_bf16(sacc[kp2 < 4 ? 2 * kp2 + 1 : 8][0], sacc[kp2 < 4 ? 2 * kp2 + 1 : 8][1]); pw.w = cvt_pk_bf16(sacc[kp2 < 4 ? 2 * kp2 + 1 : 8][2], sacc[kp2 < 4 ? 2 * kp2 + 1 : 8][3]); }
            else { pw.z = 0u; pw.w = 0u; }
            bf16x8 pf; __builtin_memcpy(&pf, &pw, 16);
            const int chb = 2 * wid + 4 * kp2;
            const LAS unsigned char* v0b = ((chb >> 4) ? (lds + SC * 32768) : (lds + SP * 32768)) + 16384;
            const LAS unsigned char* v1b = (((chb + 2) >> 4) ? (lds + SC * 32768) : (lds + SP * 32768)) + 16384;
            const int c0 = (chb & 15) + (q4 >> 1), c1 = ((chb + 2) & 15) + (q4 >> 1);
#pragma unroll
            for (int dt = 0; dt < 4; ++dt) {
                const int d = dt * 16 + q;
                const int roff = d * 256 + (q4 & 1) * 8;
                u32x4 vw; const u32x2 lo = *(const LAS u32x2*)(v0b + roff + ((c0 ^ q) * 16)); vw.x = lo.x; vw.y = lo.y;
                if (kp2 < 4) { const u32x2 hi = *(const LAS u32x2*)(v1b + roff + ((c1 ^ q) * 16)); vw.z = hi.x; vw.w = hi.y; } else { vw.z = 0u; vw.w = 0u; }
                bf16x8 vf; __builtin_memcpy(&vf, &vw, 16);
                oacc[dt] = __builtin_amdgcn_mfma_f32_16x16x32_bf16(vf, pf, oacc[dt], 0, 0, 0);
            }
            __builtin_amdgcn_sched_barrier(0);
        }
        const float inv = 1.0f / lsum;
        float lse = (mx + __log2f(lsum)) * LN2;
        float w_new = inv, w_old = 0.f;
        if (g > 0) {
            const float mm = fmaxf(oldlse, lse), e0 = __expf(oldlse - mm), e1 = __expf(lse - mm), tot = e0 + e1;
            w_old = e0 / tot; w_new = inv * (e1 / tot); lse = mm + __logf(tot);
        }
#pragma unroll
        for (int dt = 0; dt < 4; ++dt) {
            f32x4 o = oacc[dt] * w_new;
            if (g > 0) { const u32x2 pr = oldacc[dt]; o[0] += w_old * bf_lo(pr.x); o[1] += w_old * bf_hi(pr.x); o[2] += w_old * bf_lo(pr.y); o[3] += w_old * bf_hi(pr.y); }
            u32x2 w; w.x = cvt_pk_bf16(o[0], o[1]); w.y = cvt_pk_bf16(o[2], o[3]);
            pend[dt] = w;
        }
        pend_lse = lse; pend_tq = tq; pend_hh = hh; have_pend = true;
        qf[0] = qn[0]; qf[1] = qn[1]; oldlse = oldlsen; tq = tqn; hh = hhn; n = nn;
#pragma unroll
        for (int dt = 0; dt < 4; ++dt) oldacc[dt] = oldn[dt];
    };
#pragma unroll 1
    for (int kq = 0; kq < 2; ++kq) { item_body(AttIC<0>{}, 4 * kq); item_body(AttIC<1>{}, 4 * kq + 1); item_body(AttIC<2>{}, 4 * kq + 2); item_body(AttIC<3>{}, 4 * kq + 3); }
    if (have_pend) {
        bf16_t* pp = ACC + (size_t)pend_tq * 1024 + pend_hh * 64 + q40 * 4;
#pragma unroll
        for (int dt = 0; dt < 4; ++dt) *(u32x2*)(pp + dt * 16) = pend[dt];
        if (q40 == 0) LSE[(size_t)pend_hh * MT + pend_tq] = pend_lse;
    }
    asm volatile("s_waitcnt vmcnt(0)" ::: "memory");
    __builtin_amdgcn_s_barrier();
}

__global__ void __launch_bounds__(512, 2) yoco_fwd(Params p) {
    extern __shared__ __attribute__((aligned(16))) unsigned char smem[];
    LAS unsigned char* lds = (LAS unsigned char*)smem;
    cg::grid_group grid = cg::this_grid();
    volatile LAS unsigned* xst = (volatile LAS unsigned*)(lds + 131072);
    if (threadIdx.x < 4) xst[threadIdx.x] = 0u;
    __syncthreads();
    const XcdBarrier xb = xcd_barrier_post((unsigned*)(p.ws + OFF_BAR), xst);
    if (p.ws == nullptr) grid.sync();
    unsigned char* ws = p.ws;
    const int G = gridDim.x, c = blockIdx.x;
    bf16_t* HB = (bf16_t*)(ws + OFF_HB);

    phase_prep(p, lds);
    xcd_barrier(xb);
    { SingleUnit S; S.has = c < 64; const int lg = c >> 3, un = c & 7; S.u0.pm = un >> 2; S.u0.pn = un & 3;
      Gemm gm; gm.A = (const bf16_t*)(ws + OFF_WGT) + (size_t)lg * 512 * 512; gm.Bt = (const bf16_t*)(ws + OFF_WINU) + (size_t)lg * 1024 * 512; gm.M = 512; gm.N = 1024; gm.K = 512;
      EpiStore16<true> E; E.O = (bf16_t*)(ws + OFF_BTA) + (size_t)(lg >> 2) * 4096 * 1024 + (size_t)(lg & 3) * 512 * 1024; E.ldc = 1024;
      gemm_phase<EpiStore16<true>, SingleUnit, 0, true>(lds, gm, S, E); }
    xcd_barrier(xb);
    for (int l = 0; l < 2; ++l) {
        { StaticOrder S; S.init(MT, 4096, G, c); Gemm gm; gm.A = HB; gm.Bt = (const bf16_t*)(ws + OFF_BTA) + (size_t)l * 4096 * 1024; gm.M = MT; gm.N = 4096; gm.K = 1024;
          EpiAG1 E; E.V = (bf16_t*)(ws + OFF_V); E.SG = (bf16_t*)(ws + OFF_SG); gemm_phase<EpiAG1, StaticOrder, 0, true>(lds, gm, S, E); }
        xcd_barrier(xb);
        phase_pool((const bf16_t*)(ws + OFF_V), (bf16_t*)(ws + OFF_SG), p.scale_a + l * 2048);
        xcd_barrier(xb);
        { StaticOrder S; S.init(MT, 1024, G, c); Gemm gm; gm.A = (const bf16_t*)(ws + OFF_SG); gm.Bt = (const bf16_t*)(ws + OFF_WOA) + (size_t)l * 1024 * 2048; gm.M = MT; gm.N = 1024; gm.K = 2048;
          if (l == 0) { EpiLnFused<false, false, true, true> E; E.hin_f = nullptr; E.hin_b = HB; E.out_f = nullptr; E.out_b = HB; E.gam = p.ln_g; E.bet = p.ln_b;
              E.xbuf = (unsigned long long*)(ws + OFF_XBUF); E.cnt = (unsigned*)(ws + OFF_CNT); E.want = 32u; gemm_phase(lds, gm, S, E); }
          else { EpiLnFused<false, false, true, true> E; E.hin_f = nullptr; E.hin_b = HB; E.out_f = nullptr; E.out_b = HB; E.gam = p.ln_g + DM; E.bet = p.ln_b + DM;
              E.xbuf = (unsigned long long*)(ws + OFF_XBUF); E.cnt = (unsigned*)(ws + OFF_CNT); E.want = 64u; gemm_phase(lds, gm, S, E); } }
        xcd_barrier(xb);
    }
    { StaticOrder S; S.init(MT, 3072, G, c); Gemm gm; gm.A = HB; gm.Bt = (const bf16_t*)(ws + OFF_KVT); gm.M = MT; gm.N = 3072; gm.K = 1024;
      EpiKr E; E.Kr = (bf16_t*)(ws + OFF_K); gemm_phase<EpiKr, StaticOrder, 0, true>(lds, gm, S, E); }
    { StaticOrder S; S.init(1024, MT, G, c); Gemm gm; gm.Bt = HB; gm.M = 1024; gm.N = MT; gm.K = 1024;
      gm.A = (const bf16_t*)(ws + OFF_KVT) + (size_t)(3072 + 0) * 1024;    { EpiVt<0> E; E.Vt = (bf16_t*)(ws + OFF_VT) + (size_t)0 * MT;    gemm_phase<EpiVt<0>, StaticOrder, 0, true>(lds, gm, S, E); }
      gm.A = (const bf16_t*)(ws + OFF_KVT) + (size_t)(3072 + 1024) * 1024; { EpiVt<2> E; E.Vt = (bf16_t*)(ws + OFF_VT) + (size_t)1024 * MT; gemm_phase<EpiVt<2>, StaticOrder, 2, true>(lds, gm, S, E); }
      gm.A = (const bf16_t*)(ws + OFF_KVT) + (size_t)(3072 + 2048) * 1024; { EpiVt<4> E; E.Vt = (bf16_t*)(ws + OFF_VT) + (size_t)2048 * MT; gemm_phase<EpiVt<4>, StaticOrder, 4, true>(lds, gm, S, E); } }
    bf16_t* QG = (bf16_t*)p.out; bf16_t* QY = (bf16_t*)p.out + (size_t)MT * DM; bf16_t* ACC = QG; float* LSE = (float*)(ws + OFF_LSE);
    for (int j = 0; j < 2; ++j) {
        const bf16_t* inb = (const bf16_t*)(ws + OFF_INB) + (size_t)j * 4096 * 1024;
        { StaticOrder S; S.init(MT, 2048, G, c); Gemm gm; gm.A = HB; gm.Bt = inb; gm.M = MT; gm.N = 2048; gm.K = 1024;
          EpiStoreSplit E; E.O0 = QG; E.O1 = QY; gemm_phase<EpiStoreSplit, StaticOrder, 0, true>(lds, gm, S, E); }
        if (j != 0) attn_issue_first((const bf16_t*)(ws + OFF_K), (const bf16_t*)(ws + OFF_VT), 0, lds);
        xcd_barrier(xb);
        if (j == 0) { tp_job(p.w_out_b, (size_t)1024 * 1024, 1024, 0, (bf16_t*)(ws + OFF_OUTB), (size_t)1024 * 1024, 1024, 1024, 1024, 2, (LAS float*)lds);
                      phase_attn<false>(QG, (const bf16_t*)(ws + OFF_K), (const bf16_t*)(ws + OFF_VT), QG, LSE, 0, lds); }
        else phase_attn<true>(QG, (const bf16_t*)(ws + OFF_K), (const bf16_t*)(ws + OFF_VT), QG, LSE, 0, lds);
        attn_issue_first((const bf16_t*)(ws + OFF_K), (const bf16_t*)(ws + OFF_VT), 1, lds);
        xcd_barrier(xb);
        phase_attn<true>(QY, (const bf16_t*)(ws + OFF_K), (const bf16_t*)(ws + OFF_VT), QG, LSE, 1, lds);
        xcd_barrier(xb);
        { StaticOrder S; S.init(MT, 1024, G, c); Gemm gm; gm.A = HB; gm.Bt = inb + (size_t)2 * 1024 * 1024; gm.M = MT; gm.N = 1024; gm.K = 1024;
          EpiStore16<false> E; E.O = QY; E.ldc = 1024; gemm_phase<EpiStore16<false>, StaticOrder, 0, true>(lds, gm, S, E); }
        attn_issue_first((const bf16_t*)(ws + OFF_K), (const bf16_t*)(ws + OFF_VT), 2, lds);
        xcd_barrier(xb);
        phase_attn<true>(QY, (const bf16_t*)(ws + OFF_K), (const bf16_t*)(ws + OFF_VT), QG, LSE, 2, lds);
        xcd_barrier(xb);
        bf16_t* ZB = j == 0 ? ACC : (bf16_t*)(ws + OFF_K);
        { StaticOrder S; S.init(MT, 1024, G, c); Gemm gm; gm.A = HB; gm.Bt = inb + (size_t)3 * 1024 * 1024; gm.M = MT; gm.N = 1024; gm.K = 1024;
          EpiGateMul E; E.Zin = ACC; E.Zout = ZB; gemm_phase<EpiGateMul, StaticOrder, 0, true>(lds, gm, S, E); }
        xcd_barrier(xb);
        { StaticOrder S; S.init(MT, 1024, G, c); Gemm gm; gm.A = ZB; gm.Bt = (const bf16_t*)(ws + OFF_OUTB) + (size_t)j * 1024 * 1024; gm.M = MT; gm.N = 1024; gm.K = 1024;
          if (j == 0) { EpiLnFused<false, false, true, true> E; E.hin_f = nullptr; E.hin_b = HB; E.out_f = nullptr; E.out_b = HB; E.gam = p.ln_g + 2 * DM; E.bet = p.ln_b + 2 * DM;
              E.xbuf = (unsigned long long*)(ws + OFF_XBUF); E.cnt = (unsigned*)(ws + OFF_CNT); E.want = 96u; gemm_phase(lds, gm, S, E); }
          else { EpiLnFused<false, true, false, true> E; E.hin_f = nullptr; E.hin_b = HB; E.out_f = p.out; E.out_b = nullptr; E.gam = p.ln_g + 3 * DM; E.bet = p.ln_b + 3 * DM;
              E.xbuf = (unsigned long long*)(ws + OFF_XBUF); E.cnt = (unsigned*)(ws + OFF_CNT); E.want = 128u; gemm_phase(lds, gm, S, E); } }
        if (j == 0) xcd_barrier(xb);
    }
}

extern "C" void kernel_launch(void* const* d_in, const int* in_sizes, int n_in, void* d_out, int out_size, void* d_ws, size_t ws_size, hipStream_t stream) {
    static int grid = 0;
    if (grid == 0) {
        if (n_in != 10 || out_size != MT * DM || ws_size < WS_NEED) { fprintf(stderr, "kernel_launch: unexpected shapes / workspace (n_in %d out %d ws %zu)\n", n_in, out_size, ws_size); grid = -1; return; }
        int dev = 0, cus = 0, per_cu = 0;
        hipGetDevice(&dev);
        hipDeviceGetAttribute(&cus, hipDeviceAttributeMultiprocessorCount, dev);
        hipFuncSetAttribute((const void*)yoco_fwd, hipFuncAttributeMaxDynamicSharedMemorySize, LDS_BYTES);
        hipOccupancyMaxActiveBlocksPerMultiprocessor(&per_cu, (const void*)yoco_fwd, 512, LDS_BYTES);
        if (per_cu < 1) per_cu = 1;
        (void)hipGetLastError();
        grid = cus;
    }
    if (grid < 0) return;
    Params p{};
    p.x = (const float*)d_in[0]; p.w_in_a = (const float*)d_in[1]; p.w_grp_a = (const float*)d_in[2]; p.scale_a = (const float*)d_in[3]; p.w_out_a = (const float*)d_in[4];
    p.w_kv = (const float*)d_in[5]; p.w_in_b = (const float*)d_in[6]; p.w_out_b = (const float*)d_in[7]; p.ln_g = (const float*)d_in[8]; p.ln_b = (const float*)d_in[9];
    p.out = (float*)d_out; p.ws = (unsigned char*)d_ws;
    if (hipMemsetAsync((unsigned char*)d_ws + OFF_BAR, 0, 32768, stream) != hipSuccess) { fprintf(stderr, "memset failed\n"); return; }
    void* args[] = {&p};
    hipError_t e = hipLaunchCooperativeKernel((const void*)yoco_fwd, dim3(grid), dim3(512), args, LDS_BYTES, stream);
    if (e != hipSuccess) fprintf(stderr, "cooperative launch failed: %s (grid %d)\n", hipGetErrorString(e), grid);
}
```

```cpp
#include <hip/hip_runtime.h>
#include <hip/hip_cooperative_groups.h>
#include <cstdio>
namespace cg = cooperative_groups;

#define LAS __attribute__((address_space(3)))
typedef unsigned short bf16_t;
typedef short bf16x8 __attribute__((ext_vector_type(8)));
typedef short bf16x4 __attribute__((ext_vector_type(4)));
typedef float f32x4 __attribute__((ext_vector_type(4)));
typedef float f32x2 __attribute__((ext_vector_type(2)));
typedef unsigned u32x4 __attribute__((ext_vector_type(4)));
typedef unsigned u32x2 __attribute__((ext_vector_type(2)));

constexpr int MT = 16384, DM = 1024, SEQ = 4096;
constexpr int BM = 256, BK = 64, HALF = 128, HTB = HALF * BK * 2, STAGE_BYTES = 8 * HTB, NXCD = 8, WGM = 4;
constexpr int LDS_BYTES = 131072 + 1024;
constexpr float DN_ALPHA = 1.681792830507429f;
constexpr float LN_EPS = 1e-5f;
constexpr float LOG2E = 1.4426950408889634f, LN2 = 0.6931471805599453f;
constexpr size_t MiB = 1024 * 1024;
constexpr size_t OFF_V = 0, OFF_SG = 64 * MiB, OFF_BTA = 128 * MiB, OFF_WOA = 144 * MiB, OFF_WGT = 152 * MiB, OFF_WINU = 156 * MiB;
constexpr size_t OFF_KVT = 192 * MiB, OFF_INB = 204 * MiB, OFF_BAR = 220 * MiB, OFF_HB = 224 * MiB;
constexpr size_t OFF_CNT = OFF_BAR + 16384, OFF_XBUF = OFF_BAR + 32768;
constexpr size_t OFF_OUTB = 193 * MiB;
constexpr size_t OFF_K = 0, OFF_VT = 96 * MiB, OFF_LSE = 192 * MiB;
constexpr size_t WS_NEED = 256 * MiB;

typedef __bf16 bf16x2_t __attribute__((ext_vector_type(2)));
__device__ __forceinline__ unsigned cvt_pk_bf16(float lo, float hi) { const f32x2 v = {lo, hi}; const bf16x2_t b = __builtin_convertvector(v, bf16x2_t); return __builtin_bit_cast(unsigned, b); }
__device__ __forceinline__ float bf_lo(unsigned w) { return __uint_as_float(w << 16); }
__device__ __forceinline__ float bf_hi(unsigned w) { return __uint_as_float(w & 0xffff0000u); }
typedef _Float16 half8 __attribute__((ext_vector_type(8)));
__device__ __forceinline__ unsigned cvt_pk_f16(float lo, float hi) { const _Float16 a = (_Float16)lo, b = (_Float16)hi; return (unsigned)__builtin_bit_cast(unsigned short, a) | ((unsigned)__builtin_bit_cast(unsigned short, b) << 16); }
__device__ __forceinline__ float h_lo(unsigned w) { return (float)__builtin_bit_cast(_Float16, (unsigned short)(w & 0xffffu)); }
__device__ __forceinline__ float h_hi(unsigned w) { return (float)__builtin_bit_cast(_Float16, (unsigned short)(w >> 16)); }
template <bool F16> __device__ __forceinline__ unsigned cvt_pk16(float lo, float hi) { if constexpr (F16) return cvt_pk_f16(lo, hi); else return cvt_pk_bf16(lo, hi); }
__device__ __forceinline__ int opaque(int x) { asm volatile("" : "+v"(x)); return x; }
__device__ __forceinline__ float silu_f(float x) { return x * __builtin_amdgcn_rcpf(1.0f + __builtin_amdgcn_exp2f(-x * LOG2E)); }

__host__ __device__ __forceinline__ int lds_byte(int r, int c) { const int st = (r >> 4) * 2 + (c >> 5), rr = r & 15, cc = c & 31, ob = rr * 64 + cc * 2; return st * 1024 + (ob ^ (((ob >> 9) & 1) << 5)); }
__host__ __device__ __forceinline__ void stage_rc(int b, int& R, int& C) { const int st = b / 1024, sb = b % 1024, swz = sb ^ (((sb >> 9) & 1) << 5); R = (st >> 1) * 16 + swz / 64; C = (st & 1) * 32 + (swz % 64) / 2; }
__host__ __device__ __forceinline__ int perm32(int rho) { const int n = rho >> 4, i = rho & 15; return 8 * (i >> 2) + 4 * n + (i & 3); }

struct Unit { int pm, pn; };
struct Gemm { const bf16_t* A; const bf16_t* Bt; int M, N, K; };

struct StaticOrder {
    int nM, nN, nwg, G, c;
    __device__ void init(int M, int N, int G_, int c_) { nM = M / BM; nN = N / BM; nwg = nM * nN; G = G_; c = c_; }
    __device__ bool next(int i, Unit& u) const {
        const long L = (long)i * G + c; if (L >= nwg) return false;
        int wgid = (int)L; { const int q = nwg / NXCD, r = nwg % NXCD, xcd = wgid % NXCD, off = wgid / NXCD; wgid = (xcd < r ? xcd * (q + 1) : r * (q + 1) + (xcd - r) * q) + off; }
        const int nig = WGM * nN, gid = wgid / nig, fm = gid * WGM, gsz = (nM - fm) < WGM ? (nM - fm) : WGM;
        u.pm = fm + ((wgid % nig) % gsz); u.pn = (wgid % nig) / gsz; return true;
    }
};
struct SingleUnit {
    bool has; Unit u0;
    __device__ bool next(int i, Unit& u) const { if (i == 0 && has) { u = u0; return true; } return false; }
};

template <bool F16 = false> struct EpiStore16 {
    static constexpr bool PERM = true, AFTER_DRAIN = false;
    bf16_t* O; int ldc;
    __device__ __forceinline__ void operator()(const f32x4 (&acc)[2][2][4][2], const Unit& u, int wr, int wc, int fr, int fq) const {
        const int row0 = u.pm * BM + wr * 64 + fr, col0 = u.pn * BM + wc * 32 + 8 * fq;
#pragma unroll
        for (int ai = 0; ai < 2; ++ai)
#pragma unroll
            for (int m = 0; m < 4; ++m) { bf16_t* rowp = O + (size_t)(row0 + ai * HALF + m * 16) * ldc + col0;
#pragma unroll
                for (int bj = 0; bj < 2; ++bj) { const f32x4 v0 = acc[ai][bj][m][0], v1 = acc[ai][bj][m][1];
                    u32x4 w; w.x = cvt_pk16<F16>(v0[0], v0[1]); w.y = cvt_pk16<F16>(v0[2], v0[3]); w.z = cvt_pk16<F16>(v1[0], v1[1]); w.w = cvt_pk16<F16>(v1[2], v1[3]);
                    *(u32x4*)(rowp + bj * HALF) = w; } }
    }
};
struct EpiStoreSplit {
    static constexpr bool PERM = true, AFTER_DRAIN = false;
    bf16_t* O0; bf16_t* O1;
    __device__ __forceinline__ void operator()(const f32x4 (&acc)[2][2][4][2], const Unit& u, int wr, int wc, int fr, int fq) const {
        const int row0 = u.pm * BM + wr * 64 + fr, col0 = (u.pn & 3) * BM + wc * 32 + 8 * fq;
        bf16_t* base = u.pn >= 4 ? O1 : O0;
#pragma unroll
        for (int ai = 0; ai < 2; ++ai)
#pragma unroll
            for (int m = 0; m < 4; ++m) { bf16_t* rowp = base + (size_t)(row0 + ai * HALF + m * 16) * 1024 + col0;
#pragma unroll
                for (int bj = 0; bj < 2; ++bj) { const f32x4 v0 = acc[ai][bj][m][0], v1 = acc[ai][bj][m][1];
                    u32x4 w; w.x = cvt_pk_bf16(v0[0], v0[1]); w.y = cvt_pk_bf16(v0[2], v0[3]); w.z = cvt_pk_bf16(v1[0], v1[1]); w.w = cvt_pk_bf16(v1[2], v1[3]);
                    *(u32x4*)(rowp + bj * HALF) = w; } }
    }
};
struct EpiAG1 {
    static constexpr bool PERM = true, AFTER_DRAIN = false;
    bf16_t* V; bf16_t* SG;
    __device__ __forceinline__ void operator()(const f32x4 (&acc)[2][2][4][2], const Unit& u, int wr, int wc, int fr, int fq) const {
        const bool isg = u.pn >= 8;
        const int row0 = u.pm * BM + wr * 64 + fr, col0 = (isg ? u.pn - 8 : u.pn) * BM + wc * 32 + 8 * fq;
        bf16_t* base = isg ? SG : V;
#pragma unroll
        for (int ai = 0; ai < 2; ++ai)
#pragma unroll
            for (int m = 0; m < 4; ++m) { bf16_t* rowp = base + (size_t)(row0 + ai * HALF + m * 16) * 2048 + col0;
#pragma unroll
                for (int bj = 0; bj < 2; ++bj) { f32x4 v0 = acc[ai][bj][m][0], v1 = acc[ai][bj][m][1];
                    if (isg) {
#pragma unroll
                        for (int j = 0; j < 4; ++j) { v0[j] = silu_f(v0[j]); v1[j] = silu_f(v1[j]); } }
                    u32x4 w; w.x = cvt_pk_bf16(v0[0], v0[1]); w.y = cvt_pk_bf16(v0[2], v0[3]); w.z = cvt_pk_bf16(v1[0], v1[1]); w.w = cvt_pk_bf16(v1[2], v1[3]);
                    *(u32x4*)(rowp + bj * HALF) = w; } }
    }
};
struct EpiGateMul {
    static constexpr bool PERM = true, AFTER_DRAIN = false;
    const bf16_t* Zin; bf16_t* Zout;
    __device__ __forceinline__ void operator()(const f32x4 (&acc)[2][2][4][2], const Unit& u, int wr, int wc, int fr, int fq) const {
        const int row0 = u.pm * BM + wr * 64 + fr, col0 = u.pn * BM + wc * 32 + 8 * fq;
#pragma unroll
        for (int ai = 0; ai < 2; ++ai)
#pragma unroll
            for (int m = 0; m < 4; ++m) { const size_t roff = (size_t)(row0 + ai * HALF + m * 16) * DM + col0; const bf16_t* rowp = Zin + roff; bf16_t* rowo = Zout + roff;
#pragma unroll
                for (int bj = 0; bj < 2; ++bj) { const f32x4 v0 = acc[ai][bj][m][0], v1 = acc[ai][bj][m][1];
                    const u32x4 h = *(const u32x4*)(rowp + bj * HALF);
                    u32x4 w;
                    w.x = cvt_pk_bf16(bf_lo(h.x) * silu_f(v0[0]), bf_hi(h.x) * silu_f(v0[1]));
                    w.y = cvt_pk_bf16(bf_lo(h.y) * silu_f(v0[2]), bf_hi(h.y) * silu_f(v0[3]));
                    w.z = cvt_pk_bf16(bf_lo(h.z) * silu_f(v1[0]), bf_hi(h.z) * silu_f(v1[1]));
                    w.w = cvt_pk_bf16(bf_lo(h.w) * silu_f(v1[2]), bf_hi(h.w) * silu_f(v1[3]));
                    *(u32x4*)(rowo + bj * HALF) = w; } }
    }
};
struct EpiKr {
    static constexpr bool PERM = true, AFTER_DRAIN = false;
    bf16_t* Kr;
    __device__ __forceinline__ void operator()(const f32x4 (&acc)[2][2][4][2], const Unit& u, int wr, int wc, int fr, int fq) const {
        const int row0 = u.pm * BM + wr * 64 + fr, col0 = u.pn * BM + wc * 32 + 8 * fq;
        const int g = u.pn >> 2, dsh = 2 * g;
#pragma unroll
        for (int ai = 0; ai < 2; ++ai)
#pragma unroll
            for (int m = 0; m < 4; ++m) { const int t = row0 + ai * HALF + m * 16, b = t >> 12, s = t & 4095, r = s & ((1 << dsh) - 1), i = s >> dsh;
                const int rowidx = r * (SEQ >> dsh) + i;
#pragma unroll
                for (int bj = 0; bj < 2; ++bj) { const f32x4 v0 = acc[ai][bj][m][0], v1 = acc[ai][bj][m][1];
                    const int col = col0 + bj * HALF, hh = (col >> 6) & 15, d0 = col & 63;
                    u32x4 w; w.x = cvt_pk_bf16(v0[0], v0[1]); w.y = cvt_pk_bf16(v0[2], v0[3]); w.z = cvt_pk_bf16(v1[0], v1[1]); w.w = cvt_pk_bf16(v1[2], v1[3]);
                    *(u32x4*)(Kr + ((size_t)(((g * 16 + hh) * 4 + b) * SEQ + rowidx)) * 64 + d0) = w; } }
    }
};
template <int DSH> struct EpiVt {
    static constexpr bool PERM = true, AFTER_DRAIN = false;
    bf16_t* Vt;
    __device__ __forceinline__ void operator()(const f32x4 (&acc)[2][2][4][2], const Unit& u, int wr, int wc, int fr, int fq) const {
        const int row0 = u.pm * BM + wr * 64 + fr;
        const int t_tile = u.pn * BM, b = t_tile >> 12, s_tile = t_tile & 4095;
#pragma unroll
        for (int ai = 0; ai < 2; ++ai)
#pragma unroll
            for (int m = 0; m < 4; ++m) { bf16_t* rowp = Vt + (size_t)(row0 + ai * HALF + m * 16) * MT + b * SEQ + (s_tile >> DSH);
#pragma unroll
                for (int bj = 0; bj < 2; ++bj) { const f32x4 v0 = acc[ai][bj][m][0], v1 = acc[ai][bj][m][1];
                    const int c = bj * HALF + wc * 32 + 8 * fq, r = c >> (8 - DSH), il = c & ((256 >> DSH) - 1);
                    u32x4 w; w.x = cvt_pk_bf16(v0[0], v0[1]); w.y = cvt_pk_bf16(v0[2], v0[3]); w.z = cvt_pk_bf16(v1[0], v1[1]); w.w = cvt_pk_bf16(v1[2], v1[3]);
                    *(u32x4*)(rowp + r * (SEQ >> DSH) + il) = w; } }
    }
};

template <bool RES_F32, bool OUT_F, bool OUT_B, bool F16 = false> struct EpiLnFused {
    static constexpr bool PERM = false, AFTER_DRAIN = true;
    const float* hin_f; const bf16_t* hin_b;
    float* out_f; bf16_t* out_b;
    const float* gam; const float* bet;
    unsigned long long* xbuf; unsigned* cnt; unsigned want;
    __device__ __forceinline__ void fused(f32x4 (&acc)[2][2][4][2], const Unit& u, int wr, int wc, int fr, int fq, LAS unsigned char* lds, int wid, int lane) const {
        LAS f32x2* P = (LAS f32x2*)lds;
        LAS f32x2* S = (LAS f32x2*)(lds + 8192);
        const int col0 = u.pn * BM + wc * 32 + 4 * fq;
#pragma unroll
        for (int ai = 0; ai < 2; ++ai)
#pragma unroll
            for (int mp = 0; mp < 2; ++mp) {
                f32x4 hb_[2][2][2];
#pragma unroll
                for (int mi = 0; mi < 2; ++mi) { const int m = mp * 2 + mi; const unsigned off = (unsigned)(u.pm * BM + ai * HALF + wr * 64 + m * 16 + fr) * DM + col0;
#pragma unroll
                    for (int bj = 0; bj < 2; ++bj)
#pragma unroll
                        for (int n = 0; n < 2; ++n) {
                            if constexpr (RES_F32) hb_[mi][bj][n] = *(const f32x4*)(hin_f + off + bj * HALF + n * 16);
                            else { const u32x2 w = *(const u32x2*)(hin_b + off + bj * HALF + n * 16); hb_[mi][bj][n] = (f32x4){__uint_as_float(w.x), __uint_as_float(w.y), 0.f, 0.f}; } } }
                asm volatile("" : "+v"(hb_[0][0][0]), "+v"(hb_[0][0][1]), "+v"(hb_[0][1][0]), "+v"(hb_[0][1][1]), "+v"(hb_[1][0][0]), "+v"(hb_[1][0][1]), "+v"(hb_[1][1][0]), "+v"(hb_[1][1][1]));
#pragma unroll
                for (int mi = 0; mi < 2; ++mi) { const int m = mp * 2 + mi;
#pragma unroll
                    for (int bj = 0; bj < 2; ++bj)
#pragma unroll
                        for (int n = 0; n < 2; ++n) { f32x4 h = hb_[mi][bj][n];
                            if constexpr (!RES_F32) { const unsigned wx = __float_as_uint(h[0]), wy = __float_as_uint(h[1]); if constexpr (F16) h = (f32x4){h_lo(wx), h_hi(wx), h_lo(wy), h_hi(wy)}; else h = (f32x4){bf_lo(wx), bf_hi(wx), bf_lo(wy), bf_hi(wy)}; }
                            acc[ai][bj][m][n] = h * DN_ALPHA + acc[ai][bj][m][n]; }
                    asm volatile("" : "+v"(acc[ai][0][m][0]), "+v"(acc[ai][0][m][1]), "+v"(acc[ai][1][m][0]), "+v"(acc[ai][1][m][1])); }
                asm volatile("" ::: "memory"); }
#pragma unroll
        for (int ai = 0; ai < 2; ++ai)
#pragma unroll
            for (int m = 0; m < 4; ++m) {
                float s = 0.f;
#pragma unroll
                for (int bj = 0; bj < 2; ++bj)
#pragma unroll
                    for (int n = 0; n < 2; ++n) { const f32x4 x = acc[ai][bj][m][n]; s += (x[0] + x[1]) + (x[2] + x[3]); }
                s += __shfl_xor(s, 16); s += __shfl_xor(s, 32);
                const float mw = s * (1.0f / 64.0f); float qq = 0.f;
#pragma unroll
                for (int bj = 0; bj < 2; ++bj)
#pragma unroll
                    for (int n = 0; n < 2; ++n) { const f32x4 d = acc[ai][bj][m][n] - mw; qq += (d[0] * d[0] + d[1] * d[1]) + (d[2] * d[2] + d[3] * d[3]); }
                qq += __shfl_xor(qq, 16); qq += __shfl_xor(qq, 32);
                if (fq == 0) P[(ai * HALF + wr * 64 + m * 16 + fr) * 4 + wc] = (f32x2){mw, qq};
            }
        asm volatile("s_waitcnt lgkmcnt(0)" ::: "memory"); __builtin_amdgcn_s_barrier(); asm volatile("" ::: "memory");
        const int row = wid * 32 + (lane & 31);
        if (lane < 32) {
            const f32x2 a = P[row * 4 + 0], b = P[row * 4 + 1], c = P[row * 4 + 2], d = P[row * 4 + 3];
            const float mt = (a.x + b.x + c.x + d.x) * 0.25f;
            const float da = a.x - mt, db = b.x - mt, dc = c.x - mt, dd = d.x - mt;
            const float m2 = (a.y + b.y) + (c.y + d.y) + 64.0f * ((da * da + db * db) + (dc * dc + dd * dd));
            unsigned long long* slot = xbuf + ((size_t)(u.pm * BM + row) * 4 + u.pn);
            __hip_atomic_store(slot, ((unsigned long long)__float_as_uint(m2) << 32) | __float_as_uint(mt), __ATOMIC_RELAXED, __HIP_MEMORY_SCOPE_AGENT);
        }
        asm volatile("s_waitcnt vmcnt(0)" ::: "memory");
        if (lane == 0) __hip_atomic_fetch_add(cnt + 64 * u.pm, 1u, __ATOMIC_RELAXED, __HIP_MEMORY_SCOPE_AGENT);
        if (wid == 0) {
            unsigned sp = 0;
            while ((unsigned)__builtin_amdgcn_readfirstlane(__hip_atomic_load(cnt + 64 * u.pm, __ATOMIC_RELAXED, __HIP_MEMORY_SCOPE_AGENT)) < want) { __builtin_amdgcn_s_sleep(2); if (++sp > (1u << 22)) break; }
            __builtin_amdgcn_fence(__ATOMIC_ACQUIRE, "agent");
        }
        asm volatile("s_waitcnt vmcnt(0) lgkmcnt(0)" ::: "memory"); __builtin_amdgcn_s_barrier(); asm volatile("" ::: "memory");
        if (lane < 32) {
            const unsigned long long* slot = xbuf + (size_t)(u.pm * BM + row) * 4; float mt[4], m2[4]; float ms = 0.f;
#pragma unroll
            for (int t = 0; t < 4; ++t) { const unsigned long long w = __hip_atomic_load(slot + t, __ATOMIC_RELAXED, __HIP_MEMORY_SCOPE_AGENT); mt[t] = __uint_as_float((unsigned)w); m2[t] = __uint_as_float((unsigned)(w >> 32)); ms += mt[t]; }
            const float mean = ms * 0.25f; float qq = 0.f;
#pragma unroll
            for (int t = 0; t < 4; ++t) { const float dm = mt[t] - mean; qq += m2[t] + 256.0f * dm * dm; }
            S[row] = (f32x2){mean, 1.0f / sqrtf(qq * (1.0f / 1024.0f) + LN_EPS)};
        }
        asm volatile("s_waitcnt lgkmcnt(0)" ::: "memory"); __builtin_amdgcn_s_barrier(); asm volatile("" ::: "memory");
        f32x2 sr[2][4];
#pragma unroll
        for (int ai = 0; ai < 2; ++ai)
#pragma unroll
            for (int m = 0; m < 4; ++m) sr[ai][m] = S[ai * HALF + wr * 64 + m * 16 + fr];
#pragma unroll
        for (int bj = 0; bj < 2; ++bj)
#pragma unroll
            for (int n = 0; n < 2; ++n) { const f32x4 gv = *(const f32x4*)(gam + col0 + bj * HALF + n * 16), bv = *(const f32x4*)(bet + col0 + bj * HALF + n * 16);
#pragma unroll
                for (int ai = 0; ai < 2; ++ai)
#pragma unroll
                    for (int m = 0; m < 4; ++m) { const int r = ai * HALF + wr * 64 + m * 16 + fr; const unsigned off = (unsigned)(u.pm * BM + r) * DM + col0 + bj * HALF + n * 16;
                        const f32x4 o = (acc[ai][bj][m][n] - sr[ai][m].x) * sr[ai][m].y * gv + bv;
                        if constexpr (OUT_F) *(f32x4*)(out_f + off) = o;
                        if constexpr (OUT_B) { u32x2 w; w.x = cvt_pk16<F16>(o[0], o[1]); w.y = cvt_pk16<F16>(o[2], o[3]); *(u32x2*)(out_b + off) = w; } } }
    }
};

template <class Epi, class Sched, int DSH = 0, bool F16 = false, bool SP2 = true, bool ALIGN_EPI = true>
__device__ __forceinline__ void gemm_phase(LAS unsigned char* lds, const Gemm g, const Sched& S, const Epi& E) {
    const int tid = opaque(threadIdx.x), wid = __builtin_amdgcn_readfirstlane(tid >> 6), lane = tid & 63, wr = wid >> 2, wc = wid & 3, fr = lane & 15, fq = lane >> 4;
    const int K = g.K, nt = K / BK;
    unsigned voffA[2], voffB[2], voffB1[2];
#pragma unroll
    for (int i = 0; i < 2; ++i) { int R, C; stage_rc(tid * 16 + i * 8192, R, C); const int Rb = Epi::PERM ? ((R & ~31) + perm32(R & 31)) : R;
        voffA[i] = (unsigned)(R * K + C) * 2u;
        if constexpr (DSH == 0) { voffB[i] = (unsigned)(Rb * K + C) * 2u; voffB1[i] = (unsigned)((Rb + HALF) * K + C) * 2u; }
        else { const int c0_ = Rb, c1_ = Rb + HALF; const int t0_ = ((c0_ & ((256 >> DSH) - 1)) << DSH) + (c0_ >> (8 - DSH)), t1_ = ((c1_ & ((256 >> DSH) - 1)) << DSH) + (c1_ >> (8 - DSH));
            voffB[i] = (unsigned)(t0_ * K + C) * 2u; voffB1[i] = (unsigned)(t1_ * K + C) * 2u; } }
    const size_t kstep = (size_t)(BK * 2);
    const size_t hstep = (size_t)HALF * K * 2;
    const size_t tstep = 2 * hstep;
    const unsigned ldsw = (unsigned)wid * 1024u;
    const int aoff = lds_byte(wr * 64 + fr, fq * 8), boff = lds_byte(wc * 32 + fr, fq * 8);
#define PG8_SA(b, h) (((b) * 2 + (h)) * HTB)
#define PG8_SB(b, h) ((4 + (b) * 2 + (h)) * HTB)
#define PG8_STAGE(bufoff, gbase, voff) do { _Pragma("unroll") for (int _i = 0; _i < 2; ++_i) \
        __builtin_amdgcn_global_load_lds((const unsigned*)((const char*)(gbase) + (voff)[_i]), (LAS unsigned*)(lds + (bufoff) + ldsw + _i * 8192), 16, 0, 0); } while (0)
#define PG8_LDA(dst, b, h) do { _Pragma("unroll") for (int m = 0; m < 4; ++m) _Pragma("unroll") for (int k = 0; k < 2; ++k) dst[m][k] = *(const LAS bf16x8*)(lds + PG8_SA(b, h) + aoff + m * 2048 + k * 1024); } while (0)
#define PG8_LDB(dst, b, h) do { _Pragma("unroll") for (int n = 0; n < 2; ++n) _Pragma("unroll") for (int k = 0; k < 2; ++k) dst[n][k] = *(const LAS bf16x8*)(lds + PG8_SB(b, h) + boff + n * 2048 + k * 1024); } while (0)
#define PG8_MMA(ai, bj, At, Bt) do { __builtin_amdgcn_s_setprio(1); _Pragma("unroll") for (int m = 0; m < 4; ++m) _Pragma("unroll") for (int n = 0; n < 2; ++n) _Pragma("unroll") for (int k = 0; k < 2; ++k) \
        acc[ai][bj][m][n] = F16 ? __builtin_amdgcn_mfma_f32_16x16x32_f16(__builtin_bit_cast(half8, Bt[n][k]), __builtin_bit_cast(half8, At[m][k]), acc[ai][bj][m][n], 0, 0, 0) : __builtin_amdgcn_mfma_f32_16x16x32_bf16(Bt[n][k], At[m][k], acc[ai][bj][m][n], 0, 0, 0); __builtin_amdgcn_s_setprio(0); } while (0)
#define PG8_WAIT_V(n) asm volatile("s_waitcnt vmcnt(" #n ")" ::: "memory")
#define PG8_WAIT_L(n) asm volatile("s_waitcnt lgkmcnt(" #n ")" ::: "memory")
#define PG8_BAR __builtin_amdgcn_s_barrier()
#define PG8_SCHED __builtin_amdgcn_sched_barrier(0)
    Unit cur, nxt; int ui = 0;
    if (!S.next(0, cur)) return;
    f32x4 acc[2][2][4][2];
#pragma unroll
    for (int a = 0; a < 2; ++a)
#pragma unroll
        for (int b = 0; b < 2; ++b)
#pragma unroll
            for (int m = 0; m < 4; ++m)
#pragma unroll
                for (int n = 0; n < 2; ++n) acc[a][b][m][n] = (f32x4){0.f, 0.f, 0.f, 0.f};
    bf16x8 At[4][2], B0[2][2], B1[2][2];
    const char* cA = (const char*)g.A + (size_t)cur.pm * tstep; const char* cB = (const char*)g.Bt + (size_t)cur.pn * tstep;
    if constexpr (SP2) {
        PG8_STAGE(PG8_SB(0, 0), cB, voffB); PG8_STAGE(PG8_SB(0, 1), cB, voffB1); PG8_STAGE(PG8_SA(0, 0), cA, voffA); PG8_STAGE(PG8_SA(0, 1), cA + hstep, voffA);
        if (wr == 1) PG8_BAR;
        PG8_WAIT_V(2); PG8_BAR;
        PG8_STAGE(PG8_SB(1, 0), cB + kstep, voffB); PG8_STAGE(PG8_SA(1, 0), cA + kstep, voffA); PG8_STAGE(PG8_SB(1, 1), cB + kstep, voffB1);
        PG8_WAIT_V(6); PG8_BAR;
    } else {
    PG8_STAGE(PG8_SB(0, 0), cB, voffB); PG8_STAGE(PG8_SA(0, 0), cA, voffA); PG8_STAGE(PG8_SB(0, 1), cB, voffB1); PG8_STAGE(PG8_SA(0, 1), cA + hstep, voffA);
    if (wr == 1) PG8_BAR;
    PG8_WAIT_V(4); PG8_BAR;
    PG8_STAGE(PG8_SB(1, 0), cB + kstep, voffB); PG8_STAGE(PG8_SA(1, 0), cA + kstep, voffA); PG8_STAGE(PG8_SB(1, 1), cB + kstep, voffB1);
    PG8_WAIT_V(6); PG8_BAR;
    }
    for (;;) {
        const bool has_next = S.next(ui + 1, nxt);
        const char* nA = has_next ? (const char*)g.A + (size_t)nxt.pm * tstep : cA; const char* nB = has_next ? (const char*)g.Bt + (size_t)nxt.pn * tstep : cB;
        for (int t = 0; t < nt; t += 2) {
            const bool last = (t == nt - 2);
            const char* a1 = cA + (size_t)(t + 1) * kstep;
            const char* a2 = last ? nA : cA + (size_t)(t + 2) * kstep; const char* b2 = last ? nB : cB + (size_t)(t + 2) * kstep;
            const char* a3 = a2 + kstep; const char* b3 = b2 + kstep;
            if constexpr (SP2) {
            PG8_LDB(B0, 0, 0); PG8_LDB(B1, 0, 1); PG8_SCHED; PG8_LDA(At, 0, 0); PG8_STAGE(PG8_SA(1, 1), a1 + hstep, voffA);
            PG8_WAIT_V(8); PG8_WAIT_L(0); PG8_BAR; PG8_MMA(0, 0, At, B0); PG8_MMA(0, 1, At, B1); PG8_BAR; PG8_SCHED;
            PG8_LDA(At, 0, 1); PG8_STAGE(PG8_SB(0, 0), b2, voffB); PG8_STAGE(PG8_SB(0, 1), b2, voffB1); PG8_STAGE(PG8_SA(0, 0), a2, voffA);
            PG8_WAIT_V(8); PG8_WAIT_L(0); PG8_BAR; PG8_MMA(1, 0, At, B0); PG8_MMA(1, 1, At, B1); PG8_BAR; PG8_SCHED;
            PG8_LDB(B0, 1, 0); PG8_LDB(B1, 1, 1); PG8_SCHED; PG8_LDA(At, 1, 0); PG8_STAGE(PG8_SA(0, 1), a2 + hstep, voffA);
            PG8_WAIT_V(8); PG8_WAIT_L(0); PG8_BAR; PG8_MMA(0, 0, At, B0); PG8_MMA(0, 1, At, B1); PG8_BAR; PG8_SCHED;
            PG8_LDA(At, 1, 1); PG8_STAGE(PG8_SB(1, 0), b3, voffB); PG8_STAGE(PG8_SB(1, 1), b3, voffB1); PG8_STAGE(PG8_SA(1, 0), a3, voffA);
            PG8_WAIT_V(8); PG8_WAIT_L(0); PG8_BAR; PG8_MMA(1, 0, At, B0); PG8_MMA(1, 1, At, B1); PG8_BAR; PG8_SCHED;
            } else {
            PG8_LDB(B0, 0, 0); PG8_SCHED; PG8_LDA(At, 0, 0); PG8_STAGE(PG8_SA(1, 1), a1 + hstep, voffA);
            PG8_WAIT_L(8); PG8_BAR; PG8_WAIT_L(0); PG8_MMA(0, 0, At, B0); PG8_BAR; PG8_SCHED;
            PG8_LDB(B1, 0, 1); PG8_STAGE(PG8_SB(0, 0), b2, voffB);
            PG8_BAR; PG8_WAIT_L(0); PG8_MMA(0, 1, At, B1); PG8_BAR;
            PG8_LDA(At, 0, 1); PG8_STAGE(PG8_SA(0, 0), a2, voffA);
            PG8_BAR; PG8_WAIT_L(0); PG8_MMA(1, 0, At, B0); PG8_BAR; PG8_SCHED;
            PG8_STAGE(PG8_SB(0, 1), b2, voffB1);
            PG8_WAIT_V(6); PG8_BAR; PG8_MMA(1, 1, At, B1); PG8_BAR;
            PG8_LDB(B0, 1, 0); PG8_SCHED; PG8_LDA(At, 1, 0); PG8_STAGE(PG8_SA(0, 1), a2 + hstep, voffA);
            PG8_WAIT_L(8); PG8_BAR; PG8_WAIT_L(0); PG8_MMA(0, 0, At, B0); PG8_BAR; PG8_SCHED;
            PG8_LDB(B1, 1, 1); PG8_STAGE(PG8_SB(1, 0), b3, voffB);
            PG8_BAR; PG8_WAIT_L(0); PG8_MMA(0, 1, At, B1); PG8_BAR;
            PG8_LDA(At, 1, 1); PG8_STAGE(PG8_SA(1, 0), a3, voffA);
            PG8_BAR; PG8_WAIT_L(0); PG8_MMA(1, 0, At, B0); PG8_BAR; PG8_SCHED;
            PG8_STAGE(PG8_SB(1, 1), b3, voffB1);
            PG8_WAIT_V(6); PG8_BAR; PG8_MMA(1, 1, At, B1); PG8_BAR;
            }
        }
        if constexpr (ALIGN_EPI) { if (wr == 0) PG8_BAR; }
        if constexpr (!Epi::AFTER_DRAIN) E(acc, cur, wr, wc, fr, fq);
        if (!has_next) break;
#pragma unroll
        for (int a = 0; a < 2; ++a)
#pragma unroll
            for (int b = 0; b < 2; ++b)
#pragma unroll
                for (int m = 0; m < 4; ++m)
#pragma unroll
                    for (int n = 0; n < 2; ++n) acc[a][b][m][n] = (f32x4){0.f, 0.f, 0.f, 0.f};
        cur = nxt; cA = nA; cB = nB; ++ui;
        if constexpr (ALIGN_EPI) { if (wr == 1) PG8_BAR; }
    }
    PG8_WAIT_V(0);
    if constexpr (!ALIGN_EPI) { if (wr == 0) PG8_BAR; }
    PG8_BAR;
    if constexpr (Epi::AFTER_DRAIN) E.fused(acc, cur, wr, wc, fr, fq, lds, wid, lane);
#undef PG8_SA
#undef PG8_SB
#undef PG8_STAGE
#undef PG8_LDA
#undef PG8_LDB
#undef PG8_MMA
#undef PG8_WAIT_V
#undef PG8_WAIT_L
#undef PG8_BAR
#undef PG8_SCHED
}


#define XB_TMO      128
#define XB_XCNT(j)  (256  + 64 * (j))
#define XB_XSUB(j)  (1280 + 64 * (j))
#define XB_XGEN(j)  (2304 + 64 * (j))
#define XB_TOP      3328
#define XB_TOPGEN   3392
#define XCD_BAR_WORDS 3456
#define XB_SPIN_CAP (1u << 18)
__device__ __forceinline__ unsigned xb_ld(unsigned* p)              { return __hip_atomic_load(p, __ATOMIC_RELAXED, __HIP_MEMORY_SCOPE_AGENT); }
__device__ __forceinline__ unsigned xb_add(unsigned* p, unsigned v) { return __hip_atomic_fetch_add(p, v, __ATOMIC_RELAXED, __HIP_MEMORY_SCOPE_AGENT); }
__device__ __forceinline__ unsigned xb_xcc_id() { return (unsigned)__builtin_amdgcn_s_getreg((3 << 11) | 20) & 0xFu; }
#define XB_SPIN(cond, bar) do { unsigned _sp = 0; while (cond) { __builtin_amdgcn_s_sleep(1); \
    if ((++_sp & 255u) == 0u) { if (xb_ld(&(bar)[XB_TMO])) break; if (_sp > XB_SPIN_CAP) { atomicAdd(&(bar)[XB_TMO], 1u); break; } } } } while (0)
struct XcdBarrier { unsigned* bar; unsigned x; volatile LAS unsigned* st; };
__device__ __forceinline__ XcdBarrier xcd_barrier_post(unsigned* bar, volatile LAS unsigned* st) {
    XcdBarrier b; b.bar = bar; b.x = xb_xcc_id(); b.st = st;
    if (threadIdx.x == 0) (void)xb_add(&bar[XB_XCNT(b.x)], 1u);
    return b;
}
__device__ __forceinline__ void xcd_barrier_complete(unsigned* bar, unsigned x, unsigned& nloc, unsigned& nx) {
    const unsigned G = gridDim.x * gridDim.y * gridDim.z;
    unsigned sum, cnt, mine, sp = 0u;
    for (;;) {
        sum = 0u; cnt = 0u; mine = 0u;
#pragma unroll
        for (unsigned j = 0; j < 16; ++j) { const unsigned c = xb_ld(&bar[XB_XCNT(j)]); sum += c; cnt += (c > 0u) ? 1u : 0u; mine = (j == x) ? c : mine; }
        if (sum == G) break;
        __builtin_amdgcn_s_sleep(1);
        if ((++sp & 255u) == 0u) { if (xb_ld(&bar[XB_TMO])) break; if (sp > XB_SPIN_CAP) { atomicAdd(&bar[XB_TMO], 1u); break; } }
    }
    nloc = mine > 0u ? mine : 1u; nx = cnt > 0u ? cnt : 1u;
}
__device__ __forceinline__ void xcd_barrier(const XcdBarrier& b) {
    asm volatile("s_waitcnt vmcnt(0)" ::: "memory");
    __syncthreads();
    if (threadIdx.x == 0) {
        unsigned* bar = b.bar;
        const unsigned bx = xb_xcc_id();
        __builtin_amdgcn_s_waitcnt(0);
        unsigned nloc = b.st[0], nx = b.st[1];
        if (nloc == 0u) { xcd_barrier_complete(bar, bx, nloc, nx); b.st[0] = nloc; b.st[1] = nx; }
        const unsigned old = xb_add(&bar[XB_XSUB(bx)], 1u);
        const unsigned gen = old / nloc;
        if (old + 1u == (gen + 1u) * nloc) {
            __builtin_amdgcn_fence(__ATOMIC_RELEASE, "agent");
            asm volatile("s_waitcnt vmcnt(0)" ::: "memory");
            const unsigned og = xb_add(&bar[XB_TOP], 1u);
            const unsigned tg = og / nx;
            if (og + 1u == (tg + 1u) * nx) xb_add(&bar[XB_TOPGEN], 1u);
            else XB_SPIN(xb_ld(&bar[XB_TOPGEN]) == tg, bar);
            __builtin_amdgcn_fence(__ATOMIC_ACQUIRE, "agent");
            xb_add(&bar[XB_XGEN(bx)], 1u);
            asm volatile("s_waitcnt vmcnt(0)" ::: "memory");
        } else {
            XB_SPIN(xb_ld(&bar[XB_XGEN(bx)]) == gen, bar);
            __builtin_amdgcn_fence(__ATOMIC_ACQUIRE, "agent");
            asm volatile("s_waitcnt vmcnt(0)" ::: "memory");
        }
    }
    __syncthreads();
}

template <bool F16 = false>
__device__ __forceinline__ void tp_job(const float* src, size_t smat, int lsrc, int coff, bf16_t* dst, size_t dmat, int ldd, int R, int C, int nmat, LAS float* scr) {
    const int tid = opaque(threadIdx.x);
    const int ntc = C / 64, per = (R / 64) * ntc, total = per * nmat;
    const int G = gridDim.x;
    f32x4 v[2];
    int t = blockIdx.x;
#define TP_LOAD(tt_) do { const int i_ = (tt_) / per, t2_ = (tt_) % per, tr_ = t2_ / ntc, tc_ = t2_ % ntc; const float* s_ = src + (size_t)i_ * smat + coff; \
        _Pragma("unroll") for (int k_ = 0; k_ < 2; ++k_) { const int idx_ = tid + 512 * k_, row_ = idx_ >> 4, c4_ = idx_ & 15; v[k_] = *(const f32x4*)(s_ + (size_t)(tr_ * 64 + row_) * lsrc + tc_ * 64 + c4_ * 4); } } while (0)
    if (t < total) TP_LOAD(t);
#pragma unroll 1
    for (; t < total; t += G) {
#pragma unroll
        for (int k = 0; k < 2; ++k) { const int idx = tid + 512 * k, row = idx >> 4, c4 = idx & 15; LAS float* pp = scr + row * 65 + c4 * 4; pp[0] = v[k][0]; pp[1] = v[k][1]; pp[2] = v[k][2]; pp[3] = v[k][3]; }
        if (t + G < total) TP_LOAD(t + G);
        __syncthreads();
        { const int i = t / per, t2 = t % per, tr = t2 / ntc, tc = t2 % ntc; bf16_t* d = dst + (size_t)i * dmat;
          const int c = tid >> 3, ch = tid & 7; const LAS float* sp = scr + (ch * 8) * 65 + c;
          u32x4 o; o.x = cvt_pk16<F16>(sp[0], sp[65]); o.y = cvt_pk16<F16>(sp[2 * 65], sp[3 * 65]); o.z = cvt_pk16<F16>(sp[4 * 65], sp[5 * 65]); o.w = cvt_pk16<F16>(sp[6 * 65], sp[7 * 65]);
          *(u32x4*)(d + (size_t)(tc * 64 + c) * ldd + tr * 64 + ch * 8) = o; }
        __syncthreads();
    }
#undef TP_LOAD
}

struct Params {
    const float *x, *w_in_a, *w_grp_a, *scale_a, *w_out_a, *w_kv, *w_in_b, *w_out_b, *ln_g, *ln_b;
    float* out; unsigned char* ws;
};

__device__ __forceinline__ void phase_prep(const Params& p, LAS unsigned char* lds) {
    LAS float* scr = (LAS float*)lds;
    unsigned char* ws = p.ws;
    tp_job<true>(p.w_in_a, (size_t)1024 * 4096, 4096, 2048, (bf16_t*)(ws + OFF_BTA) + (size_t)2048 * 1024, (size_t)4096 * 1024, 1024, 1024, 2048, 2, scr);
    tp_job(p.w_out_a, (size_t)2048 * 1024, 1024, 0, (bf16_t*)(ws + OFF_WOA), (size_t)1024 * 2048, 2048, 2048, 1024, 2, scr);
    tp_job<true>(p.w_kv, 0, 6144, 0, (bf16_t*)(ws + OFF_KVT), 0, 1024, 1024, 6144, 1, scr);
    tp_job<true>(p.w_in_b, (size_t)1024 * 4096, 4096, 0, (bf16_t*)(ws + OFF_INB), (size_t)4096 * 1024, 1024, 1024, 4096, 2, scr);
    tp_job<true>(p.w_grp_a, (size_t)512 * 512, 512, 0, (bf16_t*)(ws + OFF_WGT), (size_t)512 * 512, 512, 512, 512, 8, scr);
    { bf16_t* winu = (bf16_t*)(ws + OFF_WINU);
      const int total = 2 * 4 * 1024 * 64;
      const int tid = opaque(threadIdx.x);
#pragma unroll 1
      for (int i0 = blockIdx.x * 512 + tid; i0 < total; i0 += gridDim.x * 512 * 4) {
          f32x4 a[4], b[4];
#pragma unroll
          for (int u = 0; u < 4; ++u) { const int i = i0 + u * gridDim.x * 512; if (i < total) { const int c8 = i & 63, k = (i >> 6) & 1023, lg = i >> 16, l = lg >> 2, g = lg & 3;
              const float* s = p.w_in_a + ((size_t)l * 1024 + k) * 4096 + g * 512 + c8 * 8; a[u] = *(const f32x4*)s; b[u] = *(const f32x4*)(s + 4); } }
#pragma unroll
          for (int u = 0; u < 4; ++u) { const int i = i0 + u * gridDim.x * 512; if (i < total) {
              u32x4 o; o.x = cvt_pk_f16(a[u][0], a[u][1]); o.y = cvt_pk_f16(a[u][2], a[u][3]); o.z = cvt_pk_f16(b[u][0], b[u][1]); o.w = cvt_pk_f16(b[u][2], b[u][3]);
              *(u32x4*)(winu + (size_t)i * 8) = o; } } } }
    { bf16_t* hb = (bf16_t*)(ws + OFF_HB);
      const int total = MT * DM / 8;
      const int tid = opaque(threadIdx.x);
#pragma unroll 1
      for (int i0 = blockIdx.x * 512 + tid; i0 < total; i0 += gridDim.x * 512 * 4) {
          f32x4 a[4], b[4];
#pragma unroll
          for (int u = 0; u < 4; ++u) { const int i = i0 + u * gridDim.x * 512; if (i < total) { const float* s = p.x + (size_t)i * 8; a[u] = *(const f32x4*)s; b[u] = *(const f32x4*)(s + 4); } }
#pragma unroll
          for (int u = 0; u < 4; ++u) { const int i = i0 + u * gridDim.x * 512; if (i < total) {
              u32x4 o; o.x = cvt_pk_f16(a[u][0], a[u][1]); o.y = cvt_pk_f16(a[u][2], a[u][3]); o.z = cvt_pk_f16(b[u][0], b[u][1]); o.w = cvt_pk_f16(b[u][2], b[u][3]);
              *(u32x4*)(hb + (size_t)i * 8) = o; } } } }
}

__device__ __forceinline__ void unpack8(const u32x4 w, float (&f)[8]) { f[0] = bf_lo(w.x); f[1] = bf_hi(w.x); f[2] = bf_lo(w.y); f[3] = bf_hi(w.y); f[4] = bf_lo(w.z); f[5] = bf_hi(w.z); f[6] = bf_lo(w.w); f[7] = bf_hi(w.w); }
template <int W>
__device__ __forceinline__ void pool_item(const bf16_t* V, bf16_t* SG, const float (&sc)[8], int t0, int c0) {
    const int s0 = t0 & (SEQ - 1);
    u32x4 rows[W + 3], gts[4];
#pragma unroll
    for (int j = 0; j < W + 3; ++j) { const int dt = j - (W - 1); rows[j] = (u32x4){0u, 0u, 0u, 0u}; if (s0 + dt >= 0) rows[j] = *(const u32x4*)(V + (size_t)(t0 + dt) * 2048 + c0); }
#pragma unroll
    for (int i = 0; i < 4; ++i) gts[i] = *(const u32x4*)(SG + (size_t)(t0 + i) * 2048 + c0);
    float sum[8];
#pragma unroll
    for (int j = 0; j < 8; ++j) sum[j] = 0.f;
#pragma unroll
    for (int j = 0; j < W - 1; ++j) { float f[8]; unpack8(rows[j], f);
#pragma unroll
        for (int k = 0; k < 8; ++k) sum[k] += f[k]; }
#pragma unroll
    for (int i = 0; i < 4; ++i) {
        float f[8], gt[8]; unpack8(rows[W - 1 + i], f); unpack8(gts[i], gt);
#pragma unroll
        for (int k = 0; k < 8; ++k) sum[k] += f[k];
        const int s = s0 + i; const float inv = 1.0f / (float)(s + 1 < W ? s + 1 : W);
        float o[8];
#pragma unroll
        for (int k = 0; k < 8; ++k) o[k] = (sum[k] * inv - f[k]) * sc[k] * gt[k];
        u32x4 wv; wv.x = cvt_pk_bf16(o[0], o[1]); wv.y = cvt_pk_bf16(o[2], o[3]); wv.z = cvt_pk_bf16(o[4], o[5]); wv.w = cvt_pk_bf16(o[6], o[7]);
        *(u32x4*)(SG + (size_t)(t0 + i) * 2048 + c0) = wv;
        float fo[8]; unpack8(rows[i], fo);
#pragma unroll
        for (int k = 0; k < 8; ++k) sum[k] -= fo[k];
    }
}
__device__ __forceinline__ void phase_pool(const bf16_t* V, bf16_t* SG, const float* scale) {
    const int tid = opaque(threadIdx.x), cth = tid & 255, sub = tid >> 8;
    const int c0 = cth * 8, grp = c0 >> 9;
    float sc[8];
    { const f32x4 a = *(const f32x4*)(scale + c0), b = *(const f32x4*)(scale + c0 + 4); sc[0] = a[0]; sc[1] = a[1]; sc[2] = a[2]; sc[3] = a[3]; sc[4] = b[0]; sc[5] = b[1]; sc[6] = b[2]; sc[7] = b[3]; }
    const int qper = (MT / 4) / (int)gridDim.x;
#pragma unroll 1
    for (int qi = sub; qi < qper; qi += 2) {
        const int q = blockIdx.x * qper + qi;
        const int t0 = q * 4;
        if (grp == 0) pool_item<2>(V, SG, sc, t0, c0);
        else if (grp == 1) pool_item<4>(V, SG, sc, t0, c0);
        else if (grp == 2) pool_item<8>(V, SG, sc, t0, c0);
        else pool_item<16>(V, SG, sc, t0, c0);
    }
}

template <int V_> struct AttIC { static constexpr int value = V_; };
struct AttGeo { int dsh, dil, L, nblk, g; };
__device__ __forceinline__ void att_decode(const AttGeo& G_, int it, int& hh, int& b, int& r, int& n) { n = it & (G_.nblk - 1); const int y = it >> (5 - G_.dsh); r = y & (G_.dil - 1); const int z = y >> G_.dsh; b = z & 3; hh = z >> 2; }
__device__ __forceinline__ void att_dma_half(const AttGeo& G_, const bf16_t* Kr, const bf16_t* Vt, int it, int which, int slot, LAS unsigned char* lds, int wid, int lane0) {
    int hh, b, r, n; att_decode(G_, it, hh, b, r, n);
    const int lane = opaque(lane0);
    int blk = n - 1 + which; blk = blk < 0 ? 0 : blk;
    const bf16_t* kb = Kr + ((size_t)(((G_.g * 16 + hh) * 4 + b) * SEQ + r * G_.L + blk * 128)) * 64;
    const bf16_t* vb = Vt + (size_t)(G_.g * 1024 + hh * 64) * MT + b * SEQ + r * G_.L + blk * 128;
    LAS unsigned char* kl = lds + slot * 32768; LAS unsigned char* vl = kl + 16384;
#pragma unroll
    for (int rd = 0; rd < 2; ++rd) { const int ch = rd * 8 + wid; const int rho = ch * 8 + (lane >> 3); const int cs = (lane & 7) ^ ((rho >> 1) & 7);
        __builtin_amdgcn_global_load_lds((const unsigned*)(kb + (size_t)rho * 64 + cs * 8), (LAS unsigned*)(kl + ch * 1024), 16, 0, 0); }
#pragma unroll
    for (int rd = 0; rd < 2; ++rd) { const int ch = rd * 8 + wid; const int d = ch * 4 + (lane >> 4); const int cs = (lane & 15) ^ (d & 15);
        __builtin_amdgcn_global_load_lds((const unsigned*)(vb + (size_t)d * MT + cs * 8), (LAS unsigned*)(vl + ch * 1024), 16, 0, 0); }
}
__device__ __forceinline__ int att_first_item() { return ((blockIdx.x & 7) * 32 + (blockIdx.x >> 3)) * 8; }
__device__ __forceinline__ void attn_issue_first(const bf16_t* Kr, const bf16_t* Vt, int g, LAS unsigned char* lds) {
    const int tid = opaque(threadIdx.x), wid = __builtin_amdgcn_readfirstlane(tid >> 6), lane0 = tid & 63;
    AttGeo G_; G_.g = g; G_.dsh = 2 * g; G_.dil = 1 << G_.dsh; G_.L = SEQ >> G_.dsh; G_.nblk = G_.L >> 7;
    const int it = att_first_item();
    att_dma_half(G_, Kr, Vt, it, 0, 3, lds, wid, lane0);
    att_dma_half(G_, Kr, Vt, it, 1, 0, lds, wid, lane0);
}
template <bool PRE>
__device__ __forceinline__ void phase_attn(const bf16_t* Q, const bf16_t* Kr, const bf16_t* Vt, bf16_t* ACC, float* LSE, int g, LAS unsigned char* lds) {
    const int tid = opaque(threadIdx.x), wid = __builtin_amdgcn_readfirstlane(tid >> 6), lane0 = tid & 63, q0 = lane0 & 15, q40 = lane0 >> 4;
    AttGeo G_; G_.g = g; G_.dsh = 2 * g; G_.dil = 1 << G_.dsh; G_.L = SEQ >> G_.dsh; G_.nblk = G_.L >> 7;
    const int dsh = G_.dsh, dil = G_.dil;
    const int it0 = att_first_item();
    bf16x8 qf[2]; u32x2 oldacc[4]; float oldlse = 0.f; int tq = 0, hh = 0, n = 0;
    {
        if constexpr (!PRE) { att_dma_half(G_, Kr, Vt, it0, 0, 3, lds, wid, lane0); att_dma_half(G_, Kr, Vt, it0, 1, 0, lds, wid, lane0); }
        int b, r; att_decode(G_, it0, hh, b, r, n);
        tq = b * SEQ + ((n * 128 + wid * 16 + q0) << dsh) + r;
#pragma unroll
        for (int ks = 0; ks < 2; ++ks) qf[ks] = *(const bf16x8*)(Q + (size_t)tq * 1024 + hh * 64 + ks * 32 + q40 * 8);
        if (g > 0) { oldlse = LSE[(size_t)hh * MT + tq];
#pragma unroll
            for (int dt = 0; dt < 4; ++dt) oldacc[dt] = *(const u32x2*)(ACC + (size_t)tq * 1024 + hh * 64 + q40 * 4 + dt * 16); }
    }
    u32x2 pend[4]; float pend_lse = 0.f; int pend_tq = 0, pend_hh = 0; bool have_pend = false;
    auto item_body = [&](auto kkc, int k) __attribute__((always_inline)) {
        constexpr int KK = decltype(kkc)::value;
        constexpr int SC = KK, SP = (KK + 3) & 3, SN = (KK + 1) & 3;
        asm volatile("s_waitcnt vmcnt(0)" ::: "memory");
        __builtin_amdgcn_s_barrier();
        asm volatile("" ::: "memory");
        asm volatile("" : "+v"(qf[0]), "+v"(qf[1]), "+v"(oldacc[0]), "+v"(oldacc[1]), "+v"(oldacc[2]), "+v"(oldacc[3]), "+v"(oldlse));
        if (have_pend) {
            bf16_t* pp = ACC + (size_t)pend_tq * 1024 + pend_hh * 64 + q40 * 4;
#pragma unroll
            for (int dt = 0; dt < 4; ++dt) *(u32x2*)(pp + dt * 16) = pend[dt];
            if (q40 == 0) LSE[(size_t)pend_hh * MT + pend_tq] = pend_lse;
        }
        const int q = opaque(q0), q4 = opaque(q40);
        bf16x8 qn[2]; u32x2 oldn[4]; float oldlsen = 0.f; int tqn = 0, hhn = 0, nn = 0;
        if (k + 1 < 8) {
            const int itn = it0 + k + 1;
            att_dma_half(G_, Kr, Vt, itn, 1, SN, lds, wid, lane0);
            int b, r; att_decode(G_, itn, hhn, b, r, nn);
            tqn = b * SEQ + ((nn * 128 + wid * 16 + q) << dsh) + r;
#pragma unroll
            for (int ks = 0; ks < 2; ++ks) qn[ks] = *(const bf16x8*)(Q + (size_t)tqn * 1024 + hhn * 64 + ks * 32 + q4 * 8);
            if (g > 0) { oldlsen = LSE[(size_t)hhn * MT + tqn];
#pragma unroll
                for (int dt = 0; dt < 4; ++dt) oldn[dt] = *(const u32x2*)(ACC + (size_t)tqn * 1024 + hhn * 64 + q4 * 4 + dt * 16); }
        }
        const float slope = __builtin_amdgcn_exp2f(-8.0f * (float)(g * 16 + hh + 1) / 48.0f);
        const float bias2 = slope * (float)dil * LOG2E;
        f32x4 sacc[9];
        {
            bf16x8 kf[9][2];
#pragma unroll
            for (int kt = 0; kt < 9; ++kt) { const int t16 = wid + kt; const int rl = (t16 & 7) * 16 + q, sw = (rl >> 1) & 7;
                const LAS unsigned char* kb_ = (t16 >= 8) ? (lds + SC * 32768) : (lds + SP * 32768);
                kf[kt][0] = *(const LAS bf16x8*)(kb_ + rl * 128 + ((q4 ^ sw) * 16));
                kf[kt][1] = *(const LAS bf16x8*)(kb_ + rl * 128 + (((4 + q4) ^ sw) * 16)); }
            asm volatile("" : "+v"(kf[0][0]), "+v"(kf[0][1]), "+v"(kf[1][0]), "+v"(kf[1][1]), "+v"(kf[2][0]), "+v"(kf[2][1]), "+v"(kf[3][0]), "+v"(kf[3][1]), "+v"(kf[4][0]), "+v"(kf[4][1]));
            asm volatile("" : "+v"(kf[5][0]), "+v"(kf[5][1]), "+v"(kf[6][0]), "+v"(kf[6][1]), "+v"(kf[7][0]), "+v"(kf[7][1]), "+v"(kf[8][0]), "+v"(kf[8][1]));
#pragma unroll
            for (int kt = 0; kt < 9; ++kt) { f32x4 a = (f32x4){0.f, 0.f, 0.f, 0.f};
                a = __builtin_amdgcn_mfma_f32_16x16x32_bf16(kf[kt][0], qf[0], a, 0, 0, 0);
                sacc[kt] = a; }
#pragma unroll
            for (int kt = 0; kt < 9; ++kt) sacc[kt] = __builtin_amdgcn_mfma_f32_16x16x32_bf16(kf[kt][1], qf[1], sacc[kt], 0, 0, 0);
        }
        const float relb = (float)(128 + q - q4 * 4);
        const float a0 = -bias2 * relb;
        float mx = -1e30f;
#pragma unroll
        for (int kt = 0; kt < 9; ++kt)
#pragma unroll
            for (int jj = 0; jj < 4; ++jj) {
                float s = __builtin_fmaf(sacc[kt][jj], 0.125f * LOG2E, __builtin_fmaf(bias2, (float)(kt * 16 + jj), a0));
                if (kt == 0) { if (q4 * 4 + jj < q) s = -1e30f; }
                if (kt == 8) { if (q4 * 4 + jj > q) s = -1e30f; }
                sacc[kt][jj] = s; }
        if (n == 0) {
#pragma unroll
            for (int kt = 0; kt < 8; ++kt)
#pragma unroll
                for (int jj = 0; jj < 4; ++jj) if (wid * 16 + kt * 16 + q4 * 4 + jj < 128) sacc[kt][jj] = -1e30f;
        }
#pragma unroll
        for (int kt = 0; kt < 9; ++kt)
#pragma unroll
            for (int jj = 0; jj < 4; ++jj) mx = fmaxf(mx, sacc[kt][jj]);
        mx = fmaxf(mx, __shfl_xor(mx, 16)); mx = fmaxf(mx, __shfl_xor(mx, 32));
        float lsum = 0.f;
#pragma unroll
        for (int kt = 0; kt < 9; ++kt)
#pragma unroll
            for (int jj = 0; jj < 4; ++jj) { const float pv = __builtin_amdgcn_exp2f(sacc[kt][jj] - mx); sacc[kt][jj] = pv; lsum += pv; }
        lsum += __shfl_xor(lsum, 16); lsum += __shfl_xor(lsum, 32);
        f32x4 oacc[4];
#pragma unroll
        for (int dt = 0; dt < 4; ++dt) oacc[dt] = (f32x4){0.f, 0.f, 0.f, 0.f};
#pragma unroll
        for (int kp2 = 0; kp2 < 5; ++kp2) {
            u32x4 pw; pw.x = cvt_pk_bf16(sacc[2 * kp2][0], sacc[2 * kp2][1]); pw.y = cvt_pk_bf16(sacc[2 * kp2][2], sacc[2 * kp2][3]);
            if (kp2 < 4) { pw.z = cvt_pk_bf16(sacc[kp2 < 4 ? 2 * kp2 + 1 : 8][0], sacc[kp2 < 4 ? 2 * kp2 + 1 : 8][1]); pw.w = cvt_pk_bf16(sacc[kp2 < 4 ? 2 * kp2 + 1 : 8][2], sacc[kp2 < 4 ? 2 * kp2 + 1 : 8][3]); }
            else { pw.z = 0u; pw.w = 0u; }
            bf16x8 pf; __builtin_memcpy(&pf, &pw, 16);
            const int chb = 2 * wid + 4 * kp2;
            const LAS unsigned char* v0b = ((chb >> 4) ? (lds + SC * 32768) : (lds + SP * 32768)) + 16384;
            const LAS unsigned char* v1b = (((chb + 2) >> 4) ? (lds + SC * 32768) : (lds + SP * 32768)) + 16384;
            const int c0 = (chb & 15) + (q4 >> 1), c1 = ((chb + 2) & 15) + (q4 >> 1);
#pragma unroll
            for (int dt = 0; dt < 4; ++dt) {
                const int d = dt * 16 + q;
                const int roff = d * 256 + (q4 & 1) * 8;
                u32x4 vw; const u32x2 lo = *(const LAS u32x2*)(v0b + roff + ((c0 ^ q) * 16)); vw.x = lo.x; vw.y = lo.y;
                if (kp2 < 4) { const u32x2 hi = *(const LAS u32x2*)(v1b + roff + ((c1 ^ q) * 16)); vw.z = hi.x; vw.w = hi.y; } else { vw.z = 0u; vw.w = 0u; }
                bf16x8 vf; __builtin_memcpy(&vf, &vw, 16);
                oacc[dt] = __builtin_amdgcn_mfma_f32_16x16x32_bf16(vf, pf, oacc[dt], 0, 0, 0);
            }
            __builtin_amdgcn_sched_barrier(0);
        }
        const float inv = 1.0f / lsum;
        float lse = (mx + __log2f(lsum)) * LN2;
        float w_new = inv, w_old = 0.f;
        if (g > 0) {
            const float mm = fmaxf(oldlse, lse), e0 = __expf(oldlse - mm), e1 = __expf(lse - mm), tot = e0 + e1;
            w_old = e0 / tot; w_new = inv * (e1 / tot); lse = mm + __logf(tot);
        }
#pragma unroll
        for (int dt = 0; dt < 4; ++dt) {
            f32x4 o = oacc[dt] * w_new;
            if (g > 0) { const u32x2 pr = oldacc[dt]; o[0] += w_old * bf_lo(pr.x); o[1] += w_old * bf_hi(pr.x); o[2] += w_old * bf_lo(pr.y); o[3] += w_old * bf_hi(pr.y); }
            u32x2 w; w.x = cvt_pk_bf16(o[0], o[1]); w.y = cvt_pk_bf16(o[2], o[3]);
            pend[dt] = w;
        }
        pend_lse = lse; pend_tq = tq; pend_hh = hh; have_pend = true;
        qf[0] = qn[0]; qf[1] = qn[1]; oldlse = oldlsen; tq = tqn; hh = hhn; n = nn;
#pragma unroll
        for (int dt = 0; dt < 4; ++dt) oldacc[dt] = oldn[dt];
    };
#pragma unroll 1
    for (int kq = 0; kq < 2; ++kq) { item_body(AttIC<0>{}, 4 * kq); item_body(AttIC<1>{}, 4 * kq + 1); item_body(AttIC<2>{}, 4 * kq + 2); item_body(AttIC<3>{}, 4 * kq + 3); }
    if (have_pend) {
        bf16_t* pp = ACC + (size_t)pend_tq * 1024 + pend_hh * 64 + q40 * 4;
#pragma unroll
        for (int dt = 0; dt < 4; ++dt) *(u32x2*)(pp + dt * 16) = pend[dt];
        if (q40 == 0) LSE[(size_t)pend_hh * MT + pend_tq] = pend_lse;
    }
    asm volatile("s_waitcnt vmcnt(0)" ::: "memory");
    __builtin_amdgcn_s_barrier();
}

__global__ void __launch_bounds__(512, 2) yoco_fwd(Params p) {
    extern __shared__ __attribute__((aligned(16))) unsigned char smem[];
    LAS unsigned char* lds = (LAS unsigned char*)smem;
    cg::grid_group grid = cg::this_grid();
    volatile LAS unsigned* xst = (volatile LAS unsigned*)(lds + 131072);
    if (threadIdx.x < 4) xst[threadIdx.x] = 0u;
    __syncthreads();
    const XcdBarrier xb = xcd_barrier_post((unsigned*)(p.ws + OFF_BAR), xst);
    if (p.ws == nullptr) grid.sync();
    unsigned char* ws = p.ws;
    const int G = gridDim.x, c = blockIdx.x;
    bf16_t* HB = (bf16_t*)(ws + OFF_HB);

    phase_prep(p, lds);
    xcd_barrier(xb);
    { SingleUnit S; S.has = c < 64; const int lg = c >> 3, un = c & 7; S.u0.pm = un >> 2; S.u0.pn = un & 3;
      Gemm gm; gm.A = (const bf16_t*)(ws + OFF_WGT) + (size_t)lg * 512 * 512; gm.Bt = (const bf16_t*)(ws + OFF_WINU) + (size_t)lg * 1024 * 512; gm.M = 512; gm.N = 1024; gm.K = 512;
      EpiStore16<true> E; E.O = (bf16_t*)(ws + OFF_BTA) + (size_t)(lg >> 2) * 4096 * 1024 + (size_t)(lg & 3) * 512 * 1024; E.ldc = 1024;
      gemm_phase<EpiStore16<true>, SingleUnit, 0, true>(lds, gm, S, E); }
    xcd_barrier(xb);
    for (int l = 0; l < 2; ++l) {
        { StaticOrder S; S.init(MT, 4096, G, c); Gemm gm; gm.A = HB; gm.Bt = (const bf16_t*)(ws + OFF_BTA) + (size_t)l * 4096 * 1024; gm.M = MT; gm.N = 4096; gm.K = 1024;
          EpiAG1 E; E.V = (bf16_t*)(ws + OFF_V); E.SG = (bf16_t*)(ws + OFF_SG); gemm_phase<EpiAG1, StaticOrder, 0, true>(lds, gm, S, E); }
        xcd_barrier(xb);
        phase_pool((const bf16_t*)(ws + OFF_V), (bf16_t*)(ws + OFF_SG), p.scale_a + l * 2048);
        xcd_barrier(xb);
        { StaticOrder S; S.init(MT, 1024, G, c); Gemm gm; gm.A = (const bf16_t*)(ws + OFF_SG); gm.Bt = (const bf16_t*)(ws + OFF_WOA) + (size_t)l * 1024 * 2048; gm.M = MT; gm.N = 1024; gm.K = 2048;
          if (l == 0) { EpiLnFused<false, false, true, true> E; E.hin_f = nullptr; E.hin_b = HB; E.out_f = nullptr; E.out_b = HB; E.gam = p.ln_g; E.bet = p.ln_b;
              E.xbuf = (unsigned long long*)(ws + OFF_XBUF); E.cnt = (unsigned*)(ws + OFF_CNT); E.want = 32u; gemm_phase(lds, gm, S, E); }
          else { EpiLnFused<false, false, true, true> E; E.hin_f = nullptr; E.hin_b = HB; E.out_f = nullptr; E.out_b = HB; E.gam = p.ln_g + DM; E.bet = p.ln_b + DM;
              E.xbuf = (unsigned long long*)(ws + OFF_XBUF); E.cnt = (unsigned*)(ws + OFF_CNT); E.want = 64u; gemm_phase(lds, gm, S, E); } }
        xcd_barrier(xb);
    }
    { StaticOrder S; S.init(MT, 3072, G, c); Gemm gm; gm.A = HB; gm.Bt = (const bf16_t*)(ws + OFF_KVT); gm.M = MT; gm.N = 3072; gm.K = 1024;
      EpiKr E; E.Kr = (bf16_t*)(ws + OFF_K); gemm_phase<EpiKr, StaticOrder, 0, true>(lds, gm, S, E); }
    { StaticOrder S; S.init(1024, MT, G, c); Gemm gm; gm.Bt = HB; gm.M = 1024; gm.N = MT; gm.K = 1024;
      gm.A = (const bf16_t*)(ws + OFF_KVT) + (size_t)(3072 + 0) * 1024;    { EpiVt<0> E; E.Vt = (bf16_t*)(ws + OFF_VT) + (size_t)0 * MT;    gemm_phase<EpiVt<0>, StaticOrder, 0, true>(lds, gm, S, E); }
      gm.A = (const bf16_t*)(ws + OFF_KVT) + (size_t)(3072 + 1024) * 1024; { EpiVt<2> E; E.Vt = (bf16_t*)(ws + OFF_VT) + (size_t)1024 * MT; gemm_phase<EpiVt<2>, StaticOrder, 2, true>(lds, gm, S, E); }
      gm.A = (const bf16_t*)(ws + OFF_KVT) + (size_t)(3072 + 2048) * 1024; { EpiVt<4> E; E.Vt = (bf16_t*)(ws + OFF_VT) + (size_t)2048 * MT; gemm_phase<EpiVt<4>, StaticOrder, 4, true>(lds, gm, S, E); } }
    bf16_t* QG = (bf16_t*)p.out; bf16_t* QY = (bf16_t*)p.out + (size_t)MT * DM; bf16_t* ACC = QG; float* LSE = (float*)(ws + OFF_LSE);
    for (int j = 0; j < 2; ++j) {
        const bf16_t* inb = (const bf16_t*)(ws + OFF_INB) + (size_t)j * 4096 * 1024;
        { StaticOrder S; S.init(MT, 2048, G, c); Gemm gm; gm.A = HB; gm.Bt = inb; gm.M = MT; gm.N = 2048; gm.K = 1024;
          EpiStoreSplit E; E.O0 = QG; E.O1 = QY; gemm_phase<EpiStoreSplit, StaticOrder, 0, true>(lds, gm, S, E); }
        if (j != 0) attn_issue_first((const bf16_t*)(ws + OFF_K), (const bf16_t*)(ws + OFF_VT), 0, lds);
        xcd_barrier(xb);
        if (j == 0) { tp_job(p.w_out_b, (size_t)1024 * 1024, 1024, 0, (bf16_t*)(ws + OFF_OUTB), (size_t)1024 * 1024, 1024, 1024, 1024, 2, (LAS float*)lds);
                      phase_attn<false>(QG, (const bf16_t*)(ws + OFF_K), (const bf16_t*)(ws + OFF_VT), QG, LSE, 0, lds); }
        else phase_attn<true>(QG, (const bf16_t*)(ws + OFF_K), (const bf16_t*)(ws + OFF_VT), QG, LSE, 0, lds);
        attn_issue_first((const bf16_t*)(ws + OFF_K), (const bf16_t*)(ws + OFF_VT), 1, lds);
        xcd_barrier(xb);
        phase_attn<true>(QY, (const bf16_t*)(ws + OFF_K), (const bf16_t*)(ws + OFF_VT), QG, LSE, 1, lds);
        xcd_barrier(xb);
        { StaticOrder S; S.init(MT, 1024, G, c); Gemm gm; gm.A = HB; gm.Bt = inb + (size_t)2 * 1024 * 1024; gm.M = MT; gm.N = 1024; gm.K = 1024;
          EpiStore16<false> E; E.O = QY; E.ldc = 1024; gemm_phase<EpiStore16<false>, StaticOrder, 0, true>(lds, gm, S, E); }
        attn_issue_first((const bf16_t*)(ws + OFF_K), (const bf16_t*)(ws + OFF_VT), 2, lds);
        xcd_barrier(xb);
        phase_attn<true>(QY, (const bf16_t*)(ws + OFF_K), (const bf16_t*)(ws + OFF_VT), QG, LSE, 2, lds);
        xcd_barrier(xb);
        bf16_t* ZB = j == 0 ? ACC : (bf16_t*)(ws + OFF_K);
        { StaticOrder S; S.init(MT, 1024, G, c); Gemm gm; gm.A = HB; gm.Bt = inb + (size_t)3 * 1024 * 1024; gm.M = MT; gm.N = 1024; gm.K = 1024;
          EpiGateMul E; E.Zin = ACC; E.Zout = ZB; gemm_phase<EpiGateMul, StaticOrder, 0, true>(lds, gm, S, E); }
        xcd_barrier(xb);
        { StaticOrder S; S.init(MT, 1024, G, c); Gemm gm; gm.A = ZB; gm.Bt = (const bf16_t*)(ws + OFF_OUTB) + (size_t)j * 1024 * 1024; gm.M = MT; gm.N = 1024; gm.K = 1024;
          if (j == 0) { EpiLnFused<false, false, true, true> E; E.hin_f = nullptr; E.hin_b = HB; E.out_f = nullptr; E.out_b = HB; E.gam = p.ln_g + 2 * DM; E.bet = p.ln_b + 2 * DM;
              E.xbuf = (unsigned long long*)(ws + OFF_XBUF); E.cnt = (unsigned*)(ws + OFF_CNT); E.want = 96u; gemm_phase(lds, gm, S, E); }
          else { EpiLnFused<false, true, false, true> E; E.hin_f = nullptr; E.hin_b = HB; E.out_f = p.out; E.out_b = nullptr; E.gam = p.ln_g + 3 * DM; E.bet = p.ln_b + 3 * DM;
              E.xbuf = (unsigned long long*)(ws + OFF_XBUF); E.cnt = (unsigned*)(ws + OFF_CNT); E.want = 128u; gemm_phase(lds, gm, S, E); } }
        if (j == 0) xcd_barrier(xb);
    }
}

extern "C" void kernel_launch(void* const* d_in, const int* in_sizes, int n_in, void* d_out, int out_size, void* d_ws, size_t ws_size, hipStream_t stream) {
    static int grid = 0;
    if (grid == 0) {
        if (n_in != 10 || out_size != MT * DM || ws_size < WS_NEED) { fprintf(stderr, "kernel_launch: unexpected shapes / workspace (n_in %d out %d ws %zu)\n", n_in, out_size, ws_size); grid = -1; return; }
        int dev = 0, cus = 0, per_cu = 0;
        hipGetDevice(&dev);
        hipDeviceGetAttribute(&cus, hipDeviceAttributeMultiprocessorCount, dev);
        hipFuncSetAttribute((const void*)yoco_fwd, hipFuncAttributeMaxDynamicSharedMemorySize, LDS_BYTES);
        hipOccupancyMaxActiveBlocksPerMultiprocessor(&per_cu, (const void*)yoco_fwd, 512, LDS_BYTES);
        if (per_cu < 1) per_cu = 1;
        (void)hipGetLastError();
        grid = cus;
    }
    if (grid < 0) return;
    Params p{};
    p.x = (const float*)d_in[0]; p.w_in_a = (const float*)d_in[1]; p.w_grp_a = (const float*)d_in[2]; p.scale_a = (const float*)d_in[3]; p.w_out_a = (const float*)d_in[4];
    p.w_kv = (const float*)d_in[5]; p.w_in_b = (const float*)d_in[6]; p.w_out_b = (const float*)d_in[7]; p.ln_g = (const float*)d_in[8]; p.ln_b = (const float*)d_in[9];
    p.out = (float*)d_out; p.ws = (unsigned char*)d_ws;
    if (hipMemsetAsync((unsigned char*)d_ws + OFF_BAR, 0, 32768, stream) != hipSuccess) { fprintf(stderr, "memset failed\n"); return; }
    void* args[] = {&p};
    hipError_t e = hipLaunchCooperativeKernel((const void*)yoco_fwd, dim3(grid), dim3(512), args, LDS_BYTES, stream);
    if (e != hipSuccess) fprintf(stderr, "cooperative launch failed: %s (grid %d)\n", hipGetErrorString(e), grid);
}
```

```cpp
#include <hip/hip_runtime.h>
#include <hip/hip_cooperative_groups.h>
#include <cstdio>
namespace cg = cooperative_groups;

#define LAS __attribute__((address_space(3)))
typedef unsigned short bf16_t;
typedef short bf16x8 __attribute__((ext_vector_type(8)));
typedef short bf16x4 __attribute__((ext_vector_type(4)));
typedef float f32x4 __attribute__((ext_vector_type(4)));
typedef float f32x2 __attribute__((ext_vector_type(2)));
typedef unsigned u32x4 __attribute__((ext_vector_type(4)));
typedef unsigned u32x2 __attribute__((ext_vector_type(2)));

constexpr int MT = 16384, DM = 1024, SEQ = 4096;
constexpr int BM = 256, BK = 64, HALF = 128, HTB = HALF * BK * 2, STAGE_BYTES = 8 * HTB, NXCD = 8, WGM = 4;
constexpr int LDS_BYTES = 131072 + 1024;
constexpr float DN_ALPHA = 1.681792830507429f;
constexpr float LN_EPS = 1e-5f;
constexpr float LOG2E = 1.4426950408889634f, LN2 = 0.6931471805599453f;
constexpr size_t MiB = 1024 * 1024;
constexpr size_t OFF_V = 0, OFF_SG = 64 * MiB, OFF_BTA = 128 * MiB, OFF_WOA = 144 * MiB, OFF_WGT = 152 * MiB, OFF_WINU = 156 * MiB;
constexpr size_t OFF_KVT = 192 * MiB, OFF_INB = 204 * MiB, OFF_BAR = 220 * MiB, OFF_HB = 224 * MiB;
constexpr size_t OFF_CNT = OFF_BAR + 16384, OFF_XBUF = OFF_BAR + 32768;
constexpr size_t OFF_OUTB = 193 * MiB;
constexpr size_t OFF_K = 0, OFF_VT = 96 * MiB, OFF_LSE = 192 * MiB;
constexpr size_t WS_NEED = 256 * MiB;

typedef __bf16 bf16x2_t __attribute__((ext_vector_type(2)));
__device__ __forceinline__ unsigned cvt_pk_bf16(float lo, float hi) { const f32x2 v = {lo, hi}; const bf16x2_t b = __builtin_convertvector(v, bf16x2_t); return __builtin_bit_cast(unsigned, b); }
__device__ __forceinline__ float bf_lo(unsigned w) { return __uint_as_float(w << 16); }
__device__ __forceinline__ float bf_hi(unsigned w) { return __uint_as_float(w & 0xffff0000u); }
typedef _Float16 half8 __attribute__((ext_vector_type(8)));
__device__ __forceinline__ unsigned cvt_pk_f16(float lo, float hi) { const _Float16 a = (_Float16)lo, b = (_Float16)hi; return (unsigned)__builtin_bit_cast(unsigned short, a) | ((unsigned)__builtin_bit_cast(unsigned short, b) << 16); }
__device__ __forceinline__ float h_lo(unsigned w) { return (float)__builtin_bit_cast(_Float16, (unsigned short)(w & 0xffffu)); }
__device__ __forceinline__ float h_hi(unsigned w) { return (float)__builtin_bit_cast(_Float16, (unsigned short)(w >> 16)); }
template <bool F16> __device__ __forceinline__ unsigned cvt_pk16(float lo, float hi) { if constexpr (F16) return cvt_pk_f16(lo, hi); else return cvt_pk_bf16(lo, hi); }
__device__ __forceinline__ int opaque(int x) { asm volatile("" : "+v"(x)); return x; }
__device__ __forceinline__ float silu_f(float x) { return x * __builtin_amdgcn_rcpf(1.0f + __builtin_amdgcn_exp2f(-x * LOG2E)); }

__host__ __device__ __forceinline__ int lds_byte(int r, int c) { const int st = (r >> 4) * 2 + (c >> 5), rr = r & 15, cc = c & 31, ob = rr * 64 + cc * 2; return st * 1024 + (ob ^ (((ob >> 9) & 1) << 5)); }
__host__ __device__ __forceinline__ void stage_rc(int b, int& R, int& C) { const int st = b / 1024, sb = b % 1024, swz = sb ^ (((sb >> 9) & 1) << 5); R = (st >> 1) * 16 + swz / 64; C = (st & 1) * 32 + (swz % 64) / 2; }
__host__ __device__ __forceinline__ int perm32(int rho) { const int n = rho >> 4, i = rho & 15; return 8 * (i >> 2) + 4 * n + (i & 3); }

__device__ __forceinline__ size_t hm_idx(int t, int c) { return ((size_t)(c >> 6) * MT + t) * 64 + (c & 63); }
struct Unit { int pm, pn; };
struct Gemm { const bf16_t* A; const bf16_t* Bt; int M, N, K; };

struct StaticOrder {
    int nM, nN, nwg, G, c;
    __device__ void init(int M, int N, int G_, int c_) { nM = M / BM; nN = N / BM; nwg = nM * nN; G = G_; c = c_; }
    __device__ bool next(int i, Unit& u) const {
        const long L = (long)i * G + c; if (L >= nwg) return false;
        int wgid = (int)L; { const int q = nwg / NXCD, r = nwg % NXCD, xcd = wgid % NXCD, off = wgid / NXCD; wgid = (xcd < r ? xcd * (q + 1) : r * (q + 1) + (xcd - r) * q) + off; }
        const int nig = WGM * nN, gid = wgid / nig, fm = gid * WGM, gsz = (nM - fm) < WGM ? (nM - fm) : WGM;
        u.pm = fm + ((wgid % nig) % gsz); u.pn = (wgid % nig) / gsz; return true;
    }
};
struct SingleUnit {
    bool has; Unit u0;
    __device__ bool next(int i, Unit& u) const { if (i == 0 && has) { u = u0; return true; } return false; }
};

template <bool F16 = false, bool QS = false> struct EpiStore16 {
    static constexpr bool PERM = true, AFTER_DRAIN = false;
    bf16_t* O; int ldc;
    __device__ __forceinline__ void operator()(const f32x4 (&acc)[2][2][4][2], const Unit& u, int wr, int wc, int fr, int fq) const {
        const int row0 = u.pm * BM + wr * 64 + fr, col0 = u.pn * BM + wc * 32 + 8 * fq;
#pragma unroll
        for (int ai = 0; ai < 2; ++ai)
#pragma unroll
            for (int m = 0; m < 4; ++m) { bf16_t* rowp = O + (size_t)(row0 + ai * HALF + m * 16) * ldc + col0;
#pragma unroll
                for (int bj = 0; bj < 2; ++bj) { const f32x4 v0 = acc[ai][bj][m][0], v1 = acc[ai][bj][m][1];
                    u32x4 w; w.x = cvt_pk16<F16>(v0[0], v0[1]); w.y = cvt_pk16<F16>(v0[2], v0[3]); w.z = cvt_pk16<F16>(v1[0], v1[1]); w.w = cvt_pk16<F16>(v1[2], v1[3]);
                    if constexpr (QS) *(u32x4*)(O + hm_idx(row0 + ai * HALF + m * 16, col0 + bj * HALF)) = w;
                    else *(u32x4*)(rowp + bj * HALF) = w; } }
    }
};
struct EpiStoreSplit {
    static constexpr bool PERM = true, AFTER_DRAIN = false;
    bf16_t* O0; bf16_t* O1;
    __device__ __forceinline__ void operator()(const f32x4 (&acc)[2][2][4][2], const Unit& u, int wr, int wc, int fr, int fq) const {
        const int row0 = u.pm * BM + wr * 64 + fr, col0 = (u.pn & 3) * BM + wc * 32 + 8 * fq;
        bf16_t* base = u.pn >= 4 ? O1 : O0;
#pragma unroll
        for (int ai = 0; ai < 2; ++ai)
#pragma unroll
            for (int m = 0; m < 4; ++m) { bf16_t* rowp = base + (size_t)(row0 + ai * HALF + m * 16) * 1024 + col0;
#pragma unroll
                for (int bj = 0; bj < 2; ++bj) { const f32x4 v0 = acc[ai][bj][m][0], v1 = acc[ai][bj][m][1];
                    u32x4 w; w.x = cvt_pk_bf16(v0[0], v0[1]); w.y = cvt_pk_bf16(v0[2], v0[3]); w.z = cvt_pk_bf16(v1[0], v1[1]); w.w = cvt_pk_bf16(v1[2], v1[3]);
                    *(u32x4*)(base + hm_idx(row0 + ai * HALF + m * 16, col0 + bj * HALF)) = w; (void)rowp; } }
    }
};
struct EpiAG1 {
    static constexpr bool PERM = true, AFTER_DRAIN = false;
    bf16_t* V; bf16_t* SG;
    __device__ __forceinline__ void operator()(const f32x4 (&acc)[2][2][4][2], const Unit& u, int wr, int wc, int fr, int fq) const {
        const bool isg = u.pn >= 8;
        const int row0 = u.pm * BM + wr * 64 + fr, col0 = (isg ? u.pn - 8 : u.pn) * BM + wc * 32 + 8 * fq;
        bf16_t* base = isg ? SG : V;
#pragma unroll
        for (int ai = 0; ai < 2; ++ai)
#pragma unroll
            for (int m = 0; m < 4; ++m) { bf16_t* rowp = base + (size_t)(row0 + ai * HALF + m * 16) * 2048 + col0;
#pragma unroll
                for (int bj = 0; bj < 2; ++bj) { f32x4 v0 = acc[ai][bj][m][0], v1 = acc[ai][bj][m][1];
                    if (isg) {
#pragma unroll
                        for (int j = 0; j < 4; ++j) { v0[j] = silu_f(v0[j]); v1[j] = silu_f(v1[j]); } }
                    u32x4 w; w.x = cvt_pk_bf16(v0[0], v0[1]); w.y = cvt_pk_bf16(v0[2], v0[3]); w.z = cvt_pk_bf16(v1[0], v1[1]); w.w = cvt_pk_bf16(v1[2], v1[3]);
                    *(u32x4*)(rowp + bj * HALF) = w; } }
    }
};
struct EpiGateMul {
    static constexpr bool PERM = true, AFTER_DRAIN = false;
    const bf16_t* Zin; bf16_t* Zout;
    __device__ __forceinline__ void operator()(const f32x4 (&acc)[2][2][4][2], const Unit& u, int wr, int wc, int fr, int fq) const {
        const int row0 = u.pm * BM + wr * 64 + fr, col0 = u.pn * BM + wc * 32 + 8 * fq;
#pragma unroll
        for (int ai = 0; ai < 2; ++ai)
#pragma unroll
            for (int m = 0; m < 4; ++m) { const size_t roff = (size_t)(row0 + ai * HALF + m * 16) * DM + col0; const bf16_t* rowp = Zin + roff; bf16_t* rowo = Zout + roff;
#pragma unroll
                for (int bj = 0; bj < 2; ++bj) { const f32x4 v0 = acc[ai][bj][m][0], v1 = acc[ai][bj][m][1];
                    const u32x4 h = *(const u32x4*)(Zin + hm_idx(row0 + ai * HALF + m * 16, col0 + bj * HALF)); (void)rowp;
                    u32x4 w;
                    w.x = cvt_pk_bf16(bf_lo(h.x) * silu_f(v0[0]), bf_hi(h.x) * silu_f(v0[1]));
                    w.y = cvt_pk_bf16(bf_lo(h.y) * silu_f(v0[2]), bf_hi(h.y) * silu_f(v0[3]));
                    w.z = cvt_pk_bf16(bf_lo(h.z) * silu_f(v1[0]), bf_hi(h.z) * silu_f(v1[1]));
                    w.w = cvt_pk_bf16(bf_lo(h.w) * silu_f(v1[2]), bf_hi(h.w) * silu_f(v1[3]));
                    *(u32x4*)(rowo + bj * HALF) = w; } }
    }
};
struct EpiKr {
    static constexpr bool PERM = true, AFTER_DRAIN = false;
    bf16_t* Kr;
    __device__ __forceinline__ void operator()(const f32x4 (&acc)[2][2][4][2], const Unit& u, int wr, int wc, int fr, int fq) const {
        const int row0 = u.pm * BM + wr * 64 + fr, col0 = u.pn * BM + wc * 32 + 8 * fq;
        const int g = u.pn >> 2, dsh = 2 * g;
#pragma unroll
        for (int ai = 0; ai < 2; ++ai)
#pragma unroll
            for (int m = 0; m < 4; ++m) { const int t = row0 + ai * HALF + m * 16, b = t >> 12, s = t & 4095, r = s & ((1 << dsh) - 1), i = s >> dsh;
                const int rowidx = r * (SEQ >> dsh) + i;
#pragma unroll
                for (int bj = 0; bj < 2; ++bj) { const f32x4 v0 = acc[ai][bj][m][0], v1 = acc[ai][bj][m][1];
                    const int col = col0 + bj * HALF, hh = (col >> 6) & 15, d0 = col & 63;
                    u32x4 w; w.x = cvt_pk_bf16(v0[0], v0[1]); w.y = cvt_pk_bf16(v0[2], v0[3]); w.z = cvt_pk_bf16(v1[0], v1[1]); w.w = cvt_pk_bf16(v1[2], v1[3]);
                    *(u32x4*)(Kr + ((size_t)(((g * 16 + hh) * 4 + b) * SEQ + rowidx)) * 64 + d0) = w; } }
    }
};
template <int DSH> struct EpiVt {
    static constexpr bool PERM = true, AFTER_DRAIN = false;
    bf16_t* Vt;
    __device__ __forceinline__ void operator()(const f32x4 (&acc)[2][2][4][2], const Unit& u, int wr, int wc, int fr, int fq) const {
        const int row0 = u.pm * BM + wr * 64 + fr;
        const int t_tile = u.pn * BM, b = t_tile >> 12, s_tile = t_tile & 4095;
#pragma unroll
        for (int ai = 0; ai < 2; ++ai)
#pragma unroll
            for (int m = 0; m < 4; ++m) { bf16_t* rowp = Vt + (size_t)(row0 + ai * HALF + m * 16) * MT + b * SEQ + (s_tile >> DSH);
#pragma unroll
                for (int bj = 0; bj < 2; ++bj) { const f32x4 v0 = acc[ai][bj][m][0], v1 = acc[ai][bj][m][1];
                    const int c = bj * HALF + wc * 32 + 8 * fq, r = c >> (8 - DSH), il = c & ((256 >> DSH) - 1);
                    u32x4 w; w.x = cvt_pk_bf16(v0[0], v0[1]); w.y = cvt_pk_bf16(v0[2], v0[3]); w.z = cvt_pk_bf16(v1[0], v1[1]); w.w = cvt_pk_bf16(v1[2], v1[3]);
                    *(u32x4*)(rowp + r * (SEQ >> DSH) + il) = w; } }
    }
};

template <bool RES_F32, bool OUT_F, bool OUT_B, bool F16 = false> struct EpiLnFused {
    static constexpr bool PERM = false, AFTER_DRAIN = true;
    const float* hin_f; const bf16_t* hin_b;
    float* out_f; bf16_t* out_b;
    const float* gam; const float* bet;
    unsigned long long* xbuf; unsigned* cnt; unsigned want;
    __device__ __forceinline__ void fused(f32x4 (&acc)[2][2][4][2], const Unit& u, int wr, int wc, int fr, int fq, LAS unsigned char* lds, int wid, int lane) const {
        LAS f32x2* P = (LAS f32x2*)lds;
        LAS f32x2* S = (LAS f32x2*)(lds + 8192);
        const int col0 = u.pn * BM + wc * 32 + 4 * fq;
#pragma unroll
        for (int ai = 0; ai < 2; ++ai)
#pragma unroll
            for (int mp = 0; mp < 2; ++mp) {
                f32x4 hb_[2][2][2];
#pragma unroll
                for (int mi = 0; mi < 2; ++mi) { const int m = mp * 2 + mi; const unsigned off = (unsigned)(u.pm * BM + ai * HALF + wr * 64 + m * 16 + fr) * DM + col0;
#pragma unroll
                    for (int bj = 0; bj < 2; ++bj)
#pragma unroll
                        for (int n = 0; n < 2; ++n) {
                            if constexpr (RES_F32) hb_[mi][bj][n] = *(const f32x4*)(hin_f + off + bj * HALF + n * 16);
                            else { const u32x2 w = *(const u32x2*)(hin_b + off + bj * HALF + n * 16); hb_[mi][bj][n] = (f32x4){__uint_as_float(w.x), __uint_as_float(w.y), 0.f, 0.f}; } } }
                asm volatile("" : "+v"(hb_[0][0][0]), "+v"(hb_[0][0][1]), "+v"(hb_[0][1][0]), "+v"(hb_[0][1][1]), "+v"(hb_[1][0][0]), "+v"(hb_[1][0][1]), "+v"(hb_[1][1][0]), "+v"(hb_[1][1][1]));
#pragma unroll
                for (int mi = 0; mi < 2; ++mi) { const int m = mp * 2 + mi;
#pragma unroll
                    for (int bj = 0; bj < 2; ++bj)
#pragma unroll
                        for (int n = 0; n < 2; ++n) { f32x4 h = hb_[mi][bj][n];
                            if constexpr (!RES_F32) { const unsigned wx = __float_as_uint(h[0]), wy = __float_as_uint(h[1]); if constexpr (F16) h = (f32x4){h_lo(wx), h_hi(wx), h_lo(wy), h_hi(wy)}; else h = (f32x4){bf_lo(wx), bf_hi(wx), bf_lo(wy), bf_hi(wy)}; }
                            acc[ai][bj][m][n] = h * DN_ALPHA + acc[ai][bj][m][n]; }
                    asm volatile("" : "+v"(acc[ai][0][m][0]), "+v"(acc[ai][0][m][1]), "+v"(acc[ai][1][m][0]), "+v"(acc[ai][1][m][1])); }
                asm volatile("" ::: "memory"); }
#pragma unroll
        for (int ai = 0; ai < 2; ++ai)
#pragma unroll
            for (int m = 0; m < 4; ++m) {
                float s = 0.f;
#pragma unroll
                for (int bj = 0; bj < 2; ++bj)
#pragma unroll
                    for (int n = 0; n < 2; ++n) { const f32x4 x = acc[ai][bj][m][n]; s += (x[0] + x[1]) + (x[2] + x[3]); }
                s += __shfl_xor(s, 16); s += __shfl_xor(s, 32);
                const float mw = s * (1.0f / 64.0f); float qq = 0.f;
#pragma unroll
                for (int bj = 0; bj < 2; ++bj)
#pragma unroll
                    for (int n = 0; n < 2; ++n) { const f32x4 d = acc[ai][bj][m][n] - mw; qq += (d[0] * d[0] + d[1] * d[1]) + (d[2] * d[2] + d[3] * d[3]); }
                qq += __shfl_xor(qq, 16); qq += __shfl_xor(qq, 32);
                if (fq == 0) P[(ai * HALF + wr * 64 + m * 16 + fr) * 4 + wc] = (f32x2){mw, qq};
            }
        asm volatile("s_waitcnt lgkmcnt(0)" ::: "memory"); __builtin_amdgcn_s_barrier(); asm volatile("" ::: "memory");
        const int row = wid * 32 + (lane & 31);
        if (lane < 32) {
            const f32x2 a = P[row * 4 + 0], b = P[row * 4 + 1], c = P[row * 4 + 2], d = P[row * 4 + 3];
            const float mt = (a.x + b.x + c.x + d.x) * 0.25f;
            const float da = a.x - mt, db = b.x - mt, dc = c.x - mt, dd = d.x - mt;
            const float m2 = (a.y + b.y) + (c.y + d.y) + 64.0f * ((da * da + db * db) + (dc * dc + dd * dd));
            unsigned long long* slot = xbuf + ((size_t)(u.pm * BM + row) * 4 + u.pn);
            __hip_atomic_store(slot, ((unsigned long long)__float_as_uint(m2) << 32) | __float_as_uint(mt), __ATOMIC_RELAXED, __HIP_MEMORY_SCOPE_AGENT);
        }
        asm volatile("s_waitcnt vmcnt(0)" ::: "memory");
        if (lane == 0) __hip_atomic_fetch_add(cnt + 64 * u.pm, 1u, __ATOMIC_RELAXED, __HIP_MEMORY_SCOPE_AGENT);
        if (wid == 0) {
            unsigned sp = 0;
            while ((unsigned)__builtin_amdgcn_readfirstlane(__hip_atomic_load(cnt + 64 * u.pm, __ATOMIC_RELAXED, __HIP_MEMORY_SCOPE_AGENT)) < want) { __builtin_amdgcn_s_sleep(2); if (++sp > (1u << 22)) break; }
            __builtin_amdgcn_fence(__ATOMIC_ACQUIRE, "agent");
        }
        asm volatile("s_waitcnt vmcnt(0) lgkmcnt(0)" ::: "memory"); __builtin_amdgcn_s_barrier(); asm volatile("" ::: "memory");
        if (lane < 32) {
            const unsigned long long* slot = xbuf + (size_t)(u.pm * BM + row) * 4; float mt[4], m2[4]; float ms = 0.f;
#pragma unroll
            for (int t = 0; t < 4; ++t) { const unsigned long long w = __hip_atomic_load(slot + t, __ATOMIC_RELAXED, __HIP_MEMORY_SCOPE_AGENT); mt[t] = __uint_as_float((unsigned)w); m2[t] = __uint_as_float((unsigned)(w >> 32)); ms += mt[t]; }
            const float mean = ms * 0.25f; float qq = 0.f;
#pragma unroll
            for (int t = 0; t < 4; ++t) { const float dm = mt[t] - mean; qq += m2[t] + 256.0f * dm * dm; }
            S[row] = (f32x2){mean, 1.0f / sqrtf(qq * (1.0f / 1024.0f) + LN_EPS)};
        }
        asm volatile("s_waitcnt lgkmcnt(0)" ::: "memory"); __builtin_amdgcn_s_barrier(); asm volatile("" ::: "memory");
        f32x2 sr[2][4];
#pragma unroll
        for (int ai = 0; ai < 2; ++ai)
#pragma unroll
            for (int m = 0; m < 4; ++m) sr[ai][m] = S[ai * HALF + wr * 64 + m * 16 + fr];
#pragma unroll
        for (int bj = 0; bj < 2; ++bj)
#pragma unroll
            for (int n = 0; n < 2; ++n) { const f32x4 gv = *(const f32x4*)(gam + col0 + bj * HALF + n * 16), bv = *(const f32x4*)(bet + col0 + bj * HALF + n * 16);
#pragma unroll
                for (int ai = 0; ai < 2; ++ai)
#pragma unroll
                    for (int m = 0; m < 4; ++m) { const int r = ai * HALF + wr * 64 + m * 16 + fr; const unsigned off = (unsigned)(u.pm * BM + r) * DM + col0 + bj * HALF + n * 16;
                        const f32x4 o = (acc[ai][bj][m][n] - sr[ai][m].x) * sr[ai][m].y * gv + bv;
                        if constexpr (OUT_F) *(f32x4*)(out_f + off) = o;
                        if constexpr (OUT_B) { u32x2 w; w.x = cvt_pk16<F16>(o[0], o[1]); w.y = cvt_pk16<F16>(o[2], o[3]); *(u32x2*)(out_b + off) = w; } } }
    }
};

template <class Epi, class Sched, int DSH = 0, bool F16 = false, bool SP2 = true, bool ALIGN_EPI = true>
__device__ __forceinline__ void gemm_phase(LAS unsigned char* lds, const Gemm g, const Sched& S, const Epi& E) {
    const int tid = opaque(threadIdx.x), wid = __builtin_amdgcn_readfirstlane(tid >> 6), lane = tid & 63, wr = wid >> 2, wc = wid & 3, fr = lane & 15, fq = lane >> 4;
    const int K = g.K, nt = K / BK;
    unsigned voffA[2], voffB[2], voffB1[2];
#pragma unroll
    for (int i = 0; i < 2; ++i) { int R, C; stage_rc(tid * 16 + i * 8192, R, C); const int Rb = Epi::PERM ? ((R & ~31) + perm32(R & 31)) : R;
        voffA[i] = (unsigned)(R * K + C) * 2u;
        if constexpr (DSH == 0) { voffB[i] = (unsigned)(Rb * K + C) * 2u; voffB1[i] = (unsigned)((Rb + HALF) * K + C) * 2u; }
        else { const int c0_ = Rb, c1_ = Rb + HALF; const int t0_ = ((c0_ & ((256 >> DSH) - 1)) << DSH) + (c0_ >> (8 - DSH)), t1_ = ((c1_ & ((256 >> DSH) - 1)) << DSH) + (c1_ >> (8 - DSH));
            voffB[i] = (unsigned)(t0_ * K + C) * 2u; voffB1[i] = (unsigned)(t1_ * K + C) * 2u; } }
    const size_t kstep = (size_t)(BK * 2);
    const size_t hstep = (size_t)HALF * K * 2;
    const size_t tstep = 2 * hstep;
    const unsigned ldsw = (unsigned)wid * 1024u;
    const int aoff = lds_byte(wr * 64 + fr, fq * 8), boff = lds_byte(wc * 32 + fr, fq * 8);
#define PG8_SA(b, h) (((b) * 2 + (h)) * HTB)
#define PG8_SB(b, h) ((4 + (b) * 2 + (h)) * HTB)
#define PG8_STAGE(bufoff, gbase, voff) do { _Pragma("unroll") for (int _i = 0; _i < 2; ++_i) \
        __builtin_amdgcn_global_load_lds((const unsigned*)((const char*)(gbase) + (voff)[_i]), (LAS unsigned*)(lds + (bufoff) + ldsw + _i * 8192), 16, 0, 0); } while (0)
#define PG8_LDA(dst, b, h) do { _Pragma("unroll") for (int m = 0; m < 4; ++m) _Pragma("unroll") for (int k = 0; k < 2; ++k) dst[m][k] = *(const LAS bf16x8*)(lds + PG8_SA(b, h) + aoff + m * 2048 + k * 1024); } while (0)
#define PG8_LDB(dst, b, h) do { _Pragma("unroll") for (int n = 0; n < 2; ++n) _Pragma("unroll") for (int k = 0; k < 2; ++k) dst[n][k] = *(const LAS bf16x8*)(lds + PG8_SB(b, h) + boff + n * 2048 + k * 1024); } while (0)
#define PG8_MMA(ai, bj, At, Bt) do { __builtin_amdgcn_s_setprio(1); _Pragma("unroll") for (int m = 0; m < 4; ++m) _Pragma("unroll") for (int n = 0; n < 2; ++n) _Pragma("unroll") for (int k = 0; k < 2; ++k) \
        acc[ai][bj][m][n] = F16 ? __builtin_amdgcn_mfma_f32_16x16x32_f16(__builtin_bit_cast(half8, Bt[n][k]), __builtin_bit_cast(half8, At[m][k]), acc[ai][bj][m][n], 0, 0, 0) : __builtin_amdgcn_mfma_f32_16x16x32_bf16(Bt[n][k], At[m][k], acc[ai][bj][m][n], 0, 0, 0); __builtin_amdgcn_s_setprio(0); } while (0)
#define PG8_WAIT_V(n) asm volatile("s_waitcnt vmcnt(" #n ")" ::: "memory")
#define PG8_WAIT_L(n) asm volatile("s_waitcnt lgkmcnt(" #n ")" ::: "memory")
#define PG8_BAR __builtin_amdgcn_s_barrier()
#define PG8_SCHED __builtin_amdgcn_sched_barrier(0)
    Unit cur, nxt; int ui = 0;
    if (!S.next(0, cur)) return;
    f32x4 acc[2][2][4][2];
#pragma unroll
    for (int a = 0; a < 2; ++a)
#pragma unroll
        for (int b = 0; b < 2; ++b)
#pragma unroll
            for (int m = 0; m < 4; ++m)
#pragma unroll
                for (int n = 0; n < 2; ++n) acc[a][b][m][n] = (f32x4){0.f, 0.f, 0.f, 0.f};
    bf16x8 At[4][2], B0[2][2], B1[2][2];
    const char* cA = (const char*)g.A + (size_t)cur.pm * tstep; const char* cB = (const char*)g.Bt + (size_t)cur.pn * tstep;
    if constexpr (SP2) {
        PG8_STAGE(PG8_SB(0, 0), cB, voffB); PG8_STAGE(PG8_SB(0, 1), cB, voffB1); PG8_STAGE(PG8_SA(0, 0), cA, voffA); PG8_STAGE(PG8_SA(0, 1), cA + hstep, voffA);
        if (wr == 1) PG8_BAR;
        PG8_WAIT_V(2); PG8_BAR;
        PG8_STAGE(PG8_SB(1, 0), cB + kstep, voffB); PG8_STAGE(PG8_SA(1, 0), cA + kstep, voffA); PG8_STAGE(PG8_SB(1, 1), cB + kstep, voffB1);
        PG8_WAIT_V(6); PG8_BAR;
    } else {
    PG8_STAGE(PG8_SB(0, 0), cB, voffB); PG8_STAGE(PG8_SA(0, 0), cA, voffA); PG8_STAGE(PG8_SB(0, 1), cB, voffB1); PG8_STAGE(PG8_SA(0, 1), cA + hstep, voffA);
    if (wr == 1) PG8_BAR;
    PG8_WAIT_V(4); PG8_BAR;
    PG8_STAGE(PG8_SB(1, 0), cB + kstep, voffB); PG8_STAGE(PG8_SA(1, 0), cA + kstep, voffA); PG8_STAGE(PG8_SB(1, 1), cB + kstep, voffB1);
    PG8_WAIT_V(6); PG8_BAR;
    }
    for (;;) {
        const bool has_next = S.next(ui + 1, nxt);
        const char* nA = has_next ? (const char*)g.A + (size_t)nxt.pm * tstep : cA; const char* nB = has_next ? (const char*)g.Bt + (size_t)nxt.pn * tstep : cB;
        for (int t = 0; t < nt; t += 2) {
            const bool last = (t == nt - 2);
            const char* a1 = cA + (size_t)(t + 1) * kstep;
            const char* a2 = last ? nA : cA + (size_t)(t + 2) * kstep; const char* b2 = last ? nB : cB + (size_t)(t + 2) * kstep;
            const char* a3 = a2 + kstep; const char* b3 = b2 + kstep;
            if constexpr (SP2) {
            PG8_LDB(B0, 0, 0); PG8_LDB(B1, 0, 1); PG8_SCHED; PG8_LDA(At, 0, 0); PG8_STAGE(PG8_SA(1, 1), a1 + hstep, voffA);
            PG8_WAIT_V(8); PG8_WAIT_L(0); PG8_BAR; PG8_MMA(0, 0, At, B0); PG8_MMA(0, 1, At, B1); PG8_BAR; PG8_SCHED;
            PG8_LDA(At, 0, 1); PG8_STAGE(PG8_SB(0, 0), b2, voffB); PG8_STAGE(PG8_SB(0, 1), b2, voffB1); PG8_STAGE(PG8_SA(0, 0), a2, voffA);
            PG8_WAIT_V(8); PG8_WAIT_L(0); PG8_BAR; PG8_MMA(1, 0, At, B0); PG8_MMA(1, 1, At, B1); PG8_BAR; PG8_SCHED;
            PG8_LDB(B0, 1, 0); PG8_LDB(B1, 1, 1); PG8_SCHED; PG8_LDA(At, 1, 0); PG8_STAGE(PG8_SA(0, 1), a2 + hstep, voffA);
            PG8_WAIT_V(8); PG8_WAIT_L(0); PG8_BAR; PG8_MMA(0, 0, At, B0); PG8_MMA(0, 1, At, B1); PG8_BAR; PG8_SCHED;
            PG8_LDA(At, 1, 1); PG8_STAGE(PG8_SB(1, 0), b3, voffB); PG8_STAGE(PG8_SB(1, 1), b3, voffB1); PG8_STAGE(PG8_SA(1, 0), a3, voffA);
            PG8_WAIT_V(8); PG8_WAIT_L(0); PG8_BAR; PG8_MMA(1, 0, At, B0); PG8_MMA(1, 1, At, B1); PG8_BAR; PG8_SCHED;
            } else {
            PG8_LDB(B0, 0, 0); PG8_SCHED; PG8_LDA(At, 0, 0); PG8_STAGE(PG8_SA(1, 1), a1 + hstep, voffA);
            PG8_WAIT_L(8); PG8_BAR; PG8_WAIT_L(0); PG8_MMA(0, 0, At, B0); PG8_BAR; PG8_SCHED;
            PG8_LDB(B1, 0, 1); PG8_STAGE(PG8_SB(0, 0), b2, voffB);
            PG8_BAR; PG8_WAIT_L(0); PG8_MMA(0, 1, At, B1); PG8_BAR;
            PG8_LDA(At, 0, 1); PG8_STAGE(PG8_SA(0, 0), a2, voffA);
            PG8_BAR; PG8_WAIT_L(0); PG8_MMA(1, 0, At, B0); PG8_BAR; PG8_SCHED;
            PG8_STAGE(PG8_SB(0, 1), b2, voffB1);
            PG8_WAIT_V(6); PG8_BAR; PG8_MMA(1, 1, At, B1); PG8_BAR;
            PG8_LDB(B0, 1, 0); PG8_SCHED; PG8_LDA(At, 1, 0); PG8_STAGE(PG8_SA(0, 1), a2 + hstep, voffA);
            PG8_WAIT_L(8); PG8_BAR; PG8_WAIT_L(0); PG8_MMA(0, 0, At, B0); PG8_BAR; PG8_SCHED;
            PG8_LDB(B1, 1, 1); PG8_STAGE(PG8_SB(1, 0), b3, voffB);
            PG8_BAR; PG8_WAIT_L(0); PG8_MMA(0, 1, At, B1); PG8_BAR;
            PG8_LDA(At, 1, 1); PG8_STAGE(PG8_SA(1, 0), a3, voffA);
            PG8_BAR; PG8_WAIT_L(0); PG8_MMA(1, 0, At, B0); PG8_BAR; PG8_SCHED;
            PG8_STAGE(PG8_SB(1, 1), b3, voffB1);
            PG8_WAIT_V(6); PG8_BAR; PG8_MMA(1, 1, At, B1); PG8_BAR;
            }
        }
        if constexpr (ALIGN_EPI) { if (wr == 0) PG8_BAR; }
        if constexpr (!Epi::AFTER_DRAIN) E(acc, cur, wr, wc, fr, fq);
        if (!has_next) break;
#pragma unroll
        for (int a = 0; a < 2; ++a)
#pragma unroll
            for (int b = 0; b < 2; ++b)
#pragma unroll
                for (int m = 0; m < 4; ++m)
#pragma unroll
                    for (int n = 0; n < 2; ++n) acc[a][b][m][n] = (f32x4){0.f, 0.f, 0.f, 0.f};
        cur = nxt; cA = nA; cB = nB; ++ui;
        if constexpr (ALIGN_EPI) { if (wr == 1) PG8_BAR; }
    }
    PG8_WAIT_V(0);
    if constexpr (!ALIGN_EPI) { if (wr == 0) PG8_BAR; }
    PG8_BAR;
    if constexpr (Epi::AFTER_DRAIN) E.fused(acc, cur, wr, wc, fr, fq, lds, wid, lane);
#undef PG8_SA
#undef PG8_SB
#undef PG8_STAGE
#undef PG8_LDA
#undef PG8_LDB
#undef PG8_MMA
#undef PG8_WAIT_V
#undef PG8_WAIT_L
#undef PG8_BAR
#undef PG8_SCHED
}


#define XB_TMO      128
#define XB_XCNT(j)  (256  + 64 * (j))
#define XB_XSUB(j)  (1280 + 64 * (j))
#define XB_XGEN(j)  (2304 + 64 * (j))
#define XB_TOP      3328
#define XB_TOPGEN   3392
#define XCD_BAR_WORDS 3456
#define XB_SPIN_CAP (1u << 18)
__device__ __forceinline__ unsigned xb_ld(unsigned* p)              { return __hip_atomic_load(p, __ATOMIC_RELAXED, __HIP_MEMORY_SCOPE_AGENT); }
__device__ __forceinline__ unsigned xb_add(unsigned* p, unsigned v) { return __hip_atomic_fetch_add(p, v, __ATOMIC_RELAXED, __HIP_MEMORY_SCOPE_AGENT); }
__device__ __forceinline__ unsigned xb_xcc_id() { return (unsigned)__builtin_amdgcn_s_getreg((3 << 11) | 20) & 0xFu; }
#define XB_SPIN(cond, bar) do { unsigned _sp = 0; while (cond) { __builtin_amdgcn_s_sleep(1); \
    if ((++_sp & 255u) == 0u) { if (xb_ld(&(bar)[XB_TMO])) break; if (_sp > XB_SPIN_CAP) { atomicAdd(&(bar)[XB_TMO], 1u); break; } } } } while (0)
struct XcdBarrier { unsigned* bar; unsigned x; volatile LAS unsigned* st; };
__device__ __forceinline__ XcdBarrier xcd_barrier_post(unsigned* bar, volatile LAS unsigned* st) {
    XcdBarrier b; b.bar = bar; b.x = xb_xcc_id(); b.st = st;
    if (threadIdx.x == 0) (void)xb_add(&bar[XB_XCNT(b.x)], 1u);
    return b;
}
__device__ __forceinline__ void xcd_barrier_complete(unsigned* bar, unsigned x, unsigned& nloc, unsigned& nx) {
    const unsigned G = gridDim.x * gridDim.y * gridDim.z;
    unsigned sum, cnt, mine, sp = 0u;
    for (;;) {
        sum = 0u; cnt = 0u; mine = 0u;
#pragma unroll
        for (unsigned j = 0; j < 16; ++j) { const unsigned c = xb_ld(&bar[XB_XCNT(j)]); sum += c; cnt += (c > 0u) ? 1u : 0u; mine = (j == x) ? c : mine; }
        if (sum == G) break;
        __builtin_amdgcn_s_sleep(1);
        if ((++sp & 255u) == 0u) { if (xb_ld(&bar[XB_TMO])) break; if (sp > XB_SPIN_CAP) { atomicAdd(&bar[XB_TMO], 1u); break; } }
    }
    nloc = mine > 0u ? mine : 1u; nx = cnt > 0u ? cnt : 1u;
}
__device__ __forceinline__ void xcd_barrier(const XcdBarrier& b) {
    asm volatile("s_waitcnt vmcnt(0)" ::: "memory");
    __syncthreads();
    if (threadIdx.x == 0) {
        unsigned* bar = b.bar;
        const unsigned bx = xb_xcc_id();
        __builtin_amdgcn_s_waitcnt(0);
        unsigned nloc = b.st[0], nx = b.st[1];
        if (nloc == 0u) { xcd_barrier_complete(bar, bx, nloc, nx); b.st[0] = nloc; b.st[1] = nx; }
        const unsigned old = xb_add(&bar[XB_XSUB(bx)], 1u);
        const unsigned gen = old / nloc;
        if (old + 1u == (gen + 1u) * nloc) {
            __builtin_amdgcn_fence(__ATOMIC_RELEASE, "agent");
            asm volatile("s_waitcnt vmcnt(0)" ::: "memory");
            const unsigned og = xb_add(&bar[XB_TOP], 1u);
            const unsigned tg = og / nx;
            if (og + 1u == (tg + 1u) * nx) xb_add(&bar[XB_TOPGEN], 1u);
            else XB_SPIN(xb_ld(&bar[XB_TOPGEN]) == tg, bar);
            __builtin_amdgcn_fence(__ATOMIC_ACQUIRE, "agent");
            xb_add(&bar[XB_XGEN(bx)], 1u);
            asm volatile("s_waitcnt vmcnt(0)" ::: "memory");
        } else {
            XB_SPIN(xb_ld(&bar[XB_XGEN(bx)]) == gen, bar);
            __builtin_amdgcn_fence(__ATOMIC_ACQUIRE, "agent");
            asm volatile("s_waitcnt vmcnt(0)" ::: "memory");
        }
    }
    __syncthreads();
}

template <bool F16 = false>
__device__ __forceinline__ void tp_job(const float* src, size_t smat, int lsrc, int coff, bf16_t* dst, size_t dmat, int ldd, int R, int C, int nmat, LAS float* scr) {
    const int tid = opaque(threadIdx.x);
    const int ntc = C / 64, per = (R / 64) * ntc, total = per * nmat;
    const int G = gridDim.x;
    f32x4 v[2];
    int t = blockIdx.x;
#define TP_LOAD(tt_) do { const int i_ = (tt_) / per, t2_ = (tt_) % per, tr_ = t2_ / ntc, tc_ = t2_ % ntc; const float* s_ = src + (size_t)i_ * smat + coff; \
        _Pragma("unroll") for (int k_ = 0; k_ < 2; ++k_) { const int idx_ = tid + 512 * k_, row_ = idx_ >> 4, c4_ = idx_ & 15; v[k_] = *(const f32x4*)(s_ + (size_t)(tr_ * 64 + row_) * lsrc + tc_ * 64 + c4_ * 4); } } while (0)
    if (t < total) TP_LOAD(t);
#pragma unroll 1
    for (; t < total; t += G) {
#pragma unroll
        for (int k = 0; k < 2; ++k) { const int idx = tid + 512 * k, row = idx >> 4, c4 = idx & 15; LAS float* pp = scr + row * 65 + c4 * 4; pp[0] = v[k][0]; pp[1] = v[k][1]; pp[2] = v[k][2]; pp[3] = v[k][3]; }
        if (t + G < total) TP_LOAD(t + G);
        __syncthreads();
        { const int i = t / per, t2 = t % per, tr = t2 / ntc, tc = t2 % ntc; bf16_t* d = dst + (size_t)i * dmat;
          const int c = tid >> 3, ch = tid & 7; const LAS float* sp = scr + (ch * 8) * 65 + c;
          u32x4 o; o.x = cvt_pk16<F16>(sp[0], sp[65]); o.y = cvt_pk16<F16>(sp[2 * 65], sp[3 * 65]); o.z = cvt_pk16<F16>(sp[4 * 65], sp[5 * 65]); o.w = cvt_pk16<F16>(sp[6 * 65], sp[7 * 65]);
          *(u32x4*)(d + (size_t)(tc * 64 + c) * ldd + tr * 64 + ch * 8) = o; }
        __syncthreads();
    }
#undef TP_LOAD
}

struct Params {
    const float *x, *w_in_a, *w_grp_a, *scale_a, *w_out_a, *w_kv, *w_in_b, *w_out_b, *ln_g, *ln_b;
    float* out; unsigned char* ws;
};

__device__ __forceinline__ void phase_prep(const Params& p, LAS unsigned char* lds) {
    LAS float* scr = (LAS float*)lds;
    unsigned char* ws = p.ws;
    tp_job<true>(p.w_in_a, (size_t)1024 * 4096, 4096, 2048, (bf16_t*)(ws + OFF_BTA) + (size_t)2048 * 1024, (size_t)4096 * 1024, 1024, 1024, 2048, 2, scr);
    tp_job(p.w_out_a, (size_t)2048 * 1024, 1024, 0, (bf16_t*)(ws + OFF_WOA), (size_t)1024 * 2048, 2048, 2048, 1024, 2, scr);
    tp_job<true>(p.w_kv, 0, 6144, 0, (bf16_t*)(ws + OFF_KVT), 0, 1024, 1024, 6144, 1, scr);
    tp_job<true>(p.w_in_b, (size_t)1024 * 4096, 4096, 0, (bf16_t*)(ws + OFF_INB), (size_t)4096 * 1024, 1024, 1024, 4096, 2, scr);
    tp_job<true>(p.w_grp_a, (size_t)512 * 512, 512, 0, (bf16_t*)(ws + OFF_WGT), (size_t)512 * 512, 512, 512, 512, 8, scr);
    { bf16_t* winu = (bf16_t*)(ws + OFF_WINU);
      const int total = 2 * 4 * 1024 * 64;
      const int tid = opaque(threadIdx.x);
#pragma unroll 1
      for (int i0 = blockIdx.x * 512 + tid; i0 < total; i0 += gridDim.x * 512 * 4) {
          f32x4 a[4], b[4];
#pragma unroll
          for (int u = 0; u < 4; ++u) { const int i = i0 + u * gridDim.x * 512; if (i < total) { const int c8 = i & 63, k = (i >> 6) & 1023, lg = i >> 16, l = lg >> 2, g = lg & 3;
              const float* s = p.w_in_a + ((size_t)l * 1024 + k) * 4096 + g * 512 + c8 * 8; a[u] = *(const f32x4*)s; b[u] = *(const f32x4*)(s + 4); } }
#pragma unroll
          for (int u = 0; u < 4; ++u) { const int i = i0 + u * gridDim.x * 512; if (i < total) {
              u32x4 o; o.x = cvt_pk_f16(a[u][0], a[u][1]); o.y = cvt_pk_f16(a[u][2], a[u][3]); o.z = cvt_pk_f16(b[u][0], b[u][1]); o.w = cvt_pk_f16(b[u][2], b[u][3]);
              *(u32x4*)(winu + (size_t)i * 8) = o; } } } }
    { bf16_t* hb = (bf16_t*)(ws + OFF_HB);
      const int total = MT * DM / 8;
      const int tid = opaque(threadIdx.x);
#pragma unroll 1
      for (int i0 = blockIdx.x * 512 + tid; i0 < total; i0 += gridDim.x * 512 * 4) {
          f32x4 a[4], b[4];
#pragma unroll
          for (int u = 0; u < 4; ++u) { const int i = i0 + u * gridDim.x * 512; if (i < total) { const float* s = p.x + (size_t)i * 8; a[u] = *(const f32x4*)s; b[u] = *(const f32x4*)(s + 4); } }
#pragma unroll
          for (int u = 0; u < 4; ++u) { const int i = i0 + u * gridDim.x * 512; if (i < total) {
              u32x4 o; o.x = cvt_pk_f16(a[u][0], a[u][1]); o.y = cvt_pk_f16(a[u][2], a[u][3]); o.z = cvt_pk_f16(b[u][0], b[u][1]); o.w = cvt_pk_f16(b[u][2], b[u][3]);
              *(u32x4*)(hb + (size_t)i * 8) = o; } } } }
}

__device__ __forceinline__ void unpack8(const u32x4 w, float (&f)[8]) { f[0] = bf_lo(w.x); f[1] = bf_hi(w.x); f[2] = bf_lo(w.y); f[3] = bf_hi(w.y); f[4] = bf_lo(w.z); f[5] = bf_hi(w.z); f[6] = bf_lo(w.w); f[7] = bf_hi(w.w); }
template <int W>
__device__ __forceinline__ void pool_item(const bf16_t* V, bf16_t* SG, const float (&sc)[8], int t0, int c0) {
    const int s0 = t0 & (SEQ - 1);
    u32x4 rows[W + 3], gts[4];
#pragma unroll
    for (int j = 0; j < W + 3; ++j) { const int dt = j - (W - 1); rows[j] = (u32x4){0u, 0u, 0u, 0u}; if (s0 + dt >= 0) rows[j] = *(const u32x4*)(V + (size_t)(t0 + dt) * 2048 + c0); }
#pragma unroll
    for (int i = 0; i < 4; ++i) gts[i] = *(const u32x4*)(SG + (size_t)(t0 + i) * 2048 + c0);
    float sum[8];
#pragma unroll
    for (int j = 0; j < 8; ++j) sum[j] = 0.f;
#pragma unroll
    for (int j = 0; j < W - 1; ++j) { float f[8]; unpack8(rows[j], f);
#pragma unroll
        for (int k = 0; k < 8; ++k) sum[k] += f[k]; }
#pragma unroll
    for (int i = 0; i < 4; ++i) {
        float f[8], gt[8]; unpack8(rows[W - 1 + i], f); unpack8(gts[i], gt);
#pragma unroll
        for (int k = 0; k < 8; ++k) sum[k] += f[k];
        const int s = s0 + i; const float inv = 1.0f / (float)(s + 1 < W ? s + 1 : W);
        float o[8];
#pragma unroll
        for (int k = 0; k < 8; ++k) o[k] = (sum[k] * inv - f[k]) * sc[k] * gt[k];
        u32x4 wv; wv.x = cvt_pk_bf16(o[0], o[1]); wv.y = cvt_pk_bf16(o[2], o[3]); wv.z = cvt_pk_bf16(o[4], o[5]); wv.w = cvt_pk_bf16(o[6], o[7]);
        *(u32x4*)(SG + (size_t)(t0 + i) * 2048 + c0) = wv;
        float fo[8]; unpack8(rows[i], fo);
#pragma unroll
        for (int k = 0; k < 8; ++k) sum[k] -= fo[k];
    }
}
__device__ __forceinline__ void phase_pool(const bf16_t* V, bf16_t* SG, const float* scale) {
    const int tid = opaque(threadIdx.x), cth = tid & 255, sub = tid >> 8;
    const int c0 = cth * 8, grp = c0 >> 9;
    float sc[8];
    { const f32x4 a = *(const f32x4*)(scale + c0), b = *(const f32x4*)(scale + c0 + 4); sc[0] = a[0]; sc[1] = a[1]; sc[2] = a[2]; sc[3] = a[3]; sc[4] = b[0]; sc[5] = b[1]; sc[6] = b[2]; sc[7] = b[3]; }
    const int qper = (MT / 4) / (int)gridDim.x;
#pragma unroll 1
    for (int qi = sub; qi < qper; qi += 2) {
        const int q = blockIdx.x * qper + qi;
        const int t0 = q * 4;
        if (grp == 0) pool_item<2>(V, SG, sc, t0, c0);
        else if (grp == 1) pool_item<4>(V, SG, sc, t0, c0);
        else if (grp == 2) pool_item<8>(V, SG, sc, t0, c0);
        else pool_item<16>(V, SG, sc, t0, c0);
    }
}

template <int V_> struct AttIC { static constexpr int value = V_; };
struct AttGeo { int dsh, dil, L, nblk, g; };
__device__ __forceinline__ void att_decode(const AttGeo& G_, int it, int& hh, int& b, int& r, int& n) { n = it & (G_.nblk - 1); const int y = it >> (5 - G_.dsh); r = y & (G_.dil - 1); const int z = y >> G_.dsh; b = z & 3; hh = z >> 2; }
__device__ __forceinline__ void att_dma_half(const AttGeo& G_, const bf16_t* Kr, const bf16_t* Vt, int it, int which, int slot, LAS unsigned char* lds, int wid, int lane0) {
    int hh, b, r, n; att_decode(G_, it, hh, b, r, n);
    const int lane = opaque(lane0);
    int blk = n - 1 + which; blk = blk < 0 ? 0 : blk;
    const bf16_t* kb = Kr + ((size_t)(((G_.g * 16 + hh) * 4 + b) * SEQ + r * G_.L + blk * 128)) * 64;
    const bf16_t* vb = Vt + (size_t)(G_.g * 1024 + hh * 64) * MT + b * SEQ + r * G_.L + blk * 128;
    LAS unsigned char* kl = lds + slot * 32768; LAS unsigned char* vl = kl + 16384;
#pragma unroll
    for (int rd = 0; rd < 2; ++rd) { const int ch = rd * 8 + wid; const int rho = ch * 8 + (lane >> 3); const int cs = (lane & 7) ^ ((rho >> 1) & 7);
        __builtin_amdgcn_global_load_lds((const unsigned*)(kb + (size_t)rho * 64 + cs * 8), (LAS unsigned*)(kl + ch * 1024), 16, 0, 0); }
#pragma unroll
    for (int rd = 0; rd < 2; ++rd) { const int ch = rd * 8 + wid; const int d = ch * 4 + (lane >> 4); const int cs = (lane & 15) ^ (d & 15);
        __builtin_amdgcn_global_load_lds((const unsigned*)(vb + (size_t)d * MT + cs * 8), (LAS unsigned*)(vl + ch * 1024), 16, 0, 0); }
}
__device__ __forceinline__ int att_first_item() { return ((blockIdx.x & 7) * 32 + (blockIdx.x >> 3)) * 8; }
__device__ __forceinline__ void attn_issue_first(const bf16_t* Kr, const bf16_t* Vt, int g, LAS unsigned char* lds) {
    const int tid = opaque(threadIdx.x), wid = __builtin_amdgcn_readfirstlane(tid >> 6), lane0 = tid & 63;
    AttGeo G_; G_.g = g; G_.dsh = 2 * g; G_.dil = 1 << G_.dsh; G_.L = SEQ >> G_.dsh; G_.nblk = G_.L >> 7;
    const int it = att_first_item();
    att_dma_half(G_, Kr, Vt, it, 0, 3, lds, wid, lane0);
    att_dma_half(G_, Kr, Vt, it, 1, 0, lds, wid, lane0);
}
template <bool PRE>
__device__ __forceinline__ void phase_attn(const bf16_t* Q, const bf16_t* Kr, const bf16_t* Vt, bf16_t* ACC, float* LSE, int g, LAS unsigned char* lds) {
    const int tid = opaque(threadIdx.x), wid = __builtin_amdgcn_readfirstlane(tid >> 6), lane0 = tid & 63, q0 = lane0 & 15, q40 = lane0 >> 4;
    AttGeo G_; G_.g = g; G_.dsh = 2 * g; G_.dil = 1 << G_.dsh; G_.L = SEQ >> G_.dsh; G_.nblk = G_.L >> 7;
    const int dsh = G_.dsh, dil = G_.dil;
    const int it0 = att_first_item();
    bf16x8 qf[2]; u32x2 oldacc[4]; float oldlse = 0.f; int tq = 0, hh = 0, n = 0;
    {
        if constexpr (!PRE) { att_dma_half(G_, Kr, Vt, it0, 0, 3, lds, wid, lane0); att_dma_half(G_, Kr, Vt, it0, 1, 0, lds, wid, lane0); }
        int b, r; att_decode(G_, it0, hh, b, r, n);
        tq = b * SEQ + ((n * 128 + wid * 16 + q0) << dsh) + r;
#pragma unroll
        for (int ks = 0; ks < 2; ++ks) qf[ks] = *(const bf16x8*)(Q + ((size_t)hh * MT + tq) * 64 + ks * 32 + q40 * 8);
        if (g > 0) { oldlse = LSE[(size_t)hh * MT + tq];
#pragma unroll
            for (int dt = 0; dt < 4; ++dt) oldacc[dt] = *(const u32x2*)(ACC + ((size_t)hh * MT + tq) * 64 + q40 * 4 + dt * 16); }
    }
    u32x2 pend[4]; float pend_lse = 0.f; int pend_tq = 0, pend_hh = 0; bool have_pend = false;
    auto item_body = [&](auto kkc, int k) __attribute__((always_inline)) {
        constexpr int KK = decltype(kkc)::value;
        constexpr int SC = KK, SP = (KK + 3) & 3, SN = (KK + 1) & 3;
        asm volatile("s_waitcnt vmcnt(0)" ::: "memory");
        __builtin_amdgcn_s_barrier();
        asm volatile("" ::: "memory");
        asm volatile("" : "+v"(qf[0]), "+v"(qf[1]), "+v"(oldacc[0]), "+v"(oldacc[1]), "+v"(oldacc[2]), "+v"(oldacc[3]), "+v"(oldlse));
        if (have_pend) {
            bf16_t* pp = ACC + ((size_t)pend_hh * MT + pend_tq) * 64 + q40 * 4;
#pragma unroll
            for (int dt = 0; dt < 4; ++dt) *(u32x2*)(pp + dt * 16) = pend[dt];
            if (q40 == 0) LSE[(size_t)pend_hh * MT + pend_tq] = pend_lse;
        }
        const int q = opaque(q0), q4 = opaque(q40);
        bf16x8 qn[2]; u32x2 oldn[4]; float oldlsen = 0.f; int tqn = 0, hhn = 0, nn = 0;
        if (k + 1 < 8) {
            const int itn = it0 + k + 1;
            att_dma_half(G_, Kr, Vt, itn, 1, SN, lds, wid, lane0);
            int b, r; att_decode(G_, itn, hhn, b, r, nn);
            tqn = b * SEQ + ((nn * 128 + wid * 16 + q) << dsh) + r;
#pragma unroll
            for (int ks = 0; ks < 2; ++ks) qn[ks] = *(const bf16x8*)(Q + ((size_t)hhn * MT + tqn) * 64 + ks * 32 + q4 * 8);
            if (g > 0) { oldlsen = LSE[(size_t)hhn * MT + tqn];
#pragma unroll
                for (int dt = 0; dt < 4; ++dt) oldn[dt] = *(const u32x2*)(ACC + ((size_t)hhn * MT + tqn) * 64 + q4 * 4 + dt * 16); }
        }
        const float slope = __builtin_amdgcn_exp2f(-8.0f * (float)(g * 16 + hh + 1) / 48.0f);
        const float bias2 = slope * (float)dil * LOG2E;
        f32x4 sacc[9];
        {
            bf16x8 kf[9][2];
#pragma unroll
            for (int kt = 0; kt < 9; ++kt) { const int t16 = wid + kt; const int rl = (t16 & 7) * 16 + q, sw = (rl >> 1) & 7;
                const LAS unsigned char* kb_ = (t16 >= 8) ? (lds + SC * 32768) : (lds + SP * 32768);
                kf[kt][0] = *(const LAS bf16x8*)(kb_ + rl * 128 + ((q4 ^ sw) * 16));
                kf[kt][1] = *(const LAS bf16x8*)(kb_ + rl * 128 + (((4 + q4) ^ sw) * 16)); }
            asm volatile("" : "+v"(kf[0][0]), "+v"(kf[0][1]), "+v"(kf[1][0]), "+v"(kf[1][1]), "+v"(kf[2][0]), "+v"(kf[2][1]), "+v"(kf[3][0]), "+v"(kf[3][1]), "+v"(kf[4][0]), "+v"(kf[4][1]));
            asm volatile("" : "+v"(kf[5][0]), "+v"(kf[5][1]), "+v"(kf[6][0]), "+v"(kf[6][1]), "+v"(kf[7][0]), "+v"(kf[7][1]), "+v"(kf[8][0]), "+v"(kf[8][1]));
#pragma unroll
            for (int kt = 0; kt < 9; ++kt) { f32x4 a = (f32x4){0.f, 0.f, 0.f, 0.f};
                a = __builtin_amdgcn_mfma_f32_16x16x32_bf16(kf[kt][0], qf[0], a, 0, 0, 0);
                sacc[kt] = a; }
#pragma unroll
            for (int kt = 0; kt < 9; ++kt) sacc[kt] = __builtin_amdgcn_mfma_f32_16x16x32_bf16(kf[kt][1], qf[1], sacc[kt], 0, 0, 0);
        }
        const float relb = (float)(128 + q - q4 * 4);
        const float a0 = -bias2 * relb;
        float mx = -1e30f;
#pragma unroll
        for (int kt = 0; kt < 9; ++kt)
#pragma unroll
            for (int jj = 0; jj < 4; ++jj) {
                float s = __builtin_fmaf(sacc[kt][jj], 0.125f * LOG2E, __builtin_fmaf(bias2, (float)(kt * 16 + jj), a0));
                if (kt == 0) { if (q4 * 4 + jj < q) s = -1e30f; }
                if (kt == 8) { if (q4 * 4 + jj > q) s = -1e30f; }
                sacc[kt][jj] = s; }
        if (n == 0) {
#pragma unroll
            for (int kt = 0; kt < 8; ++kt)
#pragma unroll
                for (int jj = 0; jj < 4; ++jj) if (wid * 16 + kt * 16 + q4 * 4 + jj < 128) sacc[kt][jj] = -1e30f;
        }
#pragma unroll
        for (int kt = 0; kt < 9; ++kt)
#pragma unroll
            for (int jj = 0; jj < 4; ++jj) mx = fmaxf(mx, sacc[kt][jj]);
        mx = fmaxf(mx, __shfl_xor(mx, 16)); mx = fmaxf(mx, __shfl_xor(mx, 32));
        float lsum = 0.f;
#pragma unroll
        for (int kt = 0; kt < 9; ++kt)
#pragma unroll
            for (int jj = 0; jj < 4; ++jj) { const float pv = __builtin_amdgcn_exp2f(sacc[kt][jj] - mx); sacc[kt][jj] = pv; lsum += pv; }
        lsum += __shfl_xor(lsum, 16); lsum += __shfl_xor(lsum, 32);
        f32x4 oacc[4];
#pragma unroll
        for (int dt = 0; dt < 4; ++dt) oacc[dt] = (f32x4){0.f, 0.f, 0.f, 0.f};
#pragma unroll
        for (int kp2 = 0; kp2 < 5; ++kp2) {
            u32x4 pw; pw.x = cvt_pk_bf16(sacc[2 * kp2][0], sacc[2 * kp2][1]); pw.y = cvt_pk_bf16(sacc[2 * kp2][2], sacc[2 * kp2][3]);
            if (kp2 < 4) { pw.z = cvt_pk_bf16(sacc[kp2 < 4 ? 2 * kp2 + 1 : 8][0], sacc[kp2 < 4 ? 2 * kp2 + 1 : 8][1]); pw.w = cvt_pk_bf16(sacc[kp2 < 4 ? 2 * kp2 + 1 : 8][2], sacc[kp2 < 4 ? 2 * kp2 + 1 : 8][3]); }
            else { pw.z = 0u; pw.w = 0u; }
            bf16x8 pf; __builtin_memcpy(&pf, &pw, 16);
            const int chb = 2 * wid + 4 * kp2;
            const LAS unsigned char* v0b = ((chb >> 4) ? (lds + SC * 32768) : (lds + SP * 32768)) + 16384;
            const LAS unsigned char* v1b = (((chb + 2) >> 4) ? (lds + SC * 32768) : (lds + SP * 32768)) + 16384;
            const int c0 = (chb & 15) + (q4 >> 1), c1 = ((chb + 2) & 15) + (q4 >> 1);
#pragma unroll
            for (int dt = 0; dt < 4; ++dt) {
                const int d = dt * 16 + q;
                const int roff = d * 256 + (q4 & 1) * 8;
                u32x4 vw; const u32x2 lo = *(const LAS u32x2*)(v0b + roff + ((c0 ^ q) * 16)); vw.x = lo.x; vw.y = lo.y;
                if (kp2 < 4) { const u32x2 hi = *(const LAS u32x2*)(v1b + roff + ((c1 ^ q) * 16)); vw.z = hi.x; vw.w = hi.y; } else { vw.z = 0u; vw.w = 0u; }
                bf16x8 vf; __builtin_memcpy(&vf, &vw, 16);
                oacc[dt] = __builtin_amdgcn_mfma_f32_16x16x32_bf16(vf, pf, oacc[dt], 0, 0, 0);
            }
            __builtin_amdgcn_sched_barrier(0);
        }
        const float inv = 1.0f / lsum;
        float lse = (mx + __log2f(lsum)) * LN2;
        float w_new = inv, w_old = 0.f;
        if (g > 0) {
            const float mm = fmaxf(oldlse, lse), e0 = __expf(oldlse - mm), e1 = __expf(lse - mm), tot = e0 + e1;
            w_old = e0 / tot; w_new = inv * (e1 / tot); lse = mm + __logf(tot);
        }
#pragma unroll
        for (int dt = 0; dt < 4; ++dt) {
            f32x4 o = oacc[dt] * w_new;
            if (g > 0) { const u32x2 pr = oldacc[dt]; o[0] += w_old * bf_lo(pr.x); o[1] += w_old * bf_hi(pr.x); o[2] += w_old * bf_lo(pr.y); o[3] += w_old * bf_hi(pr.y); }
            u32x2 w; w.x = cvt_pk_bf16(o[0], o[1]); w.y = cvt_pk_bf16(o[2], o[3]);
            pend[dt] = w;
        }
        pend_lse = lse; pend_tq = tq; pend_hh = hh; have_pend = true;
        qf[0] = qn[0]; qf[1] = qn[1]; oldlse = oldlsen; tq = tqn; hh = hhn; n = nn;
#pragma unroll
        for (int dt = 0; dt < 4; ++dt) oldacc[dt] = oldn[dt];
    };
#pragma unroll 1
    for (int kq = 0; kq < 2; ++kq) { item_body(AttIC<0>{}, 4 * kq); item_body(AttIC<1>{}, 4 * kq + 1); item_body(AttIC<2>{}, 4 * kq + 2); item_body(AttIC<3>{}, 4 * kq + 3); }
    if (have_pend) {
        bf16_t* pp = ACC + ((size_t)pend_hh * MT + pend_tq) * 64 + q40 * 4;
#pragma unroll
        for (int dt = 0; dt < 4; ++dt) *(u32x2*)(pp + dt * 16) = pend[dt];
        if (q40 == 0) LSE[(size_t)pend_hh * MT + pend_tq] = pend_lse;
    }
    asm volatile("s_waitcnt vmcnt(0)" ::: "memory");
    __builtin_amdgcn_s_barrier();
}

__global__ void __launch_bounds__(512, 2) yoco_fwd(Params p) {
    extern __shared__ __attribute__((aligned(16))) unsigned char smem[];
    LAS unsigned char* lds = (LAS unsigned char*)smem;
    cg::grid_group grid = cg::this_grid();
    volatile LAS unsigned* xst = (volatile LAS unsigned*)(lds + 131072);
    if (threadIdx.x < 4) xst[threadIdx.x] = 0u;
    __syncthreads();
    const XcdBarrier xb = xcd_barrier_post((unsigned*)(p.ws + OFF_BAR), xst);
    if (p.ws == nullptr) grid.sync();
    unsigned char* ws = p.ws;
    const int G = gridDim.x, c = blockIdx.x;
    bf16_t* HB = (bf16_t*)(ws + OFF_HB);

    phase_prep(p, lds);
    xcd_barrier(xb);
    { SingleUnit S; S.has = c < 64; const int lg = c >> 3, un = c & 7; S.u0.pm = un >> 2; S.u0.pn = un & 3;
      Gemm gm; gm.A = (const bf16_t*)(ws + OFF_WGT) + (size_t)lg * 512 * 512; gm.Bt = (const bf16_t*)(ws + OFF_WINU) + (size_t)lg * 1024 * 512; gm.M = 512; gm.N = 1024; gm.K = 512;
      EpiStore16<true> E; E.O = (bf16_t*)(ws + OFF_BTA) + (size_t)(lg >> 2) * 4096 * 1024 + (size_t)(lg & 3) * 512 * 1024; E.ldc = 1024;
      gemm_phase<EpiStore16<true>, SingleUnit, 0, true>(lds, gm, S, E); }
    xcd_barrier(xb);
    for (int l = 0; l < 2; ++l) {
        { StaticOrder S; S.init(MT, 4096, G, c); Gemm gm; gm.A = HB; gm.Bt = (const bf16_t*)(ws + OFF_BTA) + (size_t)l * 4096 * 1024; gm.M = MT; gm.N = 4096; gm.K = 1024;
          EpiAG1 E; E.V = (bf16_t*)(ws + OFF_V); E.SG = (bf16_t*)(ws + OFF_SG); gemm_phase<EpiAG1, StaticOrder, 0, true>(lds, gm, S, E); }
        xcd_barrier(xb);
        phase_pool((const bf16_t*)(ws + OFF_V), (bf16_t*)(ws + OFF_SG), p.scale_a + l * 2048);
        xcd_barrier(xb);
        { StaticOrder S; S.init(MT, 1024, G, c); Gemm gm; gm.A = (const bf16_t*)(ws + OFF_SG); gm.Bt = (const bf16_t*)(ws + OFF_WOA) + (size_t)l * 1024 * 2048; gm.M = MT; gm.N = 1024; gm.K = 2048;
          if (l == 0) { EpiLnFused<false, false, true, true> E; E.hin_f = nullptr; E.hin_b = HB; E.out_f = nullptr; E.out_b = HB; E.gam = p.ln_g; E.bet = p.ln_b;
              E.xbuf = (unsigned long long*)(ws + OFF_XBUF); E.cnt = (unsigned*)(ws + OFF_CNT); E.want = 32u; gemm_phase(lds, gm, S, E); }
          else { EpiLnFused<false, false, true, true> E; E.hin_f = nullptr; E.hin_b = HB; E.out_f = nullptr; E.out_b = HB; E.gam = p.ln_g + DM; E.bet = p.ln_b + DM;
              E.xbuf = (unsigned long long*)(ws + OFF_XBUF); E.cnt = (unsigned*)(ws + OFF_CNT); E.want = 64u; gemm_phase(lds, gm, S, E); } }
        xcd_barrier(xb);
    }
    { StaticOrder S; S.init(MT, 3072, G, c); Gemm gm; gm.A = HB; gm.Bt = (const bf16_t*)(ws + OFF_KVT); gm.M = MT; gm.N = 3072; gm.K = 1024;
      EpiKr E; E.Kr = (bf16_t*)(ws + OFF_K); gemm_phase<EpiKr, StaticOrder, 0, true>(lds, gm, S, E); }
    { StaticOrder S; S.init(1024, MT, G, c); Gemm gm; gm.Bt = HB; gm.M = 1024; gm.N = MT; gm.K = 1024;
      gm.A = (const bf16_t*)(ws + OFF_KVT) + (size_t)(3072 + 0) * 1024;    { EpiVt<0> E; E.Vt = (bf16_t*)(ws + OFF_VT) + (size_t)0 * MT;    gemm_phase<EpiVt<0>, StaticOrder, 0, true>(lds, gm, S, E); }
      gm.A = (const bf16_t*)(ws + OFF_KVT) + (size_t)(3072 + 1024) * 1024; { EpiVt<2> E; E.Vt = (bf16_t*)(ws + OFF_VT) + (size_t)1024 * MT; gemm_phase<EpiVt<2>, StaticOrder, 2, true>(lds, gm, S, E); }
      gm.A = (const bf16_t*)(ws + OFF_KVT) + (size_t)(3072 + 2048) * 1024; { EpiVt<4> E; E.Vt = (bf16_t*)(ws + OFF_VT) + (size_t)2048 * MT; gemm_phase<EpiVt<4>, StaticOrder, 4, true>(lds, gm, S, E); } }
    bf16_t* QG = (bf16_t*)p.out; bf16_t* QY = (bf16_t*)p.out + (size_t)MT * DM; bf16_t* ACC = QG; float* LSE = (float*)(ws + OFF_LSE);
    for (int j = 0; j < 2; ++j) {
        const bf16_t* inb = (const bf16_t*)(ws + OFF_INB) + (size_t)j * 4096 * 1024;
        { StaticOrder S; S.init(MT, 2048, G, c); Gemm gm; gm.A = HB; gm.Bt = inb; gm.M = MT; gm.N = 2048; gm.K = 1024;
          EpiStoreSplit E; E.O0 = QG; E.O1 = QY; gemm_phase<EpiStoreSplit, StaticOrder, 0, true>(lds, gm, S, E); }
        if (j != 0) attn_issue_first((const bf16_t*)(ws + OFF_K), (const bf16_t*)(ws + OFF_VT), 0, lds);
        xcd_barrier(xb);
        if (j == 0) { tp_job(p.w_out_b, (size_t)1024 * 1024, 1024, 0, (bf16_t*)(ws + OFF_OUTB), (size_t)1024 * 1024, 1024, 1024, 1024, 2, (LAS float*)lds);
                      phase_attn<false>(QG, (const bf16_t*)(ws + OFF_K), (const bf16_t*)(ws + OFF_VT), QG, LSE, 0, lds); }
        else phase_attn<true>(QG, (const bf16_t*)(ws + OFF_K), (const bf16_t*)(ws + OFF_VT), QG, LSE, 0, lds);
        attn_issue_first((const bf16_t*)(ws + OFF_K), (const bf16_t*)(ws + OFF_VT), 1, lds);
        xcd_barrier(xb);
        phase_attn<true>(QY, (const bf16_t*)(ws + OFF_K), (const bf16_t*)(ws + OFF_VT), QG, LSE, 1, lds);
        xcd_barrier(xb);
        { StaticOrder S; S.init(MT, 1024, G, c); Gemm gm; gm.A = HB; gm.Bt = inb + (size_t)2 * 1024 * 1024; gm.M = MT; gm.N = 1024; gm.K = 1024;
          EpiStore16<false, true> E; E.O = QY; E.ldc = 1024; gemm_phase<EpiStore16<false, true>, StaticOrder, 0, true>(lds, gm, S, E); }
        attn_issue_first((const bf16_t*)(ws + OFF_K), (const bf16_t*)(ws + OFF_VT), 2, lds);
        xcd_barrier(xb);
        phase_attn<true>(QY, (const bf16_t*)(ws + OFF_K), (const bf16_t*)(ws + OFF_VT), QG, LSE, 2, lds);
        xcd_barrier(xb);
        bf16_t* ZB = j == 0 ? QY : (bf16_t*)(ws + OFF_K);
        { StaticOrder S; S.init(MT, 1024, G, c); Gemm gm; gm.A = HB; gm.Bt = inb + (size_t)3 * 1024 * 1024; gm.M = MT; gm.N = 1024; gm.K = 1024;
          EpiGateMul E; E.Zin = ACC; E.Zout = ZB; gemm_phase<EpiGateMul, StaticOrder, 0, true>(lds, gm, S, E); }
        xcd_barrier(xb);
        { StaticOrder S; S.init(MT, 1024, G, c); Gemm gm; gm.A = ZB; gm.Bt = (const bf16_t*)(ws + OFF_OUTB) + (size_t)j * 1024 * 1024; gm.M = MT; gm.N = 1024; gm.K = 1024;
          if (j == 0) { EpiLnFused<false, false, true, true> E; E.hin_f = nullptr; E.hin_b = HB; E.out_f = nullptr; E.out_b = HB; E.gam = p.ln_g + 2 * DM; E.bet = p.ln_b + 2 * DM;
              E.xbuf = (unsigned long long*)(ws + OFF_XBUF); E.cnt = (unsigned*)(ws + OFF_CNT); E.want = 96u; gemm_phase(lds, gm, S, E); }
          else { EpiLnFused<false, true, false, true> E; E.hin_f = nullptr; E.hin_b = HB; E.out_f = p.out; E.out_b = nullptr; E.gam = p.ln_g + 3 * DM; E.bet = p.ln_b + 3 * DM;
              E.xbuf = (unsigned long long*)(ws + OFF_XBUF); E.cnt = (unsigned*)(ws + OFF_CNT); E.want = 128u; gemm_phase(lds, gm, S, E); } }
        if (j == 0) xcd_barrier(xb);
    }
}

extern "C" void kernel_launch(void* const* d_in, const int* in_sizes, int n_in, void* d_out, int out_size, void* d_ws, size_t ws_size, hipStream_t stream) {
    static int grid = 0;
    if (grid == 0) {
        if (n_in != 10 || out_size != MT * DM || ws_size < WS_NEED) { fprintf(stderr, "kernel_launch: unexpected shapes / workspace (n_in %d out %d ws %zu)\n", n_in, out_size, ws_size); grid = -1; return; }
        int dev = 0, cus = 0, per_cu = 0;
        hipGetDevice(&dev);
        hipDeviceGetAttribute(&cus, hipDeviceAttributeMultiprocessorCount, dev);
        hipFuncSetAttribute((const void*)yoco_fwd, hipFuncAttributeMaxDynamicSharedMemorySize, LDS_BYTES);
        hipOccupancyMaxActiveBlocksPerMultiprocessor(&per_cu, (const void*)yoco_fwd, 512, LDS_BYTES);
        if (per_cu < 1) per_cu = 1;
        (void)hipGetLastError();
        grid = cus;
    }
    if (grid < 0) return;
    Params p{};
    p.x = (const float*)d_in[0]; p.w_in_a = (const float*)d_in[1]; p.w_grp_a = (const float*)d_in[2]; p.scale_a = (const float*)d_in[3]; p.w_out_a = (const float*)d_in[4];
    p.w_kv = (const float*)d_in[5]; p.w_in_b = (const float*)d_in[6]; p.w_out_b = (const float*)d_in[7]; p.ln_g = (const float*)d_in[8]; p.ln_b = (const float*)d_in[9];
    p.out = (float*)d_out; p.ws = (unsigned char*)d_ws;
    if (hipMemsetAsync((unsigned char*)d_ws + OFF_BAR, 0, 32768, stream) != hipSuccess) { fprintf(stderr, "memset failed\n"); return; }
    void* args[] = {&p};
    hipError_t e = hipLaunchCooperativeKernel((const void*)yoco_fwd, dim3(grid), dim3(512), args, LDS_BYTES, stream);
    if (e != hipSuccess) fprintf(stderr, "cooperative launch failed: %s (grid %d)\n", hipGetErrorString(e), grid);
}
```

```cpp
#include <hip/hip_runtime.h>
#include <hip/hip_cooperative_groups.h>
#include <cstdio>
namespace cg = cooperative_groups;

#define LAS __attribute__((address_space(3)))
typedef unsigned short bf16_t;
typedef short bf16x8 __attribute__((ext_vector_type(8)));
typedef short bf16x4 __attribute__((ext_vector_type(4)));
typedef float f32x4 __attribute__((ext_vector_type(4)));
typedef float f32x2 __attribute__((ext_vector_type(2)));
typedef unsigned u32x4 __attribute__((ext_vector_type(4)));
typedef unsigned u32x2 __attribute__((ext_vector_type(2)));

constexpr int MT = 16384, DM = 1024, SEQ = 4096;
constexpr int BM = 256, BK = 64, HALF = 128, HTB = HALF * BK * 2, STAGE_BYTES = 8 * HTB, NXCD = 8, WGM = 4;
constexpr int LDS_BYTES = 131072 + 1024;
constexpr float DN_ALPHA = 1.681792830507429f;
constexpr float LN_EPS = 1e-5f;
constexpr float LOG2E = 1.4426950408889634f, LN2 = 0.6931471805599453f;
constexpr size_t MiB = 1024 * 1024;
constexpr size_t OFF_V = 0, OFF_SG = 64 * MiB, OFF_BTA = 128 * MiB, OFF_WOA = 144 * MiB, OFF_WGT = 152 * MiB, OFF_WINU = 156 * MiB;
constexpr size_t OFF_KVT = 192 * MiB, OFF_INB = 204 * MiB, OFF_BAR = 220 * MiB, OFF_HB = 224 * MiB;
constexpr size_t OFF_CNT = OFF_BAR + 16384, OFF_XBUF = OFF_BAR + 32768;
constexpr size_t OFF_OUTB = 193 * MiB;
constexpr size_t OFF_K = 0, OFF_VT = 96 * MiB, OFF_LSE = 192 * MiB;
constexpr size_t WS_NEED = 256 * MiB;

typedef __bf16 bf16x2_t __attribute__((ext_vector_type(2)));
__device__ __forceinline__ unsigned cvt_pk_bf16(float lo, float hi) { const f32x2 v = {lo, hi}; const bf16x2_t b = __builtin_convertvector(v, bf16x2_t); return __builtin_bit_cast(unsigned, b); }
__device__ __forceinline__ float bf_lo(unsigned w) { return __uint_as_float(w << 16); }
__device__ __forceinline__ float bf_hi(unsigned w) { return __uint_as_float(w & 0xffff0000u); }
typedef _Float16 half8 __attribute__((ext_vector_type(8)));
__device__ __forceinline__ unsigned cvt_pk_f16(float lo, float hi) { const _Float16 a = (_Float16)lo, b = (_Float16)hi; return (unsigned)__builtin_bit_cast(unsigned short, a) | ((unsigned)__builtin_bit_cast(unsigned short, b) << 16); }
__device__ __forceinline__ float h_lo(unsigned w) { return (float)__builtin_bit_cast(_Float16, (unsigned short)(w & 0xffffu)); }
__device__ __forceinline__ float h_hi(unsigned w) { return (float)__builtin_bit_cast(_Float16, (unsigned short)(w >> 16)); }
template <bool F16> __device__ __forceinline__ unsigned cvt_pk16(float lo, float hi) { if constexpr (F16) return cvt_pk_f16(lo, hi); else return cvt_pk_bf16(lo, hi); }
__device__ __forceinline__ int opaque(int x) { asm volatile("" : "+v"(x)); return x; }
__device__ __forceinline__ float silu_f(float x) { return x * __builtin_amdgcn_rcpf(1.0f + __builtin_amdgcn_exp2f(-x * LOG2E)); }

__host__ __device__ __forceinline__ int lds_byte(int r, int c) { const int st = (r >> 4) * 2 + (c >> 5), rr = r & 15, cc = c & 31, ob = rr * 64 + cc * 2; return st * 1024 + (ob ^ (((ob >> 9) & 1) << 5)); }
__host__ __device__ __forceinline__ void stage_rc(int b, int& R, int& C) { const int st = b / 1024, sb = b % 1024, swz = sb ^ (((sb >> 9) & 1) << 5); R = (st >> 1) * 16 + swz / 64; C = (st & 1) * 32 + (swz % 64) / 2; }
__host__ __device__ __forceinline__ int perm32(int rho) { const int n = rho >> 4, i = rho & 15; return 8 * (i >> 2) + 4 * n + (i & 3); }

__device__ __forceinline__ size_t hm_idx(int t, int c) { return ((size_t)(c >> 6) * MT + t) * 64 + (c & 63); }
struct Unit { int pm, pn; };
struct Gemm { const bf16_t* A; const bf16_t* Bt; int M, N, K; };

struct StaticOrder {
    int nM, nN, nwg, G, c;
    __device__ void init(int M, int N, int G_, int c_) { nM = M / BM; nN = N / BM; nwg = nM * nN; G = G_; c = c_; }
    __device__ bool next(int i, Unit& u) const {
        const long L = (long)i * G + c; if (L >= nwg) return false;
        int wgid = (int)L; { const int q = nwg / NXCD, r = nwg % NXCD, xcd = wgid % NXCD, off = wgid / NXCD; wgid = (xcd < r ? xcd * (q + 1) : r * (q + 1) + (xcd - r) * q) + off; }
        const int nig = WGM * nN, gid = wgid / nig, fm = gid * WGM, gsz = (nM - fm) < WGM ? (nM - fm) : WGM;
        u.pm = fm + ((wgid % nig) % gsz); u.pn = (wgid % nig) / gsz; return true;
    }
};
struct SingleUnit {
    bool has; Unit u0;
    __device__ bool next(int i, Unit& u) const { if (i == 0 && has) { u = u0; return true; } return false; }
};

template <bool F16 = false, bool QS = false> struct EpiStore16 {
    static constexpr bool PERM = true, AFTER_DRAIN = false;
    bf16_t* O; int ldc;
    __device__ __forceinline__ void operator()(const f32x4 (&acc)[2][2][4][2], const Unit& u, int wr, int wc, int fr, int fq) const {
        const int row0 = u.pm * BM + wr * 64 + fr, col0 = u.pn * BM + wc * 32 + 8 * fq;
#pragma unroll
        for (int ai = 0; ai < 2; ++ai)
#pragma unroll
            for (int m = 0; m < 4; ++m) { bf16_t* rowp = O + (size_t)(row0 + ai * HALF + m * 16) * ldc + col0;
#pragma unroll
                for (int bj = 0; bj < 2; ++bj) { const f32x4 v0 = acc[ai][bj][m][0], v1 = acc[ai][bj][m][1];
                    u32x4 w; w.x = cvt_pk16<F16>(v0[0], v0[1]); w.y = cvt_pk16<F16>(v0[2], v0[3]); w.z = cvt_pk16<F16>(v1[0], v1[1]); w.w = cvt_pk16<F16>(v1[2], v1[3]);
                    if constexpr (QS) *(u32x4*)(O + hm_idx(row0 + ai * HALF + m * 16, col0 + bj * HALF)) = w;
                    else *(u32x4*)(rowp + bj * HALF) = w; } }
    }
};
struct EpiStoreSplit {
    static constexpr bool PERM = true, AFTER_DRAIN = false;
    bf16_t* O0; bf16_t* O1;
    __device__ __forceinline__ void operator()(const f32x4 (&acc)[2][2][4][2], const Unit& u, int wr, int wc, int fr, int fq) const {
        const int row0 = u.pm * BM + wr * 64 + fr, col0 = (u.pn & 3) * BM + wc * 32 + 8 * fq;
        bf16_t* base = u.pn >= 4 ? O1 : O0;
#pragma unroll
        for (int ai = 0; ai < 2; ++ai)
#pragma unroll
            for (int m = 0; m < 4; ++m) { bf16_t* rowp = base + (size_t)(row0 + ai * HALF + m * 16) * 1024 + col0;
#pragma unroll
                for (int bj = 0; bj < 2; ++bj) { const f32x4 v0 = acc[ai][bj][m][0], v1 = acc[ai][bj][m][1];
                    u32x4 w; w.x = cvt_pk_bf16(v0[0], v0[1]); w.y = cvt_pk_bf16(v0[2], v0[3]); w.z = cvt_pk_bf16(v1[0], v1[1]); w.w = cvt_pk_bf16(v1[2], v1[3]);
                    *(u32x4*)(base + hm_idx(row0 + ai * HALF + m * 16, col0 + bj * HALF)) = w; (void)rowp; } }
    }
};
struct EpiAG1 {
    static constexpr bool PERM = true, AFTER_DRAIN = false;
    bf16_t* V; bf16_t* SG;
    __device__ __forceinline__ void operator()(const f32x4 (&acc)[2][2][4][2], const Unit& u, int wr, int wc, int fr, int fq) const {
        const bool isg = u.pn >= 8;
        const int row0 = u.pm * BM + wr * 64 + fr, col0 = (isg ? u.pn - 8 : u.pn) * BM + wc * 32 + 8 * fq;
        bf16_t* base = isg ? SG : V;
#pragma unroll
        for (int ai = 0; ai < 2; ++ai)
#pragma unroll
            for (int m = 0; m < 4; ++m) { bf16_t* rowp = base + (size_t)(row0 + ai * HALF + m * 16) * 2048 + col0;
#pragma unroll
                for (int bj = 0; bj < 2; ++bj) { f32x4 v0 = acc[ai][bj][m][0], v1 = acc[ai][bj][m][1];
                    if (isg) {
#pragma unroll
                        for (int j = 0; j < 4; ++j) { v0[j] = silu_f(v0[j]); v1[j] = silu_f(v1[j]); } }
                    u32x4 w; w.x = cvt_pk_bf16(v0[0], v0[1]); w.y = cvt_pk_bf16(v0[2], v0[3]); w.z = cvt_pk_bf16(v1[0], v1[1]); w.w = cvt_pk_bf16(v1[2], v1[3]);
                    *(u32x4*)(rowp + bj * HALF) = w; } }
    }
};
struct EpiGateMul {
    static constexpr bool PERM = true, AFTER_DRAIN = false;
    const bf16_t* Zin; bf16_t* Zout;
    __device__ __forceinline__ void operator()(const f32x4 (&acc)[2][2][4][2], const Unit& u, int wr, int wc, int fr, int fq) const {
        const int row0 = u.pm * BM + wr * 64 + fr, col0 = u.pn * BM + wc * 32 + 8 * fq;
#pragma unroll
        for (int ai = 0; ai < 2; ++ai)
#pragma unroll
            for (int m = 0; m < 4; ++m) { const size_t roff = (size_t)(row0 + ai * HALF + m * 16) * DM + col0; const bf16_t* rowp = Zin + roff; bf16_t* rowo = Zout + roff;
#pragma unroll
                for (int bj = 0; bj < 2; ++bj) { const f32x4 v0 = acc[ai][bj][m][0], v1 = acc[ai][bj][m][1];
                    const u32x4 h = *(const u32x4*)(Zin + hm_idx(row0 + ai * HALF + m * 16, col0 + bj * HALF)); (void)rowp;
                    u32x4 w;
                    w.x = cvt_pk_bf16(bf_lo(h.x) * silu_f(v0[0]), bf_hi(h.x) * silu_f(v0[1]));
                    w.y = cvt_pk_bf16(bf_lo(h.y) * silu_f(v0[2]), bf_hi(h.y) * silu_f(v0[3]));
                    w.z = cvt_pk_bf16(bf_lo(h.z) * silu_f(v1[0]), bf_hi(h.z) * silu_f(v1[1]));
                    w.w = cvt_pk_bf16(bf_lo(h.w) * silu_f(v1[2]), bf_hi(h.w) * silu_f(v1[3]));
                    *(u32x4*)(rowo + bj * HALF) = w; } }
    }
};
struct EpiKr {
    static constexpr bool PERM = true, AFTER_DRAIN = false;
    bf16_t* Kr;
    __device__ __forceinline__ void operator()(const f32x4 (&acc)[2][2][4][2], const Unit& u, int wr, int wc, int fr, int fq) const {
        const int row0 = u.pm * BM + wr * 64 + fr, col0 = u.pn * BM + wc * 32 + 8 * fq;
        const int g = u.pn >> 2, dsh = 2 * g;
#pragma unroll
        for (int ai = 0; ai < 2; ++ai)
#pragma unroll
            for (int m = 0; m < 4; ++m) { const int t = row0 + ai * HALF + m * 16, b = t >> 12, s = t & 4095, r = s & ((1 << dsh) - 1), i = s >> dsh;
                const int rowidx = r * (SEQ >> dsh) + i;
#pragma unroll
                for (int bj = 0; bj < 2; ++bj) { const f32x4 v0 = acc[ai][bj][m][0], v1 = acc[ai][bj][m][1];
                    const int col = col0 + bj * HALF, hh = (col >> 6) & 15, d0 = col & 63;
                    u32x4 w; w.x = cvt_pk_bf16(v0[0], v0[1]); w.y = cvt_pk_bf16(v0[2], v0[3]); w.z = cvt_pk_bf16(v1[0], v1[1]); w.w = cvt_pk_bf16(v1[2], v1[3]);
                    *(u32x4*)(Kr + ((size_t)(((g * 16 + hh) * 4 + b) * SEQ + rowidx)) * 64 + d0) = w; } }
    }
};
template <int DSH> struct EpiVt {
    static constexpr bool PERM = true, AFTER_DRAIN = false;
    bf16_t* Vt;
    __device__ __forceinline__ void operator()(const f32x4 (&acc)[2][2][4][2], const Unit& u, int wr, int wc, int fr, int fq) const {
        const int row0 = u.pm * BM + wr * 64 + fr;
        const int t_tile = u.pn * BM, b = t_tile >> 12, s_tile = t_tile & 4095;
#pragma unroll
        for (int ai = 0; ai < 2; ++ai)
#pragma unroll
            for (int m = 0; m < 4; ++m) { bf16_t* rowp = Vt + (size_t)(row0 + ai * HALF + m * 16) * MT + b * SEQ + (s_tile >> DSH);
#pragma unroll
                for (int bj = 0; bj < 2; ++bj) { const f32x4 v0 = acc[ai][bj][m][0], v1 = acc[ai][bj][m][1];
                    const int c = bj * HALF + wc * 32 + 8 * fq, r = c >> (8 - DSH), il = c & ((256 >> DSH) - 1);
                    u32x4 w; w.x = cvt_pk_bf16(v0[0], v0[1]); w.y = cvt_pk_bf16(v0[2], v0[3]); w.z = cvt_pk_bf16(v1[0], v1[1]); w.w = cvt_pk_bf16(v1[2], v1[3]);
                    *(u32x4*)(rowp + r * (SEQ >> DSH) + il) = w; } }
    }
};

template <bool RES_F32, bool OUT_F, bool OUT_B, bool F16 = false> struct EpiLnFused {
    static constexpr bool PERM = false, AFTER_DRAIN = true;
    const float* hin_f; const bf16_t* hin_b;
    float* out_f; bf16_t* out_b;
    const float* gam; const float* bet;
    unsigned long long* xbuf; unsigned* cnt; unsigned want;
    __device__ __forceinline__ void fused(f32x4 (&acc)[2][2][4][2], const Unit& u, int wr, int wc, int fr, int fq, LAS unsigned char* lds, int wid, int lane) const {
        LAS f32x2* P = (LAS f32x2*)lds;
        LAS f32x2* S = (LAS f32x2*)(lds + 8192);
        const int col0 = u.pn * BM + wc * 32 + 4 * fq;
#pragma unroll
        for (int ai = 0; ai < 2; ++ai)
#pragma unroll
            for (int mp = 0; mp < 2; ++mp) {
                f32x4 hb_[2][2][2];
#pragma unroll
                for (int mi = 0; mi < 2; ++mi) { const int m = mp * 2 + mi; const unsigned off = (unsigned)(u.pm * BM + ai * HALF + wr * 64 + m * 16 + fr) * DM + col0;
#pragma unroll
                    for (int bj = 0; bj < 2; ++bj)
#pragma unroll
                        for (int n = 0; n < 2; ++n) {
                            if constexpr (RES_F32) hb_[mi][bj][n] = *(const f32x4*)(hin_f + off + bj * HALF + n * 16);
                            else { const u32x2 w = *(const u32x2*)(hin_b + off + bj * HALF + n * 16); hb_[mi][bj][n] = (f32x4){__uint_as_float(w.x), __uint_as_float(w.y), 0.f, 0.f}; } } }
                asm volatile("" : "+v"(hb_[0][0][0]), "+v"(hb_[0][0][1]), "+v"(hb_[0][1][0]), "+v"(hb_[0][1][1]), "+v"(hb_[1][0][0]), "+v"(hb_[1][0][1]), "+v"(hb_[1][1][0]), "+v"(hb_[1][1][1]));
#pragma unroll
                for (int mi = 0; mi < 2; ++mi) { const int m = mp * 2 + mi;
#pragma unroll
                    for (int bj = 0; bj < 2; ++bj)
#pragma unroll
                        for (int n = 0; n < 2; ++n) { f32x4 h = hb_[mi][bj][n];
                            if constexpr (!RES_F32) { const unsigned wx = __float_as_uint(h[0]), wy = __float_as_uint(h[1]); if constexpr (F16) h = (f32x4){h_lo(wx), h_hi(wx), h_lo(wy), h_hi(wy)}; else h = (f32x4){bf_lo(wx), bf_hi(wx), bf_lo(wy), bf_hi(wy)}; }
                            acc[ai][bj][m][n] = h * DN_ALPHA + acc[ai][bj][m][n]; }
                    asm volatile("" : "+v"(acc[ai][0][m][0]), "+v"(acc[ai][0][m][1]), "+v"(acc[ai][1][m][0]), "+v"(acc[ai][1][m][1])); }
                asm volatile("" ::: "memory"); }
#pragma unroll
        for (int ai = 0; ai < 2; ++ai)
#pragma unroll
            for (int m = 0; m < 4; ++m) {
                float s = 0.f;
#pragma unroll
                for (int bj = 0; bj < 2; ++bj)
#pragma unroll
                    for (int n = 0; n < 2; ++n) { const f32x4 x = acc[ai][bj][m][n]; s += (x[0] + x[1]) + (x[2] + x[3]); }
                s += __shfl_xor(s, 16); s += __shfl_xor(s, 32);
                const float mw = s * (1.0f / 64.0f); float qq = 0.f;
#pragma unroll
                for (int bj = 0; bj < 2; ++bj)
#pragma unroll
                    for (int n = 0; n < 2; ++n) { const f32x4 d = acc[ai][bj][m][n] - mw; qq += (d[0] * d[0] + d[1] * d[1]) + (d[2] * d[2] + d[3] * d[3]); }
                qq += __shfl_xor(qq, 16); qq += __shfl_xor(qq, 32);
                if (fq == 0) P[(ai * HALF + wr * 64 + m * 16 + fr) * 4 + wc] = (f32x2){mw, qq};
            }
        asm volatile("s_waitcnt lgkmcnt(0)" ::: "memory"); __builtin_amdgcn_s_barrier(); asm volatile("" ::: "memory");
        const int row = wid * 32 + (lane & 31);
        if (lane < 32) {
            const f32x2 a = P[row * 4 + 0], b = P[row * 4 + 1], c = P[row * 4 + 2], d = P[row * 4 + 3];
            const float mt = (a.x + b.x + c.x + d.x) * 0.25f;
            const float da = a.x - mt, db = b.x - mt, dc = c.x - mt, dd = d.x - mt;
            const float m2 = (a.y + b.y) + (c.y + d.y) + 64.0f * ((da * da + db * db) + (dc * dc + dd * dd));
            unsigned long long* slot = xbuf + ((size_t)(u.pm * BM + row) * 4 + u.pn);
            __hip_atomic_store(slot, ((unsigned long long)__float_as_uint(m2) << 32) | __float_as_uint(mt), __ATOMIC_RELAXED, __HIP_MEMORY_SCOPE_AGENT);
        }
        asm volatile("s_waitcnt vmcnt(0)" ::: "memory");
        if (lane == 0) __hip_atomic_fetch_add(cnt + 64 * u.pm, 1u, __ATOMIC_RELAXED, __HIP_MEMORY_SCOPE_AGENT);
        if (wid == 0) {
            unsigned sp = 0;
            while ((unsigned)__builtin_amdgcn_readfirstlane(__hip_atomic_load(cnt + 64 * u.pm, __ATOMIC_RELAXED, __HIP_MEMORY_SCOPE_AGENT)) < want) { __builtin_amdgcn_s_sleep(2); if (++sp > (1u << 22)) break; }
            __builtin_amdgcn_fence(__ATOMIC_ACQUIRE, "agent");
        }
        asm volatile("s_waitcnt vmcnt(0) lgkmcnt(0)" ::: "memory"); __builtin_amdgcn_s_barrier(); asm volatile("" ::: "memory");
        if (lane < 32) {
            const unsigned long long* slot = xbuf + (size_t)(u.pm * BM + row) * 4; float mt[4], m2[4]; float ms = 0.f;
#pragma unroll
            for (int t = 0; t < 4; ++t) { const unsigned long long w = __hip_atomic_load(slot + t, __ATOMIC_RELAXED, __HIP_MEMORY_SCOPE_AGENT); mt[t] = __uint_as_float((unsigned)w); m2[t] = __uint_as_float((unsigned)(w >> 32)); ms += mt[t]; }
            const float mean = ms * 0.25f; float qq = 0.f;
#pragma unroll
            for (int t = 0; t < 4; ++t) { const float dm = mt[t] - mean; qq += m2[t] + 256.0f * dm * dm; }
            S[row] = (f32x2){mean, 1.0f / sqrtf(qq * (1.0f / 1024.0f) + LN_EPS)};
        }
        asm volatile("s_waitcnt lgkmcnt(0)" ::: "memory"); __builtin_amdgcn_s_barrier(); asm volatile("" ::: "memory");
        f32x2 sr[2][4];
#pragma unroll
        for (int ai = 0; ai < 2; ++ai)
#pragma unroll
            for (int m = 0; m < 4; ++m) sr[ai][m] = S[ai * HALF + wr * 64 + m * 16 + fr];
#pragma unroll
        for (int bj = 0; bj < 2; ++bj)
#pragma unroll
            for (int n = 0; n < 2; ++n) { const f32x4 gv = *(const f32x4*)(gam + col0 + bj * HALF + n * 16), bv = *(const f32x4*)(bet + col0 + bj * HALF + n * 16);
#pragma unroll
                for (int ai = 0; ai < 2; ++ai)
#pragma unroll
                    for (int m = 0; m < 4; ++m) { const int r = ai * HALF + wr * 64 + m * 16 + fr; const unsigned off = (unsigned)(u.pm * BM + r) * DM + col0 + bj * HALF + n * 16;
                        const f32x4 o = (acc[ai][bj][m][n] - sr[ai][m].x) * sr[ai][m].y * gv + bv;
                        if constexpr (OUT_F) *(f32x4*)(out_f + off) = o;
                        if constexpr (OUT_B) { u32x2 w; w.x = cvt_pk16<F16>(o[0], o[1]); w.y = cvt_pk16<F16>(o[2], o[3]); *(u32x2*)(out_b + off) = w; } } }
    }
};

template <class Epi, class Sched, int DSH = 0, bool F16 = false, bool SP2 = true, bool ALIGN_EPI = true>
__device__ __forceinline__ void gemm_phase(LAS unsigned char* lds, const Gemm g, const Sched& S, const Epi& E) {
    const int tid = opaque(threadIdx.x), wid = __builtin_amdgcn_readfirstlane(tid >> 6), lane = tid & 63, wr = wid >> 2, wc = wid & 3, fr = lane & 15, fq = lane >> 4;
    const int K = g.K, nt = K / BK;
    unsigned voffA[2], voffB[2], voffB1[2];
#pragma unroll
    for (int i = 0; i < 2; ++i) { int R, C; stage_rc(tid * 16 + i * 8192, R, C); const int Rb = Epi::PERM ? ((R & ~31) + perm32(R & 31)) : R;
        voffA[i] = (unsigned)(R * K + C) * 2u;
        if constexpr (DSH == 0) { voffB[i] = (unsigned)(Rb * K + C) * 2u; voffB1[i] = (unsigned)((Rb + HALF) * K + C) * 2u; }
        else { const int c0_ = Rb, c1_ = Rb + HALF; const int t0_ = ((c0_ & ((256 >> DSH) - 1)) << DSH) + (c0_ >> (8 - DSH)), t1_ = ((c1_ & ((256 >> DSH) - 1)) << DSH) + (c1_ >> (8 - DSH));
            voffB[i] = (unsigned)(t0_ * K + C) * 2u; voffB1[i] = (unsigned)(t1_ * K + C) * 2u; } }
    const size_t kstep = (size_t)(BK * 2);
    const size_t hstep = (size_t)HALF * K * 2;
    const size_t tstep = 2 * hstep;
    const unsigned ldsw = (unsigned)wid * 1024u;
    const int aoff = lds_byte(wr * 64 + fr, fq * 8), boff = lds_byte(wc * 32 + fr, fq * 8);
#define PG8_SA(b, h) (((b) * 2 + (h)) * HTB)
#define PG8_SB(b, h) ((4 + (b) * 2 + (h)) * HTB)
#define PG8_STAGE(bufoff, gbase, voff) do { _Pragma("unroll") for (int _i = 0; _i < 2; ++_i) \
        __builtin_amdgcn_global_load_lds((const unsigned*)((const char*)(gbase) + (voff)[_i]), (LAS unsigned*)(lds + (bufoff) + ldsw + _i * 8192), 16, 0, 0); } while (0)
#define PG8_LDA(dst, b, h) do { _Pragma("unroll") for (int m = 0; m < 4; ++m) _Pragma("unroll") for (int k = 0; k < 2; ++k) dst[m][k] = *(const LAS bf16x8*)(lds + PG8_SA(b, h) + aoff + m * 2048 + k * 1024); } while (0)
#define PG8_LDB(dst, b, h) do { _Pragma("unroll") for (int n = 0; n < 2; ++n) _Pragma("unroll") for (int k = 0; k < 2; ++k) dst[n][k] = *(const LAS bf16x8*)(lds + PG8_SB(b, h) + boff + n * 2048 + k * 1024); } while (0)
#define PG8_MMA(ai, bj, At, Bt) do { __builtin_amdgcn_s_setprio(1); _Pragma("unroll") for (int m = 0; m < 4; ++m) _Pragma("unroll") for (int n = 0; n < 2; ++n) _Pragma("unroll") for (int k = 0; k < 2; ++k) \
        acc[ai][bj][m][n] = F16 ? __builtin_amdgcn_mfma_f32_16x16x32_f16(__builtin_bit_cast(half8, Bt[n][k]), __builtin_bit_cast(half8, At[m][k]), acc[ai][bj][m][n], 0, 0, 0) : __builtin_amdgcn_mfma_f32_16x16x32_bf16(Bt[n][k], At[m][k], acc[ai][bj][m][n], 0, 0, 0); __builtin_amdgcn_s_setprio(0); } while (0)
#define PG8_WAIT_V(n) asm volatile("s_waitcnt vmcnt(" #n ")" ::: "memory")
#define PG8_WAIT_L(n) asm volatile("s_waitcnt lgkmcnt(" #n ")" ::: "memory")
#define PG8_BAR __builtin_amdgcn_s_barrier()
#define PG8_SCHED __builtin_amdgcn_sched_barrier(0)
    Unit cur, nxt; int ui = 0;
    if (!S.next(0, cur)) return;
    f32x4 acc[2][2][4][2];
#pragma unroll
    for (int a = 0; a < 2; ++a)
#pragma unroll
        for (int b = 0; b < 2; ++b)
#pragma unroll
            for (int m = 0; m < 4; ++m)
#pragma unroll
                for (int n = 0; n < 2; ++n) acc[a][b][m][n] = (f32x4){0.f, 0.f, 0.f, 0.f};
    bf16x8 At[4][2], B0[2][2], B1[2][2];
    const char* cA = (const char*)g.A + (size_t)cur.pm * tstep; const char* cB = (const char*)g.Bt + (size_t)cur.pn * tstep;
    if constexpr (SP2) {
        PG8_STAGE(PG8_SB(0, 0), cB, voffB); PG8_STAGE(PG8_SB(0, 1), cB, voffB1); PG8_STAGE(PG8_SA(0, 0), cA, voffA); PG8_STAGE(PG8_SA(0, 1), cA + hstep, voffA);
        if (wr == 1) PG8_BAR;
        PG8_WAIT_V(2); PG8_BAR;
        PG8_STAGE(PG8_SB(1, 0), cB + kstep, voffB); PG8_STAGE(PG8_SA(1, 0), cA + kstep, voffA); PG8_STAGE(PG8_SB(1, 1), cB + kstep, voffB1);
        PG8_WAIT_V(6); PG8_BAR;
    } else {
    PG8_STAGE(PG8_SB(0, 0), cB, voffB); PG8_STAGE(PG8_SA(0, 0), cA, voffA); PG8_STAGE(PG8_SB(0, 1), cB, voffB1); PG8_STAGE(PG8_SA(0, 1), cA + hstep, voffA);
    if (wr == 1) PG8_BAR;
    PG8_WAIT_V(4); PG8_BAR;
    PG8_STAGE(PG8_SB(1, 0), cB + kstep, voffB); PG8_STAGE(PG8_SA(1, 0), cA + kstep, voffA); PG8_STAGE(PG8_SB(1, 1), cB + kstep, voffB1);
    PG8_WAIT_V(6); PG8_BAR;
    }
    for (;;) {
        const bool has_next = S.next(ui + 1, nxt);
        const char* nA = has_next ? (const char*)g.A + (size_t)nxt.pm * tstep : cA; const char* nB = has_next ? (const char*)g.Bt + (size_t)nxt.pn * tstep : cB;
        for (int t = 0; t < nt; t += 2) {
            const bool last = (t == nt - 2);
            const char* a1 = cA + (size_t)(t + 1) * kstep;
            const char* a2 = last ? nA : cA + (size_t)(t + 2) * kstep; const char* b2 = last ? nB : cB + (size_t)(t + 2) * kstep;
            const char* a3 = a2 + kstep; const char* b3 = b2 + kstep;
            if constexpr (SP2) {
            PG8_LDB(B0, 0, 0); PG8_LDB(B1, 0, 1); PG8_SCHED; PG8_LDA(At, 0, 0); PG8_STAGE(PG8_SA(1, 1), a1 + hstep, voffA);
            PG8_WAIT_V(8); PG8_WAIT_L(0); PG8_BAR; PG8_MMA(0, 0, At, B0); PG8_MMA(0, 1, At, B1); PG8_BAR; PG8_SCHED;
            PG8_LDA(At, 0, 1); PG8_STAGE(PG8_SB(0, 0), b2, voffB); PG8_STAGE(PG8_SB(0, 1), b2, voffB1); PG8_STAGE(PG8_SA(0, 0), a2, voffA);
            PG8_WAIT_V(8); PG8_WAIT_L(0); PG8_BAR; PG8_MMA(1, 0, At, B0); PG8_MMA(1, 1, At, B1); PG8_BAR; PG8_SCHED;
            PG8_LDB(B0, 1, 0); PG8_LDB(B1, 1, 1); PG8_SCHED; PG8_LDA(At, 1, 0); PG8_STAGE(PG8_SA(0, 1), a2 + hstep, voffA);
            PG8_WAIT_V(8); PG8_WAIT_L(0); PG8_BAR; PG8_MMA(0, 0, At, B0); PG8_MMA(0, 1, At, B1); PG8_BAR; PG8_SCHED;
            PG8_LDA(At, 1, 1); PG8_STAGE(PG8_SB(1, 0), b3, voffB); PG8_STAGE(PG8_SB(1, 1), b3, voffB1); PG8_STAGE(PG8_SA(1, 0), a3, voffA);
            PG8_WAIT_V(8); PG8_WAIT_L(0); PG8_BAR; PG8_MMA(1, 0, At, B0); PG8_MMA(1, 1, At, B1); PG8_BAR; PG8_SCHED;
            } else {
            PG8_LDB(B0, 0, 0); PG8_SCHED; PG8_LDA(At, 0, 0); PG8_STAGE(PG8_SA(1, 1), a1 + hstep, voffA);
            PG8_WAIT_L(8); PG8_BAR; PG8_WAIT_L(0); PG8_MMA(0, 0, At, B0); PG8_BAR; PG8_SCHED;
            PG8_LDB(B1, 0, 1); PG8_STAGE(PG8_SB(0, 0), b2, voffB);
            PG8_BAR; PG8_WAIT_L(0); PG8_MMA(0, 1, At, B1); PG8_BAR;
            PG8_LDA(At, 0, 1); PG8_STAGE(PG8_SA(0, 0), a2, voffA);
            PG8_BAR; PG8_WAIT_L(0); PG8_MMA(1, 0, At, B0); PG8_BAR; PG8_SCHED;
            PG8_STAGE(PG8_SB(0, 1), b2, voffB1);
            PG8_WAIT_V(6); PG8_BAR; PG8_MMA(1, 1, At, B1); PG8_BAR;
            PG8_LDB(B0, 1, 0); PG8_SCHED; PG8_LDA(At, 1, 0); PG8_STAGE(PG8_SA(0, 1), a2 + hstep, voffA);
            PG8_WAIT_L(8); PG8_BAR; PG8_WAIT_L(0); PG8_MMA(0, 0, At, B0); PG8_BAR; PG8_SCHED;
            PG8_LDB(B1, 1, 1); PG8_STAGE(PG8_SB(1, 0), b3, voffB);
            PG8_BAR; PG8_WAIT_L(0); PG8_MMA(0, 1, At, B1); PG8_BAR;
            PG8_LDA(At, 1, 1); PG8_STAGE(PG8_SA(1, 0), a3, voffA);
            PG8_BAR; PG8_WAIT_L(0); PG8_MMA(1, 0, At, B0); PG8_BAR; PG8_SCHED;
            PG8_STAGE(PG8_SB(1, 1), b3, voffB1);
            PG8_WAIT_V(6); PG8_BAR; PG8_MMA(1, 1, At, B1); PG8_BAR;
            }
        }
        if constexpr (ALIGN_EPI) { if (wr == 0) PG8_BAR; }
        if constexpr (!Epi::AFTER_DRAIN) E(acc, cur, wr, wc, fr, fq);
        if (!has_next) break;
#pragma unroll
        for (int a = 0; a < 2; ++a)
#pragma unroll
            for (int b = 0; b < 2; ++b)
#pragma unroll
                for (int m = 0; m < 4; ++m)
#pragma unroll
                    for (int n = 0; n < 2; ++n) acc[a][b][m][n] = (f32x4){0.f, 0.f, 0.f, 0.f};
        cur = nxt; cA = nA; cB = nB; ++ui;
        if constexpr (ALIGN_EPI) { if (wr == 1) PG8_BAR; }
    }
    PG8_WAIT_V(0);
    if constexpr (!ALIGN_EPI) { if (wr == 0) PG8_BAR; }
    PG8_BAR;
    if constexpr (Epi::AFTER_DRAIN) E.fused(acc, cur, wr, wc, fr, fq, lds, wid, lane);
#undef PG8_SA
#undef PG8_SB
#undef PG8_STAGE
#undef PG8_LDA
#undef PG8_LDB
#undef PG8_MMA
#undef PG8_WAIT_V
#undef PG8_WAIT_L
#undef PG8_BAR
#undef PG8_SCHED
}


#define XB_TMO      128
#define XB_XCNT(j)  (256  + 64 * (j))
#define XB_XSUB(j)  (1280 + 64 * (j))
#define XB_XGEN(j)  (2304 + 64 * (j))
#define XB_TOP      3328
#define XB_TOPGEN   3392
#define XCD_BAR_WORDS 3456
#define XB_SPIN_CAP (1u << 18)
__device__ __forceinline__ unsigned xb_ld(unsigned* p)              { return __hip_atomic_load(p, __ATOMIC_RELAXED, __HIP_MEMORY_SCOPE_AGENT); }
__device__ __forceinline__ unsigned xb_add(unsigned* p, unsigned v) { return __hip_atomic_fetch_add(p, v, __ATOMIC_RELAXED, __HIP_MEMORY_SCOPE_AGENT); }
__device__ __forceinline__ unsigned xb_xcc_id() { return (unsigned)__builtin_amdgcn_s_getreg((3 << 11) | 20) & 0xFu; }
#define XB_SPIN(cond, bar) do { unsigned _sp = 0; while (cond) { __builtin_amdgcn_s_sleep(1); \
    if ((++_sp & 255u) == 0u) { if (xb_ld(&(bar)[XB_TMO])) break; if (_sp > XB_SPIN_CAP) { atomicAdd(&(bar)[XB_TMO], 1u); break; } } } } while (0)
struct XcdBarrier { unsigned* bar; unsigned x; volatile LAS unsigned* st; };
__device__ __forceinline__ XcdBarrier xcd_barrier_post(unsigned* bar, volatile LAS unsigned* st) {
    XcdBarrier b; b.bar = bar; b.x = xb_xcc_id(); b.st = st;
    if (threadIdx.x == 0) (void)xb_add(&bar[XB_XCNT(b.x)], 1u);
    return b;
}
__device__ __forceinline__ void xcd_barrier_complete(unsigned* bar, unsigned x, unsigned& nloc, unsigned& nx) {
    const unsigned G = gridDim.x * gridDim.y * gridDim.z;
    unsigned sum, cnt, mine, sp = 0u;
    for (;;) {
        sum = 0u; cnt = 0u; mine = 0u;
#pragma unroll
        for (unsigned j = 0; j < 16; ++j) { const unsigned c = xb_ld(&bar[XB_XCNT(j)]); sum += c; cnt += (c > 0u) ? 1u : 0u; mine = (j == x) ? c : mine; }
        if (sum == G) break;
        __builtin_amdgcn_s_sleep(1);
        if ((++sp & 255u) == 0u) { if (xb_ld(&bar[XB_TMO])) break; if (sp > XB_SPIN_CAP) { atomicAdd(&bar[XB_TMO], 1u); break; } }
    }
    nloc = mine > 0u ? mine : 1u; nx = cnt > 0u ? cnt : 1u;
}
__device__ __forceinline__ void xcd_barrier(const XcdBarrier& b) {
    asm volatile("s_waitcnt vmcnt(0)" ::: "memory");
    __syncthreads();
    if (threadIdx.x == 0) {
        unsigned* bar = b.bar;
        const unsigned bx = xb_xcc_id();
        __builtin_amdgcn_s_waitcnt(0);
        unsigned nloc = b.st[0], nx = b.st[1];
        if (nloc == 0u) { xcd_barrier_complete(bar, bx, nloc, nx); b.st[0] = nloc; b.st[1] = nx; }
        const unsigned old = xb_add(&bar[XB_XSUB(bx)], 1u);
        const unsigned gen = old / nloc;
        if (old + 1u == (gen + 1u) * nloc) {
            __builtin_amdgcn_fence(__ATOMIC_RELEASE, "agent");
            asm volatile("s_waitcnt vmcnt(0)" ::: "memory");
            const unsigned og = xb_add(&bar[XB_TOP], 1u);
            const unsigned tg = og / nx;
            if (og + 1u == (tg + 1u) * nx) xb_add(&bar[XB_TOPGEN], 1u);
            else XB_SPIN(xb_ld(&bar[XB_TOPGEN]) == tg, bar);
            __builtin_amdgcn_fence(__ATOMIC_ACQUIRE, "agent");
            xb_add(&bar[XB_XGEN(bx)], 1u);
            asm volatile("s_waitcnt vmcnt(0)" ::: "memory");
        } else {
            XB_SPIN(xb_ld(&bar[XB_XGEN(bx)]) == gen, bar);
            __builtin_amdgcn_fence(__ATOMIC_ACQUIRE, "agent");
            asm volatile("s_waitcnt vmcnt(0)" ::: "memory");
        }
    }
    __syncthreads();
}

template <bool F16 = false>
__device__ __forceinline__ void tp_job(const float* src, size_t smat, int lsrc, int coff, bf16_t* dst, size_t dmat, int ldd, int R, int C, int nmat, LAS float* scr) {
    const int tid = opaque(threadIdx.x);
    const int ntc = C / 64, per = (R / 64) * ntc, total = per * nmat;
    const int G = gridDim.x;
    f32x4 v[2];
    int t = blockIdx.x;
#define TP_LOAD(tt_) do { const int i_ = (tt_) / per, t2_ = (tt_) % per, tr_ = t2_ / ntc, tc_ = t2_ % ntc; const float* s_ = src + (size_t)i_ * smat + coff; \
        _Pragma("unroll") for (int k_ = 0; k_ < 2; ++k_) { const int idx_ = tid + 512 * k_, row_ = idx_ >> 4, c4_ = idx_ & 15; v[k_] = *(const f32x4*)(s_ + (size_t)(tr_ * 64 + row_) * lsrc + tc_ * 64 + c4_ * 4); } } while (0)
    if (t < total) TP_LOAD(t);
#pragma unroll 1
    for (; t < total; t += G) {
#pragma unroll
        for (int k = 0; k < 2; ++k) { const int idx = tid + 512 * k, row = idx >> 4, c4 = idx & 15; LAS float* pp = scr + row * 65 + c4 * 4; pp[0] = v[k][0]; pp[1] = v[k][1]; pp[2] = v[k][2]; pp[3] = v[k][3]; }
        if (t + G < total) TP_LOAD(t + G);
        __syncthreads();
        { const int i = t / per, t2 = t % per, tr = t2 / ntc, tc = t2 % ntc; bf16_t* d = dst + (size_t)i * dmat;
          const int c = tid >> 3, ch = tid & 7; const LAS float* sp = scr + (ch * 8) * 65 + c;
          u32x4 o; o.x = cvt_pk16<F16>(sp[0], sp[65]); o.y = cvt_pk16<F16>(sp[2 * 65], sp[3 * 65]); o.z = cvt_pk16<F16>(sp[4 * 65], sp[5 * 65]); o.w = cvt_pk16<F16>(sp[6 * 65], sp[7 * 65]);
          *(u32x4*)(d + (size_t)(tc * 64 + c) * ldd + tr * 64 + ch * 8) = o; }
        __syncthreads();
    }
#undef TP_LOAD
}

struct Params {
    const float *x, *w_in_a, *w_grp_a, *scale_a, *w_out_a, *w_kv, *w_in_b, *w_out_b, *ln_g, *ln_b;
    float* out; unsigned char* ws;
};

__device__ __forceinline__ void phase_prepA(const Params& p, LAS unsigned char* lds) {
    LAS float* scr = (LAS float*)lds;
    unsigned char* ws = p.ws;
    tp_job<true>(p.w_grp_a, (size_t)512 * 512, 512, 0, (bf16_t*)(ws + OFF_WGT), (size_t)512 * 512, 512, 512, 512, 8, scr);
    { bf16_t* winu = (bf16_t*)(ws + OFF_WINU);
      const int total = 2 * 4 * 1024 * 64;
      const int tid = opaque(threadIdx.x);
#pragma unroll 1
      for (int i0 = blockIdx.x * 512 + tid; i0 < total; i0 += gridDim.x * 512 * 4) {
          f32x4 a[4], b[4];
#pragma unroll
          for (int u = 0; u < 4; ++u) { const int i = i0 + u * gridDim.x * 512; if (i < total) { const int c8 = i & 63, k = (i >> 6) & 1023, lg = i >> 16, l = lg >> 2, g = lg & 3;
              const float* s = p.w_in_a + ((size_t)l * 1024 + k) * 4096 + g * 512 + c8 * 8; a[u] = *(const f32x4*)s; b[u] = *(const f32x4*)(s + 4); } }
#pragma unroll
          for (int u = 0; u < 4; ++u) { const int i = i0 + u * gridDim.x * 512; if (i < total) {
              u32x4 o; o.x = cvt_pk_f16(a[u][0], a[u][1]); o.y = cvt_pk_f16(a[u][2], a[u][3]); o.z = cvt_pk_f16(b[u][0], b[u][1]); o.w = cvt_pk_f16(b[u][2], b[u][3]);
              *(u32x4*)(winu + (size_t)i * 8) = o; } } } }
}
__device__ __forceinline__ void phase_prepB(const Params& p, LAS unsigned char* lds) {
    LAS float* scr = (LAS float*)lds;
    unsigned char* ws = p.ws;
    tp_job<true>(p.w_in_a, (size_t)1024 * 4096, 4096, 2048, (bf16_t*)(ws + OFF_BTA) + (size_t)2048 * 1024, (size_t)4096 * 1024, 1024, 1024, 2048, 2, scr);
    tp_job(p.w_out_a, (size_t)2048 * 1024, 1024, 0, (bf16_t*)(ws + OFF_WOA), (size_t)1024 * 2048, 2048, 2048, 1024, 2, scr);
    tp_job<true>(p.w_kv, 0, 6144, 0, (bf16_t*)(ws + OFF_KVT), 0, 1024, 1024, 6144, 1, scr);
    tp_job<true>(p.w_in_b, (size_t)1024 * 4096, 4096, 0, (bf16_t*)(ws + OFF_INB), (size_t)4096 * 1024, 1024, 1024, 4096, 2, scr);
    { bf16_t* hb = (bf16_t*)(ws + OFF_HB);
      const int total = MT * DM / 8;
      const int tid = opaque(threadIdx.x);
      const int nb_ = (int)gridDim.x - 64;
      if (blockIdx.x >= 64)
#pragma unroll 1
      for (int i0 = ((int)blockIdx.x - 64) * 512 + tid; i0 < total; i0 += nb_ * 512 * 4) {
          f32x4 a[4], b[4];
#pragma unroll
          for (int u = 0; u < 4; ++u) { const int i = i0 + u * nb_ * 512; if (i < total) { const float* s = p.x + (size_t)i * 8; a[u] = *(const f32x4*)s; b[u] = *(const f32x4*)(s + 4); } }
#pragma unroll
          for (int u = 0; u < 4; ++u) { const int i = i0 + u * nb_ * 512; if (i < total) {
              u32x4 o; o.x = cvt_pk_f16(a[u][0], a[u][1]); o.y = cvt_pk_f16(a[u][2], a[u][3]); o.z = cvt_pk_f16(b[u][0], b[u][1]); o.w = cvt_pk_f16(b[u][2], b[u][3]);
              *(u32x4*)(hb + (size_t)i * 8) = o; } } } }
}

__device__ __forceinline__ void unpack8(const u32x4 w, float (&f)[8]) { f[0] = bf_lo(w.x); f[1] = bf_hi(w.x); f[2] = bf_lo(w.y); f[3] = bf_hi(w.y); f[4] = bf_lo(w.z); f[5] = bf_hi(w.z); f[6] = bf_lo(w.w); f[7] = bf_hi(w.w); }
template <int W>
__device__ __forceinline__ void pool_item(const bf16_t* V, bf16_t* SG, const float (&sc)[8], int t0, int c0) {
    const int s0 = t0 & (SEQ - 1);
    u32x4 rows[W + 3], gts[4];
#pragma unroll
    for (int j = 0; j < W + 3; ++j) { const int dt = j - (W - 1); rows[j] = (u32x4){0u, 0u, 0u, 0u}; if (s0 + dt >= 0) rows[j] = *(const u32x4*)(V + (size_t)(t0 + dt) * 2048 + c0); }
#pragma unroll
    for (int i = 0; i < 4; ++i) gts[i] = *(const u32x4*)(SG + (size_t)(t0 + i) * 2048 + c0);
    float sum[8];
#pragma unroll
    for (int j = 0; j < 8; ++j) sum[j] = 0.f;
#pragma unroll
    for (int j = 0; j < W - 1; ++j) { float f[8]; unpack8(rows[j], f);
#pragma unroll
        for (int k = 0; k < 8; ++k) sum[k] += f[k]; }
#pragma unroll
    for (int i = 0; i < 4; ++i) {
        float f[8], gt[8]; unpack8(rows[W - 1 + i], f); unpack8(gts[i], gt);
#pragma unroll
        for (int k = 0; k < 8; ++k) sum[k] += f[k];
        const int s = s0 + i; const float inv = 1.0f / (float)(s + 1 < W ? s + 1 : W);
        float o[8];
#pragma unroll
        for (int k = 0; k < 8; ++k) o[k] = (sum[k] * inv - f[k]) * sc[k] * gt[k];
        u32x4 wv; wv.x = cvt_pk_bf16(o[0], o[1]); wv.y = cvt_pk_bf16(o[2], o[3]); wv.z = cvt_pk_bf16(o[4], o[5]); wv.w = cvt_pk_bf16(o[6], o[7]);
        *(u32x4*)(SG + (size_t)(t0 + i) * 2048 + c0) = wv;
        float fo[8]; unpack8(rows[i], fo);
#pragma unroll
        for (int k = 0; k < 8; ++k) sum[k] -= fo[k];
    }
}
__device__ __forceinline__ void phase_pool(const bf16_t* V, bf16_t* SG, const float* scale) {
    const int tid = opaque(threadIdx.x), cth = tid & 255, sub = tid >> 8;
    const int c0 = cth * 8, grp = c0 >> 9;
    float sc[8];
    { const f32x4 a = *(const f32x4*)(scale + c0), b = *(const f32x4*)(scale + c0 + 4); sc[0] = a[0]; sc[1] = a[1]; sc[2] = a[2]; sc[3] = a[3]; sc[4] = b[0]; sc[5] = b[1]; sc[6] = b[2]; sc[7] = b[3]; }
    const int qper = (MT / 4) / (int)gridDim.x;
#pragma unroll 1
    for (int qi = sub; qi < qper; qi += 2) {
        const int q = blockIdx.x * qper + qi;
        const int t0 = q * 4;
        if (grp == 0) pool_item<2>(V, SG, sc, t0, c0);
        else if (grp == 1) pool_item<4>(V, SG, sc, t0, c0);
        else if (grp == 2) pool_item<8>(V, SG, sc, t0, c0);
        else pool_item<16>(V, SG, sc, t0, c0);
    }
}

template <int V_> struct AttIC { static constexpr int value = V_; };
struct AttGeo { int dsh, dil, L, nblk, g; };
__device__ __forceinline__ void att_decode(const AttGeo& G_, int it, int& hh, int& b, int& r, int& n) { n = it & (G_.nblk - 1); const int y = it >> (5 - G_.dsh); r = y & (G_.dil - 1); const int z = y >> G_.dsh; b = z & 3; hh = z >> 2; }
__device__ __forceinline__ void att_dma_half(const AttGeo& G_, const bf16_t* Kr, const bf16_t* Vt, int it, int which, int slot, LAS unsigned char* lds, int wid, int lane0) {
    int hh, b, r, n; att_decode(G_, it, hh, b, r, n);
    const int lane = opaque(lane0);
    int blk = n - 1 + which; blk = blk < 0 ? 0 : blk;
    const bf16_t* kb = Kr + ((size_t)(((G_.g * 16 + hh) * 4 + b) * SEQ + r * G_.L + blk * 128)) * 64;
    const bf16_t* vb = Vt + (size_t)(G_.g * 1024 + hh * 64) * MT + b * SEQ + r * G_.L + blk * 128;
    LAS unsigned char* kl = lds + slot * 32768; LAS unsigned char* vl = kl + 16384;
#pragma unroll
    for (int rd = 0; rd < 2; ++rd) { const int ch = rd * 8 + wid; const int rho = ch * 8 + (lane >> 3); const int cs = (lane & 7) ^ ((rho >> 1) & 7);
        __builtin_amdgcn_global_load_lds((const unsigned*)(kb + (size_t)rho * 64 + cs * 8), (LAS unsigned*)(kl + ch * 1024), 16, 0, 0); }
#pragma unroll
    for (int rd = 0; rd < 2; ++rd) { const int ch = rd * 8 + wid; const int d = ch * 4 + (lane >> 4); const int cs = (lane & 15) ^ (d & 15);
        __builtin_amdgcn_global_load_lds((const unsigned*)(vb + (size_t)d * MT + cs * 8), (LAS unsigned*)(vl + ch * 1024), 16, 0, 0); }
}
__device__ __forceinline__ int att_first_item() { return ((blockIdx.x & 7) * 32 + (blockIdx.x >> 3)) * 8; }
__device__ __forceinline__ void attn_issue_first(const bf16_t* Kr, const bf16_t* Vt, int g, LAS unsigned char* lds) {
    const int tid = opaque(threadIdx.x), wid = __builtin_amdgcn_readfirstlane(tid >> 6), lane0 = tid & 63;
    AttGeo G_; G_.g = g; G_.dsh = 2 * g; G_.dil = 1 << G_.dsh; G_.L = SEQ >> G_.dsh; G_.nblk = G_.L >> 7;
    const int it = att_first_item();
    att_dma_half(G_, Kr, Vt, it, 0, 3, lds, wid, lane0);
    att_dma_half(G_, Kr, Vt, it, 1, 0, lds, wid, lane0);
}
template <bool PRE>
__device__ __forceinline__ void phase_attn(const bf16_t* Q, const bf16_t* Kr, const bf16_t* Vt, bf16_t* ACC, float* LSE, int g, LAS unsigned char* lds) {
    const int tid = opaque(threadIdx.x), wid = __builtin_amdgcn_readfirstlane(tid >> 6), lane0 = tid & 63, q0 = lane0 & 15, q40 = lane0 >> 4;
    AttGeo G_; G_.g = g; G_.dsh = 2 * g; G_.dil = 1 << G_.dsh; G_.L = SEQ >> G_.dsh; G_.nblk = G_.L >> 7;
    const int dsh = G_.dsh, dil = G_.dil;
    const int it0 = att_first_item();
    bf16x8 qf[2]; u32x2 oldacc[4]; float oldlse = 0.f; int tq = 0, hh = 0, n = 0;
    {
        if constexpr (!PRE) { att_dma_half(G_, Kr, Vt, it0, 0, 3, lds, wid, lane0); att_dma_half(G_, Kr, Vt, it0, 1, 0, lds, wid, lane0); }
        int b, r; att_decode(G_, it0, hh, b, r, n);
        tq = b * SEQ + ((n * 128 + wid * 16 + q0) << dsh) + r;
#pragma unroll
        for (int ks = 0; ks < 2; ++ks) qf[ks] = *(const bf16x8*)(Q + ((size_t)hh * MT + tq) * 64 + ks * 32 + q40 * 8);
        if (g > 0) { oldlse = LSE[(size_t)hh * MT + tq];
#pragma unroll
            for (int dt = 0; dt < 4; ++dt) oldacc[dt] = *(const u32x2*)(ACC + ((size_t)hh * MT + tq) * 64 + q40 * 4 + dt * 16); }
    }
    u32x2 pend[4]; float pend_lse = 0.f; int pend_tq = 0, pend_hh = 0; bool have_pend = false;
    auto item_body = [&](auto kkc, int k) __attribute__((always_inline)) {
        constexpr int KK = decltype(kkc)::value;
        constexpr int SC = KK, SP = (KK + 3) & 3, SN = (KK + 1) & 3;
        asm volatile("s_waitcnt vmcnt(0)" ::: "memory");
        __builtin_amdgcn_s_barrier();
        asm volatile("" ::: "memory");
        asm volatile("" : "+v"(qf[0]), "+v"(qf[1]), "+v"(oldacc[0]), "+v"(oldacc[1]), "+v"(oldacc[2]), "+v"(oldacc[3]), "+v"(oldlse));
        if (have_pend) {
            bf16_t* pp = ACC + ((size_t)pend_hh * MT + pend_tq) * 64 + q40 * 4;
#pragma unroll
            for (int dt = 0; dt < 4; ++dt) *(u32x2*)(pp + dt * 16) = pend[dt];
            if (q40 == 0) LSE[(size_t)pend_hh * MT + pend_tq] = pend_lse;
        }
        const int q = opaque(q0), q4 = opaque(q40);
        bf16x8 qn[2]; u32x2 oldn[4]; float oldlsen = 0.f; int tqn = 0, hhn = 0, nn = 0;
        if (k + 1 < 8) {
            const int itn = it0 + k + 1;
            att_dma_half(G_, Kr, Vt, itn, 1, SN, lds, wid, lane0);
            int b, r; att_decode(G_, itn, hhn, b, r, nn);
            tqn = b * SEQ + ((nn * 128 + wid * 16 + q) << dsh) + r;
#pragma unroll
            for (int ks = 0; ks < 2; ++ks) qn[ks] = *(const bf16x8*)(Q + ((size_t)hhn * MT + tqn) * 64 + ks * 32 + q4 * 8);
            if (g > 0) { oldlsen = LSE[(size_t)hhn * MT + tqn];
#pragma unroll
                for (int dt = 0; dt < 4; ++dt) oldn[dt] = *(const u32x2*)(ACC + ((size_t)hhn * MT + tqn) * 64 + q4 * 4 + dt * 16); }
        }
        const float slope = __builtin_amdgcn_exp2f(-8.0f * (float)(g * 16 + hh + 1) / 48.0f);
        const float bias2 = slope * (float)dil * LOG2E;
        f32x4 sacc[9];
        {
            bf16x8 kf[9][2];
#pragma unroll
            for (int kt = 0; kt < 9; ++kt) { const int t16 = wid + kt; const int rl = (t16 & 7) * 16 + q, sw = (rl >> 1) & 7;
                const LAS unsigned char* kb_ = (t16 >= 8) ? (lds + SC * 32768) : (lds + SP * 32768);
                kf[kt][0] = *(const LAS bf16x8*)(kb_ + rl * 128 + ((q4 ^ sw) * 16));
                kf[kt][1] = *(const LAS bf16x8*)(kb_ + rl * 128 + (((4 + q4) ^ sw) * 16)); }
            asm volatile("" : "+v"(kf[0][0]), "+v"(kf[0][1]), "+v"(kf[1][0]), "+v"(kf[1][1]), "+v"(kf[2][0]), "+v"(kf[2][1]), "+v"(kf[3][0]), "+v"(kf[3][1]), "+v"(kf[4][0]), "+v"(kf[4][1]));
            asm volatile("" : "+v"(kf[5][0]), "+v"(kf[5][1]), "+v"(kf[6][0]), "+v"(kf[6][1]), "+v"(kf[7][0]), "+v"(kf[7][1]), "+v"(kf[8][0]), "+v"(kf[8][1]));
#pragma unroll
            for (int kt = 0; kt < 9; ++kt) { f32x4 a = (f32x4){0.f, 0.f, 0.f, 0.f};
                a = __builtin_amdgcn_mfma_f32_16x16x32_bf16(kf[kt][0], qf[0], a, 0, 0, 0);
                sacc[kt] = a; }
#pragma unroll
            for (int kt = 0; kt < 9; ++kt) sacc[kt] = __builtin_amdgcn_mfma_f32_16x16x32_bf16(kf[kt][1], qf[1], sacc[kt], 0, 0, 0);
        }
        const float relb = (float)(128 + q - q4 * 4);
        const float a0 = -bias2 * relb;
        float mx = -1e30f;
#pragma unroll
        for (int kt = 0; kt < 9; ++kt)
#pragma unroll
            for (int jj = 0; jj < 4; ++jj) {
                float s = __builtin_fmaf(sacc[kt][jj], 0.125f * LOG2E, __builtin_fmaf(bias2, (float)(kt * 16 + jj), a0));
                if (kt == 0) { if (q4 * 4 + jj < q) s = -1e30f; }
                if (kt == 8) { if (q4 * 4 + jj > q) s = -1e30f; }
                sacc[kt][jj] = s; }
        if (n == 0) {
#pragma unroll
            for (int kt = 0; kt < 8; ++kt)
#pragma unroll
                for (int jj = 0; jj < 4; ++jj) if (wid * 16 + kt * 16 + q4 * 4 + jj < 128) sacc[kt][jj] = -1e30f;
        }
#pragma unroll
        for (int kt = 0; kt < 9; ++kt)
#pragma unroll
            for (int jj = 0; jj < 4; ++jj) mx = fmaxf(mx, sacc[kt][jj]);
        mx = fmaxf(mx, __shfl_xor(mx, 16)); mx = fmaxf(mx, __shfl_xor(mx, 32));
        float lsum = 0.f;
#pragma unroll
        for (int kt = 0; kt < 9; ++kt)
#pragma unroll
            for (int jj = 0; jj < 4; ++jj) { const float pv = __builtin_amdgcn_exp2f(sacc[kt][jj] - mx); sacc[kt][jj] = pv; lsum += pv; }
        lsum += __shfl_xor(lsum, 16); lsum += __shfl_xor(lsum, 32);
        f32x4 oacc[4];
#pragma unroll
        for (int dt = 0; dt < 4; ++dt) oacc[dt] = (f32x4){0.f, 0.f, 0.f, 0.f};
#pragma unroll
        for (int kp2 = 0; kp2 < 5; ++kp2) {
            u32x4 pw; pw.x = cvt_pk_bf16(sacc[2 * kp2][0], sacc[2 * kp2][1]); pw.y = cvt_pk_bf16(sacc[2 * kp2][2], sacc[2 * kp2][3]);
            if (kp2 < 4) { pw.z = cvt_pk_bf16(sacc[kp2 < 4 ? 2 * kp2 + 1 : 8][0], sacc[kp2 < 4 ? 2 * kp2 + 1 : 8][1]); pw.w = cvt_pk_bf16(sacc[kp2 < 4 ? 2 * kp2 + 1 : 8][2], sacc[kp2 < 4 ? 2 * kp2 + 1 : 8][3]); }
            else { pw.z = 0u; pw.w = 0u; }
            bf16x8 pf; __builtin_memcpy(&pf, &pw, 16);
            const int chb = 2 * wid + 4 * kp2;
            const LAS unsigned char* v0b = ((chb >> 4) ? (lds + SC * 32768) : (lds + SP * 32768)) + 16384;
            const LAS unsigned char* v1b = (((chb + 2) >> 4) ? (lds + SC * 32768) : (lds + SP * 32768)) + 16384;
            const int c0 = (chb & 15) + (q4 >> 1), c1 = ((chb + 2) & 15) + (q4 >> 1);
#pragma unroll
            for (int dt = 0; dt < 4; ++dt) {
                const int d = dt * 16 + q;
                const int roff = d * 256 + (q4 & 1) * 8;
                u32x4 vw; const u32x2 lo = *(const LAS u32x2*)(v0b + roff + ((c0 ^ q) * 16)); vw.x = lo.x; vw.y = lo.y;
                if (kp2 < 4) { const u32x2 hi = *(const LAS u32x2*)(v1b + roff + ((c1 ^ q) * 16)); vw.z = hi.x; vw.w = hi.y; } else { vw.z = 0u; vw.w = 0u; }
                bf16x8 vf; __builtin_memcpy(&vf, &vw, 16);
                oacc[dt] = __builtin_amdgcn_mfma_f32_16x16x32_bf16(vf, pf, oacc[dt], 0, 0, 0);
            }
            __builtin_amdgcn_sched_barrier(0);
        }
        const float inv = 1.0f / lsum;
        float lse = (mx + __log2f(lsum)) * LN2;
        float w_new = inv, w_old = 0.f;
        if (g > 0) {
            const float mm = fmaxf(oldlse, lse), e0 = __expf(oldlse - mm), e1 = __expf(lse - mm), tot = e0 + e1;
            w_old = e0 / tot; w_new = inv * (e1 / tot); lse = mm + __logf(tot);
        }
#pragma unroll
        for (int dt = 0; dt < 4; ++dt) {
            f32x4 o = oacc[dt] * w_new;
            if (g > 0) { const u32x2 pr = oldacc[dt]; o[0] += w_old * bf_lo(pr.x); o[1] += w_old * bf_hi(pr.x); o[2] += w_old * bf_lo(pr.y); o[3] += w_old * bf_hi(pr.y); }
            u32x2 w; w.x = cvt_pk_bf16(o[0], o[1]); w.y = cvt_pk_bf16(o[2], o[3]);
            pend[dt] = w;
        }
        pend_lse = lse; pend_tq = tq; pend_hh = hh; have_pend = true;
        qf[0] = qn[0]; qf[1] = qn[1]; oldlse = oldlsen; tq = tqn; hh = hhn; n = nn;
#pragma unroll
        for (int dt = 0; dt < 4; ++dt) oldacc[dt] = oldn[dt];
    };
#pragma unroll 1
    for (int kq = 0; kq < 2; ++kq) { item_body(AttIC<0>{}, 4 * kq); item_body(AttIC<1>{}, 4 * kq + 1); item_body(AttIC<2>{}, 4 * kq + 2); item_body(AttIC<3>{}, 4 * kq + 3); }
    if (have_pend) {
        bf16_t* pp = ACC + ((size_t)pend_hh * MT + pend_tq) * 64 + q40 * 4;
#pragma unroll
        for (int dt = 0; dt < 4; ++dt) *(u32x2*)(pp + dt * 16) = pend[dt];
        if (q40 == 0) LSE[(size_t)pend_hh * MT + pend_tq] = pend_lse;
    }
    asm volatile("s_waitcnt vmcnt(0)" ::: "memory");
    __builtin_amdgcn_s_barrier();
}

__global__ void __launch_bounds__(512, 2) yoco_fwd(Params p) {
    extern __shared__ __attribute__((aligned(16))) unsigned char smem[];
    LAS unsigned char* lds = (LAS unsigned char*)smem;
    cg::grid_group grid = cg::this_grid();
    volatile LAS unsigned* xst = (volatile LAS unsigned*)(lds + 131072);
    if (threadIdx.x < 4) xst[threadIdx.x] = 0u;
    __syncthreads();
    const XcdBarrier xb = xcd_barrier_post((unsigned*)(p.ws + OFF_BAR), xst);
    if (p.ws == nullptr) grid.sync();
    unsigned char* ws = p.ws;
    const int G = gridDim.x, c = blockIdx.x;
    bf16_t* HB = (bf16_t*)(ws + OFF_HB);

    phase_prepA(p, lds);
    xcd_barrier(xb);
    { SingleUnit S; S.has = c < 64; const int lg = c >> 3, un = c & 7; S.u0.pm = un >> 2; S.u0.pn = un & 3;
      Gemm gm; gm.A = (const bf16_t*)(ws + OFF_WGT) + (size_t)lg * 512 * 512; gm.Bt = (const bf16_t*)(ws + OFF_WINU) + (size_t)lg * 1024 * 512; gm.M = 512; gm.N = 1024; gm.K = 512;
      EpiStore16<true> E; E.O = (bf16_t*)(ws + OFF_BTA) + (size_t)(lg >> 2) * 4096 * 1024 + (size_t)(lg & 3) * 512 * 1024; E.ldc = 1024;
      gemm_phase<EpiStore16<true>, SingleUnit, 0, true>(lds, gm, S, E); }
    phase_prepB(p, lds);
    xcd_barrier(xb);
    for (int l = 0; l < 2; ++l) {
        { StaticOrder S; S.init(MT, 4096, G, c); Gemm gm; gm.A = HB; gm.Bt = (const bf16_t*)(ws + OFF_BTA) + (size_t)l * 4096 * 1024; gm.M = MT; gm.N = 4096; gm.K = 1024;
          EpiAG1 E; E.V = (bf16_t*)(ws + OFF_V); E.SG = (bf16_t*)(ws + OFF_SG); gemm_phase<EpiAG1, StaticOrder, 0, true>(lds, gm, S, E); }
        xcd_barrier(xb);
        phase_pool((const bf16_t*)(ws + OFF_V), (bf16_t*)(ws + OFF_SG), p.scale_a + l * 2048);
        xcd_barrier(xb);
        { StaticOrder S; S.init(MT, 1024, G, c); Gemm gm; gm.A = (const bf16_t*)(ws + OFF_SG); gm.Bt = (const bf16_t*)(ws + OFF_WOA) + (size_t)l * 1024 * 2048; gm.M = MT; gm.N = 1024; gm.K = 2048;
          if (l == 0) { EpiLnFused<false, false, true, true> E; E.hin_f = nullptr; E.hin_b = HB; E.out_f = nullptr; E.out_b = HB; E.gam = p.ln_g; E.bet = p.ln_b;
              E.xbuf = (unsigned long long*)(ws + OFF_XBUF); E.cnt = (unsigned*)(ws + OFF_CNT); E.want = 32u; gemm_phase(lds, gm, S, E); }
          else { EpiLnFused<false, false, true, true> E; E.hin_f = nullptr; E.hin_b = HB; E.out_f = nullptr; E.out_b = HB; E.gam = p.ln_g + DM; E.bet = p.ln_b + DM;
              E.xbuf = (unsigned long long*)(ws + OFF_XBUF); E.cnt = (unsigned*)(ws + OFF_CNT); E.want = 64u; gemm_phase(lds, gm, S, E); } }
        xcd_barrier(xb);
    }
    { StaticOrder S; S.init(MT, 3072, G, c); Gemm gm; gm.A = HB; gm.Bt = (const bf16_t*)(ws + OFF_KVT); gm.M = MT; gm.N = 3072; gm.K = 1024;
      EpiKr E; E.Kr = (bf16_t*)(ws + OFF_K); gemm_phase<EpiKr, StaticOrder, 0, true>(lds, gm, S, E); }
    { StaticOrder S; S.init(1024, MT, G, c); Gemm gm; gm.Bt = HB; gm.M = 1024; gm.N = MT; gm.K = 1024;
      gm.A = (const bf16_t*)(ws + OFF_KVT) + (size_t)(3072 + 0) * 1024;    { EpiVt<0> E; E.Vt = (bf16_t*)(ws + OFF_VT) + (size_t)0 * MT;    gemm_phase<EpiVt<0>, StaticOrder, 0, true>(lds, gm, S, E); }
      gm.A = (const bf16_t*)(ws + OFF_KVT) + (size_t)(3072 + 1024) * 1024; { EpiVt<2> E; E.Vt = (bf16_t*)(ws + OFF_VT) + (size_t)1024 * MT; gemm_phase<EpiVt<2>, StaticOrder, 2, true>(lds, gm, S, E); }
      gm.A = (const bf16_t*)(ws + OFF_KVT) + (size_t)(3072 + 2048) * 1024; { EpiVt<4> E; E.Vt = (bf16_t*)(ws + OFF_VT) + (size_t)2048 * MT; gemm_phase<EpiVt<4>, StaticOrder, 4, true>(lds, gm, S, E); } }
    bf16_t* QG = (bf16_t*)p.out; bf16_t* QY = (bf16_t*)p.out + (size_t)MT * DM; bf16_t* ACC = QG; float* LSE = (float*)(ws + OFF_LSE);
    for (int j = 0; j < 2; ++j) {
        const bf16_t* inb = (const bf16_t*)(ws + OFF_INB) + (size_t)j * 4096 * 1024;
        { StaticOrder S; S.init(MT, 2048, G, c); Gemm gm; gm.A = HB; gm.Bt = inb; gm.M = MT; gm.N = 2048; gm.K = 1024;
          EpiStoreSplit E; E.O0 = QG; E.O1 = QY; gemm_phase<EpiStoreSplit, StaticOrder, 0, true>(lds, gm, S, E); }
        if (j != 0) attn_issue_first((const bf16_t*)(ws + OFF_K), (const bf16_t*)(ws + OFF_VT), 0, lds);
        xcd_barrier(xb);
        if (j == 0) { tp_job(p.w_out_b, (size_t)1024 * 1024, 1024, 0, (bf16_t*)(ws + OFF_OUTB), (size_t)1024 * 1024, 1024, 1024, 1024, 2, (LAS float*)lds);
                      phase_attn<false>(QG, (const bf16_t*)(ws + OFF_K), (const bf16_t*)(ws + OFF_VT), QG, LSE, 0, lds); }
        else phase_attn<true>(QG, (const bf16_t*)(ws + OFF_K), (const bf16_t*)(ws + OFF_VT), QG, LSE, 0, lds);
        attn_issue_first((const bf16_t*)(ws + OFF_K), (const bf16_t*)(ws + OFF_VT), 1, lds);
        xcd_barrier(xb);
        phase_attn<true>(QY, (const bf16_t*)(ws + OFF_K), (const bf16_t*)(ws + OFF_VT), QG, LSE, 1, lds);
        xcd_barrier(xb);
        { StaticOrder S; S.init(MT, 1024, G, c); Gemm gm; gm.A = HB; gm.Bt = inb + (size_t)2 * 1024 * 1024; gm.M = MT; gm.N = 1024; gm.K = 1024;
          EpiStore16<false, true> E; E.O = QY; E.ldc = 1024; gemm_phase<EpiStore16<false, true>, StaticOrder, 0, true>(lds, gm, S, E); }
        attn_issue_first((const bf16_t*)(ws + OFF_K), (const bf16_t*)(ws + OFF_VT), 2, lds);
        xcd_barrier(xb);
        phase_attn<true>(QY, (const bf16_t*)(ws + OFF_K), (const bf16_t*)(ws + OFF_VT), QG, LSE, 2, lds);
        xcd_barrier(xb);
        bf16_t* ZB = j == 0 ? QY : (bf16_t*)(ws + OFF_K);
        { StaticOrder S; S.init(MT, 1024, G, c); Gemm gm; gm.A = HB; gm.Bt = inb + (size_t)3 * 1024 * 1024; gm.M = MT; gm.N = 1024; gm.K = 1024;
          EpiGateMul E; E.Zin = ACC; E.Zout = ZB; gemm_phase<EpiGateMul, StaticOrder, 0, true>(lds, gm, S, E); }
        xcd_barrier(xb);
        { StaticOrder S; S.init(MT, 1024, G, c); Gemm gm; gm.A = ZB; gm.Bt = (const bf16_t*)(ws + OFF_OUTB) + (size_t)j * 1024 * 1024; gm.M = MT; gm.N = 1024; gm.K = 1024;
          if (j == 0) { EpiLnFused<false, false, true, true> E; E.hin_f = nullptr; E.hin_b = HB; E.out_f = nullptr; E.out_b = HB; E.gam = p.ln_g + 2 * DM; E.bet = p.ln_b + 2 * DM;
              E.xbuf = (unsigned long long*)(ws + OFF_XBUF); E.cnt = (unsigned*)(ws + OFF_CNT); E.want = 96u; gemm_phase(lds, gm, S, E); }
          else { EpiLnFused<false, true, false, true> E; E.hin_f = nullptr; E.hin_b = HB; E.out_f = p.out; E.out_b = nullptr; E.gam = p.ln_g + 3 * DM; E.bet = p.ln_b + 3 * DM;
              E.xbuf = (unsigned long long*)(ws + OFF_XBUF); E.cnt = (unsigned*)(ws + OFF_CNT); E.want = 128u; gemm_phase(lds, gm, S, E); } }
        if (j == 0) xcd_barrier(xb);
    }
}

extern "C" void kernel_launch(void* const* d_in, const int* in_sizes, int n_in, void* d_out, int out_size, void* d_ws, size_t ws_size, hipStream_t stream) {
    static int grid = 0;
    if (grid == 0) {
        if (n_in != 10 || out_size != MT * DM || ws_size < WS_NEED) { fprintf(stderr, "kernel_launch: unexpected shapes / workspace (n_in %d out %d ws %zu)\n", n_in, out_size, ws_size); grid = -1; return; }
        int dev = 0, cus = 0, per_cu = 0;
        hipGetDevice(&dev);
        hipDeviceGetAttribute(&cus, hipDeviceAttributeMultiprocessorCount, dev);
        hipFuncSetAttribute((const void*)yoco_fwd, hipFuncAttributeMaxDynamicSharedMemorySize, LDS_BYTES);
        hipOccupancyMaxActiveBlocksPerMultiprocessor(&per_cu, (const void*)yoco_fwd, 512, LDS_BYTES);
        if (per_cu < 1) per_cu = 1;
        (void)hipGetLastError();
        grid = cus;
    }
    if (grid < 0) return;
    Params p{};
    p.x = (const float*)d_in[0]; p.w_in_a = (const float*)d_in[1]; p.w_grp_a = (const float*)d_in[2]; p.scale_a = (const float*)d_in[3]; p.w_out_a = (const float*)d_in[4];
    p.w_kv = (const float*)d_in[5]; p.w_in_b = (const float*)d_in[6]; p.w_out_b = (const float*)d_in[7]; p.ln_g = (const float*)d_in[8]; p.ln_b = (const float*)d_in[9];
    p.out = (float*)d_out; p.ws = (unsigned char*)d_ws;
    if (hipMemsetAsync((unsigned char*)d_ws + OFF_BAR, 0, 32768, stream) != hipSuccess) { fprintf(stderr, "memset failed\n"); return; }
    void* args[] = {&p};
    hipError_t e = hipLaunchCooperativeKernel((const void*)yoco_fwd, dim3(grid), dim3(512), args, LDS_BYTES, stream);
    if (e != hipSuccess) fprintf(stderr, "cooperative launch failed: %s (grid %d)\n", hipGetErrorString(e), grid);
}
```
